# Optimizing an MI355X kernel written in HIP

```python
import jax, jax.numpy as jnp
from jax import lax
import numpy as np

D_MODEL = 1024
BATCH = 8
SEQ = 4096
DEPTH = 2

GRID_W = 64
CTX_LEN = 256
EPS = 1e-6
LB_FLOOR = 1e-30
MASK_SCORE = -1e4
HGRN_WIDTH = D_MODEL // 2
HGRN_HEAD_DIM = 128
HGRN_HEADS = HGRN_WIDTH // HGRN_HEAD_DIM
POOL_WIDTH = D_MODEL - HGRN_WIDTH
POOL_WINDOWS = (2, 4, 8, 16)
POOL_GROUPS = len(POOL_WINDOWS)
POOL_GROUP_DIM = POOL_WIDTH // POOL_GROUPS
IN_COLS = 5 * HGRN_WIDTH + POOL_WIDTH
CHUNK = 64
N_EXPERTS = 64
TOP_K = 6
N_EXPERT_GROUPS = 8
TOPK_GROUPS = 4
EXPERT_HIDDEN = 256
SHARED_HIDDEN = 256
ROUTED_SCALE = 2.5
MOE_BLOCK = 128

kernel_name = "hgrn2_pool_moe_prefix_dit"


def rmsnorm(x, w):
    xf = x.astype(jnp.float32)
    y = xf * lax.rsqrt(jnp.mean(xf * xf, axis=-1, keepdims=True) + EPS)
    return (y * w.astype(jnp.float32)).astype(x.dtype)


def split_heads(t):
    return t.reshape(t.shape[:-1] + (HGRN_HEADS, HGRN_HEAD_DIM))


def forget_gates(f_logit, lb):
    z = split_heads(f_logit).astype(jnp.float32)
    k = (1.0 - lb) * jax.nn.sigmoid(-z)
    log_f = jnp.logaddexp(jnp.log(jnp.maximum(lb, LB_FLOOR)), jnp.log1p(-lb) + jax.nn.log_sigmoid(z))
    return k, log_f


def gla_chunk_scan(q, k, v, g, s0, with_output):
    bsz, seq_len, n_heads, dv = v.shape
    n_chunks = seq_len // CHUNK

    def to_chunks(t):
        t = t.astype(jnp.float32).reshape(bsz, n_chunks, CHUNK, n_heads, t.shape[-1])
        return jnp.moveaxis(t, 1, 0)

    incl = jnp.tril(jnp.ones((CHUNK, CHUNK), dtype=bool))[None, :, :, None, None]

    def step(state, chunk):
        if with_output:
            k_c, v_c, g_c, q_c = chunk
        else:
            k_c, v_c, g_c = chunk
        b_cum = jnp.cumsum(g_c, axis=1)
        b_tot = b_cum[:, -1]
        k_end = k_c * jnp.exp(b_tot[:, None] - b_cum)
        new_state = jnp.exp(b_tot)[..., None] * state + jnp.einsum("bchk,bchv->bhkv", k_end, v_c)
        if not with_output:
            return new_state, None
        o_inter = jnp.einsum("bchk,bhkv->bchv", q_c * jnp.exp(b_cum), state)
        rel = b_cum[:, :, None] - b_cum[:, None]
        decay = jnp.where(incl, jnp.exp(jnp.minimum(rel, 0.0)), 0.0)
        scores = jnp.einsum("bthk,bshk,btshk->bhts", q_c, k_c, decay)
        o_intra = jnp.einsum("bhts,bshv->bthv", scores, v_c)
        return new_state, o_inter + o_intra

    xs = (to_chunks(k), to_chunks(v), to_chunks(g)) + ((to_chunks(q),) if with_output else ())
    final_state, o = lax.scan(step, s0, xs)
    if with_output:
        o = jnp.moveaxis(o, 0, 1).reshape(bsz, seq_len, n_heads, dv)
    return o, final_state


def gated_head_norm(o, gate_logits, w, dtype):
    y = o * lax.rsqrt(jnp.mean(o * o, axis=-1, keepdims=True) + EPS) * w.astype(jnp.float32)
    y = y * jax.nn.silu(split_heads(gate_logits).astype(jnp.float32))
    return y.reshape(y.shape[:-2] + (HGRN_WIDTH,)).astype(dtype)


def hgrn2_mixer(px, pc, lb_layer, gnorm_w, ctx_out):
    W = HGRN_WIDTH

    def q_of(p):
        return jax.nn.silu(split_heads(p[..., 3 * W:4 * W]).astype(jnp.float32)) * HGRN_HEAD_DIM ** -0.5

    def v_of(p):
        return split_heads(p[..., 2 * W:3 * W]).astype(jnp.float32)

    q_x, v_x, v_c = q_of(px), v_of(px), v_of(pc)
    q_c = q_of(pc) if ctx_out else None
    s0 = jnp.zeros((px.shape[0], HGRN_HEADS, HGRN_HEAD_DIM, HGRN_HEAD_DIM), jnp.float32)
    o_x_dirs, o_c_dirs = [], []
    for d in range(2):
        flip = (lambda t: jnp.flip(t, axis=1)) if d == 1 else (lambda t: t)
        lb = lb_layer[d].reshape(HGRN_HEADS, HGRN_HEAD_DIM)
        k_x, g_x = forget_gates(px[..., d * W:(d + 1) * W], lb)
        k_c, g_c = forget_gates(pc[..., d * W:(d + 1) * W], lb)
        o_c, s_c = gla_chunk_scan(flip(q_c) if ctx_out else None, flip(k_c), flip(v_c), flip(g_c), s0, ctx_out)
        o_x, _ = gla_chunk_scan(flip(q_x), flip(k_x), flip(v_x), flip(g_x), s_c, True)
        o_x_dirs.append(flip(o_x))
        if ctx_out:
            o_c_dirs.append(flip(o_c))
    y_x = gated_head_norm(o_x_dirs[0] + o_x_dirs[1], px[..., 4 * W:5 * W], gnorm_w, px.dtype)
    y_c = gated_head_norm(o_c_dirs[0] + o_c_dirs[1], pc[..., 4 * W:5 * W], gnorm_w, pc.dtype) if ctx_out else None
    return y_x, y_c


def multiscale_pool(x):
    n = x.shape[-2]
    xf = x.astype(jnp.float32)
    prefix = jnp.concatenate([jnp.zeros_like(xf[..., :1, :]), jnp.cumsum(xf, axis=-2)], axis=-2)
    pos = jnp.arange(n)
    outs = []
    for gi, w in enumerate(POOL_WINDOWS):
        lo = jnp.clip(pos - w // 2, 0, n)
        hi = jnp.clip(pos + w - w // 2, 0, n)
        sl = slice(gi * POOL_GROUP_DIM, (gi + 1) * POOL_GROUP_DIM)
        pg = prefix[..., sl]
        window_sum = jnp.take(pg, hi, axis=-2) - jnp.take(pg, lo, axis=-2)
        mean = window_sum / (hi - lo).astype(jnp.float32)[:, None]
        outs.append(mean - xf[..., sl])
    return jnp.concatenate(outs, axis=-1).astype(x.dtype)


def pool_mixer(p, w_pool_l, scale_l, rows):
    bsz, n, ch = p.shape
    if rows is None:
        pooled = multiscale_pool(p)
    else:
        pooled = multiscale_pool(p.reshape(bsz, rows, GRID_W, ch)).reshape(bsz, n, ch)
    grouped = pooled.reshape(bsz, n, POOL_GROUPS, POOL_GROUP_DIM)
    mixed = jnp.einsum("bngc,gcd->bngd", grouped, w_pool_l)
    return mixed.reshape(bsz, n, ch) * scale_l


def moe(h, w_router, r_bias, w1, w3, w2, sw1, sw3, sw2):
    n_tok, d = h.shape
    scores = jax.nn.sigmoid((h @ w_router).astype(jnp.float32))
    biased = scores + r_bias.astype(jnp.float32)
    per_group = N_EXPERTS // N_EXPERT_GROUPS
    grp_score = lax.top_k(biased.reshape(n_tok, N_EXPERT_GROUPS, per_group), 2)[0].sum(-1)
    _, top_grp = lax.top_k(grp_score, TOPK_GROUPS)
    keep = jnp.any(top_grp[:, :, None] == jnp.arange(N_EXPERT_GROUPS)[None, None, :], axis=1)
    masked = jnp.where(jnp.repeat(keep, per_group, axis=1), biased, MASK_SCORE)
    _, idx = lax.top_k(masked, TOP_K)
    gate = jnp.take_along_axis(scores, idx, axis=1)
    gate = gate / jnp.sum(gate, axis=-1, keepdims=True) * ROUTED_SCALE
    n_assign = n_tok * TOP_K
    n_blocks = -(-n_assign // MOE_BLOCK) + N_EXPERTS
    flat_e = idx.reshape(n_assign)
    flat_t = jnp.arange(n_assign, dtype=jnp.int32) // TOP_K
    order = jnp.argsort(flat_e)
    se, st, sw = flat_e[order], flat_t[order], gate.reshape(n_assign)[order]
    counts = jnp.bincount(flat_e, length=N_EXPERTS)
    padded = (counts + MOE_BLOCK - 1) // MOE_BLOCK * MOE_BLOCK
    pad_end = jnp.cumsum(padded)
    pad_start = pad_end - padded
    start = jnp.cumsum(counts) - counts
    dest = pad_start[se] + jnp.arange(n_assign, dtype=jnp.int32) - start[se]
    rows_total = n_blocks * MOE_BLOCK
    tok_buf = jnp.full((rows_total,), n_tok, jnp.int32).at[dest].set(st)
    w_buf = jnp.zeros((rows_total,), jnp.float32).at[dest].set(sw)
    blk_e = jnp.minimum(jnp.searchsorted(pad_end, jnp.arange(n_blocks, dtype=jnp.int32) * MOE_BLOCK, side="right"), N_EXPERTS - 1)
    h_pad = jnp.concatenate([h, jnp.zeros((1, d), h.dtype)], axis=0)

    def expert_block(acc, blk):
        tok, wt, e = blk
        xb = h_pad[tok]
        y = (jax.nn.silu(xb @ w1[e]) * (xb @ w3[e])) @ w2[e]
        return acc.at[tok].add(y * wt[:, None].astype(y.dtype)), None

    routed, _ = lax.scan(expert_block, jnp.zeros((n_tok + 1, d), h.dtype),
                         (tok_buf.reshape(n_blocks, MOE_BLOCK), w_buf.reshape(n_blocks, MOE_BLOCK), blk_e))
    shared = (jax.nn.silu(h @ sw1) * (h @ sw3)) @ sw2
    return routed[:n_tok] + shared


def setup_inputs(seed: int = 0) -> dict:
    key = jax.random.key(seed)
    ks = jax.random.split(key, 24)
    D, E, F, FS = D_MODEL, N_EXPERTS, EXPERT_HIDDEN, SHARED_HIDDEN

    def nrm(k, shape, scale):
        return jax.random.normal(k, shape, jnp.float32) * scale

    return {
        "x": nrm(ks[0], (BATCH, SEQ, D), 1.0),
        "c": nrm(ks[1], (BATCH, D), 1.0),
        "ctx": nrm(ks[2], (BATCH, CTX_LEN, D), 1.0),
        "c_ctx": nrm(ks[3], (D,), 1.0),
        "norm1_w": 1.0 + nrm(ks[4], (DEPTH, D), 0.01),
        "norm2_w": 1.0 + nrm(ks[5], (DEPTH, D), 0.01),
        "w_ada": nrm(ks[6], (DEPTH, D, 6 * D), 0.5 * D ** -0.5),
        "b_ada": nrm(ks[7], (DEPTH, 6 * D), 0.02),
        "w_in": nrm(ks[8], (DEPTH, D, IN_COLS), D ** -0.5),
        "hgrn_lb_logits": nrm(ks[9], (DEPTH, 2, HGRN_WIDTH), 0.5),
        "hgrn_gnorm_w": 1.0 + nrm(ks[10], (DEPTH, HGRN_HEAD_DIM), 0.01),
        "w_pool": nrm(ks[11], (DEPTH, POOL_GROUPS, POOL_GROUP_DIM, POOL_GROUP_DIM), POOL_GROUP_DIM ** -0.5),
        "pool_scale": 1.0 + nrm(ks[12], (DEPTH, POOL_WIDTH), 0.01),
        "w_out": nrm(ks[13], (DEPTH, D, D), D ** -0.5),
        "w_router": nrm(ks[14], (DEPTH, D, E), D ** -0.5),
        "router_bias": nrm(ks[15], (DEPTH, E), 0.01),
        "w1_experts": nrm(ks[16], (DEPTH, E, D, F), D ** -0.5),
        "w3_experts": nrm(ks[17], (DEPTH, E, D, F), D ** -0.5),
        "w2_experts": nrm(ks[18], (DEPTH, E, F, D), F ** -0.5),
        "w1_shared": nrm(ks[19], (DEPTH, D, FS), D ** -0.5),
        "w3_shared": nrm(ks[20], (DEPTH, D, FS), D ** -0.5),
        "w2_shared": nrm(ks[21], (DEPTH, FS, D), FS ** -0.5),
        "final_norm_w": 1.0 + nrm(ks[22], (D,), 0.01),
    }


def reference(x, c, ctx, c_ctx, norm1_w, norm2_w, w_ada, b_ada, w_in, hgrn_lb_logits, hgrn_gnorm_w,
              w_pool, pool_scale, w_out, w_router, router_bias, w1_experts, w3_experts, w2_experts,
              w1_shared, w3_shared, w2_shared, final_norm_w):
    bsz, seq_len, d = x.shape
    ctx_len = ctx.shape[1]
    rows = seq_len // GRID_W
    W = HGRN_WIDTH
    p_lb = jax.nn.softmax(hgrn_lb_logits.astype(jnp.float32), axis=0)
    lb_all = jnp.cumsum(p_lb, axis=0) - p_lb[0:1]
    for l in range(DEPTH):
        last = l == DEPTH - 1
        mod_x = (jax.nn.silu(c) @ w_ada[l] + b_ada[l])[:, None, :]
        mod_c = (jax.nn.silu(c_ctx) @ w_ada[l] + b_ada[l])[None, None, :]
        sh1, sc1, gt1, sh2, sc2, gt2 = jnp.split(mod_x, 6, axis=-1)
        csh1, csc1, cgt1, csh2, csc2, cgt2 = jnp.split(mod_c, 6, axis=-1)
        hx = rmsnorm(x, norm1_w[l]) * (1 + sc1) + sh1
        hc = rmsnorm(ctx, norm1_w[l]) * (1 + csc1) + csh1
        px = hx @ w_in[l]
        pc = hc @ (w_in[l][:, :3 * W] if last else w_in[l])
        hg_x, hg_c = hgrn2_mixer(px, pc, lb_all[l], hgrn_gnorm_w[l], not last)
        pool_x = pool_mixer(px[..., 5 * W:], w_pool[l], pool_scale[l], rows)
        x = x + gt1 * (jnp.concatenate([hg_x, pool_x], axis=-1) @ w_out[l])
        hx2 = rmsnorm(x, norm2_w[l]) * (1 + sc2) + sh2
        if last:
            y = moe(hx2.reshape(-1, d), w_router[l], router_bias[l], w1_experts[l], w3_experts[l], w2_experts[l],
                    w1_shared[l], w3_shared[l], w2_shared[l])
            x = x + gt2 * y.reshape(bsz, seq_len, d)
        else:
            pool_c = pool_mixer(pc[..., 5 * W:], w_pool[l], pool_scale[l], None)
            ctx = ctx + cgt1 * (jnp.concatenate([hg_c, pool_c], axis=-1) @ w_out[l])
            hc2 = rmsnorm(ctx, norm2_w[l]) * (1 + csc2) + csh2
            tokens = jnp.concatenate([hc2.reshape(-1, d), hx2.reshape(-1, d)], axis=0)
            y = moe(tokens, w_router[l], router_bias[l], w1_experts[l], w3_experts[l], w2_experts[l],
                    w1_shared[l], w3_shared[l], w2_shared[l])
            ctx = ctx + cgt2 * y[:bsz * ctx_len].reshape(bsz, ctx_len, d)
            x = x + gt2 * y[bsz * ctx_len:].reshape(bsz, seq_len, d)
    return rmsnorm(x, final_norm_w)
```

```cpp
#include <hip/hip_runtime.h>
#include <cstdio>
#include <cstdint>
namespace pg8 {
#define PG8_LAS __attribute__((address_space(3)))
typedef unsigned short bf16_t;
typedef short bf16x8 __attribute__((ext_vector_type(8)));
typedef float f32x4 __attribute__((ext_vector_type(4)));
typedef unsigned u32x4 __attribute__((ext_vector_type(4)));
__device__ __forceinline__ int opaque_tid() { int t = threadIdx.x; asm volatile("" : "+v"(t)); return t; }
constexpr int BM = 256, BK = 64, HALF = 128, HTB = HALF * BK * 2  , STAGE_BYTES = 8 * HTB, NXCD = 8, WGM = 8;

__host__ __device__ __forceinline__ int lds_byte(int r, int c) { const int st = (r >> 4) * 2 + (c >> 5), rr = r & 15, cc = c & 31, ob = rr * 64 + cc * 2; return st * 1024 + (ob ^ (((ob >> 9) & 1) << 5)); }
__host__ __device__ __forceinline__ void stage_rc(int b, int& R, int& C) { const int st = b / 1024, sb = b % 1024, swz = sb ^ (((sb >> 9) & 1) << 5); R = (st >> 1) * 16 + swz / 64; C = (st & 1) * 32 + (swz % 64) / 2; }
__host__ __device__ __forceinline__ int perm32(int rho) { const int n = rho >> 4, i = rho & 15; return 8 * (i >> 2) + 4 * n + (i & 3); }

struct Unit { int pm, pn; };
struct Gemm { const bf16_t* A; const bf16_t* Bt; int K; const int* rowidx; };

struct StaticOrder {
    int nM, nN, nwg, G, c;
    __host__ __device__ void init(int M, int N, int G_, int c_) { nM = M / BM; nN = N / BM; nwg = nM * nN; G = G_; c = c_; }
    __host__ __device__ bool next(int i, Unit& u) const {
        const long L = (long)i * G + c; if (L >= nwg) return false;
        int wgid = (int)L; { const int q = nwg / NXCD, r = nwg % NXCD, xcd = wgid % NXCD, off = wgid / NXCD; wgid = (xcd < r ? xcd * (q + 1) : r * (q + 1) + (xcd - r) * q) + off; }
        const int nig = WGM * nN, gid = wgid / nig, fm = gid * WGM, gsz = (nM - fm) < WGM ? (nM - fm) : WGM;
        u.pm = fm + ((wgid % nig) % gsz); u.pn = (wgid % nig) / gsz; return true;
    }
};
struct MoeOrder {
    const int* blk_e; int nblk, NT, G, c;
    __device__ __forceinline__ bool next(int i, Unit& u) const {
        const long L = (long)i * G + c; if (L >= (long)nblk * NT) return false;
        const int blk = (int)(L / NT), pnl = (int)(L % NT); const int e = __builtin_amdgcn_readfirstlane(blk_e[blk]);
        u.pm = blk; u.pn = e * NT + pnl; return true;
    }
};

__device__ __forceinline__ unsigned cvt_pk_bf16(float lo, float hi) { unsigned r; asm volatile("v_cvt_pk_bf16_f32 %0, %1, %2" : "=v"(r) : "v"(lo), "v"(hi)); return r; }

struct EpiB16 {
    static constexpr bool PERM = true;
    bf16_t* O; int ldc; int pn_mask;
    __device__ __forceinline__ void operator()(const f32x4 (&acc)[2][2][4][2], const Unit& u, int wr, int wc, int fr, int fq) const {
        const int row0 = u.pm * BM + wr * 64 + fr; const int col0 = (u.pn & pn_mask) * BM + wc * 32 + 8 * fq;
#pragma unroll
        for (int ai = 0; ai < 2; ++ai)
#pragma unroll
            for (int m = 0; m < 4; ++m) { bf16_t* rowp = O + (size_t)(row0 + ai * HALF + m * 16) * ldc + col0;
#pragma unroll
                for (int bj = 0; bj < 2; ++bj) { const f32x4 v0 = acc[ai][bj][m][0], v1 = acc[ai][bj][m][1];
                    u32x4 w; w.x = cvt_pk_bf16(v0[0], v0[1]); w.y = cvt_pk_bf16(v0[2], v0[3]); w.z = cvt_pk_bf16(v1[0], v1[1]); w.w = cvt_pk_bf16(v1[2], v1[3]);
                    *(u32x4*)(rowp + bj * HALF) = w; } }
    }
};
struct EpiRes {
    static constexpr bool PERM = false;
    const float* base_c; const float* base_x; float* out_c; float* out_x; const float* mod; int gt_off; int row_base;
    __device__ __forceinline__ void operator()(const f32x4 (&acc)[2][2][4][2], const Unit& u, int wr, int wc, int fr, int fq) const {
        const int trow = row_base + u.pm * BM;
        const float* bp; float* op; int mr;
        if (trow < 2048) { mr = 8; bp = base_c + (size_t)trow * 1024; op = out_c + (size_t)trow * 1024; }
        else { mr = (trow - 2048) >> 12; bp = base_x + (size_t)(trow - 2048) * 1024; op = out_x + (size_t)(trow - 2048) * 1024; }
        const float* gate = mod + mr * 6144 + gt_off;
        const int r0 = wr * 64 + fr, col0 = u.pn * BM + wc * 32 + 4 * fq;
        f32x4 gv[2][2];
#pragma unroll
        for (int bj = 0; bj < 2; ++bj)
#pragma unroll
            for (int n = 0; n < 2; ++n) gv[bj][n] = *(const f32x4*)(gate + col0 + bj * HALF + n * 16);
#pragma unroll
        for (int ai = 0; ai < 2; ++ai)
#pragma unroll
            for (int m = 0; m < 4; ++m) { const size_t off = (size_t)(r0 + ai * HALF + m * 16) * 1024 + col0;
#pragma unroll
                for (int bj = 0; bj < 2; ++bj)
#pragma unroll
                    for (int n = 0; n < 2; ++n) { const f32x4 b = *(const f32x4*)(bp + off + bj * HALF + n * 16); *(f32x4*)(op + off + bj * HALF + n * 16) = b + gv[bj][n] * acc[ai][bj][m][n]; }
                asm volatile("" ::: "memory"); }
    }
};
struct EpiSwiglu {
    static constexpr bool PERM = false;
    bf16_t* HS;
    __device__ __forceinline__ void operator()(const f32x4 (&acc)[2][2][4][2], const Unit& u, int wr, int wc, int fr, int fq) const {
        const int row0 = u.pm * BM + wr * 64 + fr, hid0 = (u.pn & 1) * 128 + wc * 32 + fq * 8;
#pragma unroll
        for (int ai = 0; ai < 2; ++ai)
#pragma unroll
            for (int m = 0; m < 4; ++m) {
                float h[8];
#pragma unroll
                for (int bj = 0; bj < 2; ++bj)
#pragma unroll
                    for (int i = 0; i < 4; ++i) { const float a = acc[ai][bj][m][0][i], b = acc[ai][bj][m][1][i]; h[bj * 4 + i] = a * __builtin_amdgcn_rcpf(1.0f + __expf(-a)) * b; }
                u32x4 w; w.x = cvt_pk_bf16(h[0], h[1]); w.y = cvt_pk_bf16(h[2], h[3]); w.z = cvt_pk_bf16(h[4], h[5]); w.w = cvt_pk_bf16(h[6], h[7]);
                *(u32x4*)(HS + (size_t)(row0 + ai * HALF + m * 16) * 256 + hid0) = w; }
    }
};

template <class Epi, class Sched, bool ALIGN_EPI, bool GATHER>
__device__ __forceinline__ void gemm_phase(PG8_LAS unsigned char* lds, const Gemm g, const Sched& S, const Epi& E) {
    const int tid = opaque_tid(), wid = __builtin_amdgcn_readfirstlane(tid >> 6), lane = tid & 63, wr = wid >> 2, wc = wid & 3, fr = lane & 15, fq = lane >> 4;
    const int K = g.K, nt = K / BK;
    unsigned voffA[2], voffB[2]; int rowA[2]; unsigned colA[2];
#pragma unroll
    for (int i = 0; i < 2; ++i) { int R, C; stage_rc(tid * 16 + i * 8192, R, C); const int Rb = Epi::PERM ? ((R & ~31) + perm32(R & 31)) : R;
        voffA[i] = (unsigned)(R * K + C) * 2u; voffB[i] = (unsigned)(Rb * K + C) * 2u; rowA[i] = R; colA[i] = (unsigned)C * 2u; }
    const size_t kstep = (size_t)(BK * 2);
    const size_t hstep = (size_t)HALF * K * 2;
    const size_t tstep = 2 * hstep;
    const unsigned ldsw = (unsigned)wid * 1024u;
    const int aoff = lds_byte(wr * 64 + fr, fq * 8), boff = lds_byte(wc * 32 + fr, fq * 8);
#define PG8_SA(b, h) (((b) * 2 + (h)) * HTB)
#define PG8_SB(b, h) ((4 + (b) * 2 + (h)) * HTB)
#define PG8_STAGE(bufoff, gbase, voff) do { _Pragma("unroll") for (int _i = 0; _i < 2; ++_i) \
        __builtin_amdgcn_global_load_lds((const unsigned*)((const char*)(gbase) + (voff)[_i]), (PG8_LAS unsigned*)(lds + (bufoff) + ldsw + _i * 8192), 16, 0, 0); } while (0)
#define PG8_STAGE2(bufoff, gbase, o0, o1) do { \
        __builtin_amdgcn_global_load_lds((const unsigned*)((const char*)(gbase) + (o0)), (PG8_LAS unsigned*)(lds + (bufoff) + ldsw), 16, 0, 0); \
        __builtin_amdgcn_global_load_lds((const unsigned*)((const char*)(gbase) + (o1)), (PG8_LAS unsigned*)(lds + (bufoff) + ldsw + 8192), 16, 0, 0); } while (0)
#define PG8_LDA(dst, b, h) do { _Pragma("unroll") for (int m = 0; m < 4; ++m) _Pragma("unroll") for (int k = 0; k < 2; ++k) dst[m][k] = *(const PG8_LAS bf16x8*)(lds + PG8_SA(b, h) + aoff + m * 2048 + k * 1024); } while (0)
#define PG8_LDB(dst, b, h) do { _Pragma("unroll") for (int n = 0; n < 2; ++n) _Pragma("unroll") for (int k = 0; k < 2; ++k) dst[n][k] = *(const PG8_LAS bf16x8*)(lds + PG8_SB(b, h) + boff + n * 2048 + k * 1024); } while (0)
#define PG8_MMA(ai, bj, At, Bt) do { __builtin_amdgcn_s_setprio(1); _Pragma("unroll") for (int m = 0; m < 4; ++m) _Pragma("unroll") for (int n = 0; n < 2; ++n) _Pragma("unroll") for (int k = 0; k < 2; ++k) \
        acc[ai][bj][m][n] = __builtin_amdgcn_mfma_f32_16x16x32_bf16(Bt[n][k], At[m][k], acc[ai][bj][m][n], 0, 0, 0); __builtin_amdgcn_s_setprio(0); } while (0)
#define PG8_WAIT_V(n) asm volatile("s_waitcnt vmcnt(" #n ")" ::: "memory")
#define PG8_WAIT_L(n) asm volatile("s_waitcnt lgkmcnt(" #n ")" ::: "memory")
#define PG8_BAR __builtin_amdgcn_s_barrier()
#define PG8_SCHED __builtin_amdgcn_sched_barrier(0)
    Unit cur, nxt; int ui = 0;
    if (!S.next(0, cur)) return;
    float zf = 0.f; asm volatile("" : "+v"(zf));
    f32x4 acc[2][2][4][2];
#pragma unroll
    for (int a = 0; a < 2; ++a)
#pragma unroll
        for (int b = 0; b < 2; ++b)
#pragma unroll
            for (int m = 0; m < 4; ++m)
#pragma unroll
                for (int n = 0; n < 2; ++n) acc[a][b][m][n] = (f32x4){zf, zf, zf, zf};
    bf16x8 At[4][2], B0[2][2], B1[2][2];
    unsigned oc00 = 0, oc01 = 0, oc10 = 0, oc11 = 0, on00 = 0, on01 = 0, on10 = 0, on11 = 0;
    const char* cA = GATHER ? (const char*)g.A : (const char*)g.A + (size_t)cur.pm * tstep; const char* cB = (const char*)g.Bt + (size_t)cur.pn * tstep;
    if constexpr (GATHER) { const int* ri = g.rowidx + cur.pm * BM; const unsigned rb = (unsigned)K * 2u;
        oc00 = (unsigned)ri[rowA[0]] * rb + colA[0]; oc01 = (unsigned)ri[rowA[1]] * rb + colA[1]; oc10 = (unsigned)ri[HALF + rowA[0]] * rb + colA[0]; oc11 = (unsigned)ri[HALF + rowA[1]] * rb + colA[1]; }
    PG8_STAGE(PG8_SB(0, 0), cB, voffB); PG8_STAGE(PG8_SB(0, 1), cB + hstep, voffB);
    if constexpr (GATHER) { PG8_STAGE2(PG8_SA(0, 0), cA, oc00, oc01); PG8_STAGE2(PG8_SA(0, 1), cA, oc10, oc11); }
    else { PG8_STAGE(PG8_SA(0, 0), cA, voffA); PG8_STAGE(PG8_SA(0, 1), cA + hstep, voffA); }
    if (wr == 1) PG8_BAR;
    PG8_WAIT_V(2); PG8_BAR;
    PG8_STAGE(PG8_SB(1, 0), cB + kstep, voffB);
    if constexpr (GATHER) { PG8_STAGE2(PG8_SA(1, 0), cA + kstep, oc00, oc01); } else { PG8_STAGE(PG8_SA(1, 0), cA + kstep, voffA); }
    PG8_STAGE(PG8_SB(1, 1), cB + hstep + kstep, voffB);
    PG8_WAIT_V(6); PG8_BAR;
    for (;;) {
        const bool has_next = S.next(ui + 1, nxt);
        const char* nA = GATHER ? cA : (has_next ? (const char*)g.A + (size_t)nxt.pm * tstep : cA); const char* nB = has_next ? (const char*)g.Bt + (size_t)nxt.pn * tstep : cB;
        if constexpr (GATHER) {
            if (has_next) { const int* ri = g.rowidx + nxt.pm * BM; const unsigned rb = (unsigned)K * 2u;
                on00 = (unsigned)ri[rowA[0]] * rb + colA[0]; on01 = (unsigned)ri[rowA[1]] * rb + colA[1]; on10 = (unsigned)ri[HALF + rowA[0]] * rb + colA[0]; on11 = (unsigned)ri[HALF + rowA[1]] * rb + colA[1]; }
            else { on00 = oc00; on01 = oc01; on10 = oc10; on11 = oc11; }
        }
        for (int t = 0; t < nt; t += 2) {
            const bool last = (t == nt - 2);
            const char* a1 = cA + (size_t)(t + 1) * kstep;
            const char* a2 = last ? nA : cA + (size_t)(t + 2) * kstep; const char* b2 = last ? nB : cB + (size_t)(t + 2) * kstep;
            const char* a3 = a2 + kstep; const char* b3 = b2 + kstep;
            const unsigned s00 = last ? on00 : oc00, s01 = last ? on01 : oc01, s10 = last ? on10 : oc10, s11 = last ? on11 : oc11;
            PG8_LDB(B0, 0, 0); PG8_LDB(B1, 0, 1); PG8_SCHED; PG8_LDA(At, 0, 0);
            if constexpr (GATHER) { PG8_STAGE2(PG8_SA(1, 1), a1, oc10, oc11); } else { PG8_STAGE(PG8_SA(1, 1), a1 + hstep, voffA); }
            PG8_WAIT_V(8); PG8_WAIT_L(0); PG8_BAR; PG8_MMA(0, 0, At, B0); PG8_MMA(0, 1, At, B1); PG8_BAR; PG8_SCHED;
            PG8_LDA(At, 0, 1); PG8_STAGE(PG8_SB(0, 0), b2, voffB); PG8_STAGE(PG8_SB(0, 1), b2 + hstep, voffB);
            if constexpr (GATHER) { PG8_STAGE2(PG8_SA(0, 0), a2, s00, s01); } else { PG8_STAGE(PG8_SA(0, 0), a2, voffA); }
            PG8_WAIT_V(8); PG8_WAIT_L(0); PG8_BAR; PG8_MMA(1, 0, At, B0); PG8_MMA(1, 1, At, B1); PG8_BAR; PG8_SCHED;
            PG8_LDB(B0, 1, 0); PG8_LDB(B1, 1, 1); PG8_SCHED; PG8_LDA(At, 1, 0);
            if constexpr (GATHER) { PG8_STAGE2(PG8_SA(0, 1), a2, s10, s11); } else { PG8_STAGE(PG8_SA(0, 1), a2 + hstep, voffA); }
            PG8_WAIT_V(8); PG8_WAIT_L(0); PG8_BAR; PG8_MMA(0, 0, At, B0); PG8_MMA(0, 1, At, B1); PG8_BAR; PG8_SCHED;
            PG8_LDA(At, 1, 1); PG8_STAGE(PG8_SB(1, 0), b3, voffB); PG8_STAGE(PG8_SB(1, 1), b3 + hstep, voffB);
            if constexpr (GATHER) { PG8_STAGE2(PG8_SA(1, 0), a3, s00, s01); } else { PG8_STAGE(PG8_SA(1, 0), a3, voffA); }
            PG8_WAIT_V(8); PG8_WAIT_L(0); PG8_BAR; PG8_MMA(1, 0, At, B0); PG8_MMA(1, 1, At, B1); PG8_BAR; PG8_SCHED;
        }
        if constexpr (ALIGN_EPI) { if (wr == 0) PG8_BAR; }
        E(acc, cur, wr, wc, fr, fq);
        if (!has_next) break;
#pragma unroll
        for (int a = 0; a < 2; ++a)
#pragma unroll
            for (int b = 0; b < 2; ++b)
#pragma unroll
                for (int m = 0; m < 4; ++m)
#pragma unroll
                    for (int n = 0; n < 2; ++n) acc[a][b][m][n] = (f32x4){zf, zf, zf, zf};
        cur = nxt; cA = nA; cB = nB; ++ui; oc00 = on00; oc01 = on01; oc10 = on10; oc11 = on11;
        if constexpr (ALIGN_EPI) { if (wr == 1) PG8_BAR; }
    }
    PG8_WAIT_V(0);
    if constexpr (!ALIGN_EPI) { if (wr == 0) PG8_BAR; }
    PG8_BAR;
#undef PG8_SA
#undef PG8_SB
#undef PG8_STAGE
#undef PG8_STAGE2
#undef PG8_LDA
#undef PG8_LDB
#undef PG8_MMA
#undef PG8_WAIT_V
#undef PG8_WAIT_L
#undef PG8_BAR
#undef PG8_SCHED
}
}
#define GAS __attribute__((address_space(1)))
#define LAS __attribute__((address_space(3)))
typedef unsigned short bf16;
typedef unsigned v4u __attribute__((ext_vector_type(4)));
typedef float f32x4 __attribute__((ext_vector_type(4)));
typedef short bf16x8 __attribute__((ext_vector_type(8)));
typedef GAS unsigned gu32;
typedef GAS unsigned long long gu64;
#define RLX_AGENT __ATOMIC_RELAXED, __HIP_MEMORY_SCOPE_AGENT
#define LDS_WAIT() asm volatile("s_waitcnt lgkmcnt(0)" ::: "memory")
#define VM_WAIT() asm volatile("s_waitcnt vmcnt(0)" ::: "memory")
__device__ __forceinline__ unsigned long long rt() { return __builtin_amdgcn_s_memrealtime(); }
__device__ __forceinline__ unsigned f2bf(float f) { unsigned u = __builtin_bit_cast(unsigned, f); return (u + 0x7fffu + ((u >> 16) & 1u)) >> 16; }
__device__ __forceinline__ unsigned pk2(float lo, float hi) { return f2bf(lo) | (f2bf(hi) << 16); }

#define XB_TMO      128
#define XB_XCNT(j)  (256  + 64 * (j))
#define XB_XSUB(j)  (1280 + 64 * (j))
#define XB_XGEN(j)  (2304 + 64 * (j))
#define XB_TOP      3328
#define XB_TOPGEN   3392
#define XCD_BAR_WORDS 3456
#define XB_SPIN_CAP (1u << 18)

__device__ __forceinline__ unsigned xb_ld(unsigned* p)              { return __hip_atomic_load(p, __ATOMIC_RELAXED, __HIP_MEMORY_SCOPE_AGENT); }
__device__ __forceinline__ unsigned xb_add(unsigned* p, unsigned v) { return __hip_atomic_fetch_add(p, v, __ATOMIC_RELAXED, __HIP_MEMORY_SCOPE_AGENT); }
__device__ __forceinline__ unsigned xb_xcc_id() { return (unsigned)__builtin_amdgcn_s_getreg((3 << 11) | 20) & 0xFu; }
#define XB_SPIN(cond, bar) do { unsigned _sp = 0; while (cond) { __builtin_amdgcn_s_sleep(1); \
    if ((++_sp & 255u) == 0u) { if (xb_ld(&(bar)[XB_TMO])) break; if (_sp > XB_SPIN_CAP) { atomicAdd(&(bar)[XB_TMO], 1u); break; } } } } while (0)

struct XcdBarrier {
    unsigned* bar; unsigned x;
    volatile LAS unsigned* st;
};

__device__ __forceinline__ XcdBarrier xcd_barrier_post(unsigned* bar, volatile LAS unsigned* st) {
    XcdBarrier b; b.bar = bar; b.x = xb_xcc_id(); b.st = st;
    if (threadIdx.x == 0) (void)xb_add(&bar[XB_XCNT(b.x)], 1u);
    return b;
}
__device__ __forceinline__ void xcd_barrier_complete(unsigned* bar, unsigned x, unsigned& nloc, unsigned& nx) {
    const unsigned G = gridDim.x * gridDim.y * gridDim.z;
    unsigned sum, cnt, mine, sp = 0u;
    for (;;) {
        sum = 0u; cnt = 0u; mine = 0u;
#pragma unroll
        for (unsigned j = 0; j < 16; ++j) { const unsigned c = xb_ld(&bar[XB_XCNT(j)]); sum += c; cnt += (c > 0u) ? 1u : 0u; mine = (j == x) ? c : mine; }
        if (sum == G) break;
        __builtin_amdgcn_s_sleep(1);
        if ((++sp & 255u) == 0u) { if (xb_ld(&bar[XB_TMO])) break; if (sp > XB_SPIN_CAP) { atomicAdd(&bar[XB_TMO], 1u); break; } }
    }
    nloc = mine > 0u ? mine : 1u; nx = cnt > 0u ? cnt : 1u;
}

__device__ __forceinline__ void xcd_barrier(const XcdBarrier& b) {
    asm volatile("s_waitcnt vmcnt(0)" ::: "memory");
    __syncthreads();
    if (threadIdx.x == 0) {
        unsigned* bar = b.bar;
        __builtin_amdgcn_s_waitcnt(0);
        unsigned nloc = b.st[0], nx = b.st[1];
        if (nloc == 0u) { xcd_barrier_complete(bar, b.x, nloc, nx); b.st[0] = nloc; b.st[1] = nx; }
        const unsigned old = xb_add(&bar[XB_XSUB(b.x)], 1u);
        const unsigned gen = old / nloc;
        if (old + 1u == (gen + 1u) * nloc) {
            __builtin_amdgcn_fence(__ATOMIC_RELEASE, "agent");
            asm volatile("s_waitcnt vmcnt(0)" ::: "memory");
            const unsigned og = xb_add(&bar[XB_TOP], 1u);
            const unsigned tg = og / nx;
            if (og + 1u == (tg + 1u) * nx) xb_add(&bar[XB_TOPGEN], 1u);
            else XB_SPIN(xb_ld(&bar[XB_TOPGEN]) == tg, bar);
            __builtin_amdgcn_fence(__ATOMIC_ACQUIRE, "agent");
            xb_add(&bar[XB_XGEN(b.x)], 1u);
            asm volatile("s_waitcnt vmcnt(0)" ::: "memory");
        } else {
            XB_SPIN(xb_ld(&bar[XB_XGEN(b.x)]) == gen, bar);
            __builtin_amdgcn_fence(__ATOMIC_ACQUIRE, "agent");
            asm volatile("s_waitcnt vmcnt(0)" ::: "memory");
        }
    }
    __syncthreads();
}

constexpr int NWAVES = 8;
constexpr int DM = 1024, NBATCH = 8, SEQL = 4096, CTXL = 256;
constexpr int NC = NBATCH * CTXL, NX = NBATCH * SEQL, NTOK = NC + NX;
constexpr int HW = 512, INC = 3072, NE = 64, TOPK = 6;
constexpr int NCH = 68;
constexpr int NSEQ = NBATCH * 4 * 2;
constexpr float EPSN = 1e-6f;
constexpr int MAXBLK = 544;
constexpr int MAXSLOT = 540 * 256;

constexpr size_t MiB = 1u << 20;
constexpr size_t WS_CTL = 0, CTL_ZERO_BYTES = 1 * MiB;
constexpr size_t WS_MOD = 1 * MiB;
constexpr size_t WS_RT = 2 * MiB;
constexpr size_t RT_IDX = WS_RT, RT_GATE = WS_RT + 1 * MiB, RT_TSLOT = WS_RT + 2 * MiB, RT_STOK = WS_RT + 3 * MiB, RT_BLKE = WS_RT + 4 * MiB + 512 * 1024, RT_MISC = RT_BLKE + 8192;
constexpr size_t WS_CTXRES = 8 * MiB;
constexpr size_t WS_WIN = 16 * MiB, WS_WOUT = 22 * MiB, WS_WPOOL = 24 * MiB, WS_WR = 25 * MiB, WS_W13 = 26 * MiB, WS_W2 = 91 * MiB;
constexpr size_t WS_HX = 124 * MiB;
constexpr size_t WS_PX = 193 * MiB;
constexpr size_t WS_KV = 397 * MiB;
constexpr size_t WS_DEC = 533 * MiB;
constexpr size_t WS_HS = 193 * MiB, WS_YS = 261 * MiB;
constexpr size_t WS_END = 536 * MiB;
static_assert(WS_HS + (size_t)MAXSLOT * 512 <= WS_YS && WS_YS + (size_t)MAXSLOT * 2048 <= WS_DEC && WS_HX + (size_t)(NTOK + 1) * 2048 <= WS_PX && WS_PX + (size_t)NTOK * INC * 2 <= WS_KV, "ws map");
constexpr int CW_BAR = 4096, CW_CNT = 8192, CW_CUR = 8448;

constexpr int RING_BYTES = 131072, LDSCTL_OFF = RING_BYTES, MISC_OFF = LDSCTL_OFF + 320, LDS_BYTES = 147456;

__device__ __forceinline__ float bf2f(unsigned short u) { return __builtin_bit_cast(float, ((unsigned)u) << 16); }
__device__ __forceinline__ float shx(float v, int o, int lane) { return __builtin_bit_cast(float, __builtin_amdgcn_ds_bpermute((lane ^ o) << 2, __builtin_bit_cast(int, v))); }
__device__ __forceinline__ float shl(float v, int src) { return __builtin_bit_cast(float, __builtin_amdgcn_ds_bpermute(src << 2, __builtin_bit_cast(int, v))); }
__device__ __forceinline__ float wave_sum(float v, int lane) {
#pragma unroll
    for (int o = 1; o < 64; o <<= 1) v += shx(v, o, lane);
    return v;
}
__device__ __forceinline__ float wave_max(float v, int lane) {
#pragma unroll
    for (int o = 1; o < 64; o <<= 1) v = fmaxf(v, shx(v, o, lane));
    return v;
}
__device__ __forceinline__ float opaque_zero() { float z = 0.f; asm volatile("" : "+v"(z)); return z; }
__device__ __forceinline__ float sigmoidf_(float x) { return __builtin_amdgcn_rcpf(1.0f + __expf(-x)); }
__device__ __forceinline__ float clamp80(float x) { return fminf(fmaxf(x, -80.f), 80.f); }

struct Frame {
    LAS unsigned char* lds;
    unsigned* ctl;
    int tid, lane, wave, vcu, G;
    const float* in[23];
    float* out; unsigned char* ws;
};
extern __shared__ __attribute__((aligned(16))) unsigned char g_lds[];
constexpr int TAB_OFF = MISC_OFF + 128;
__device__ __forceinline__ unsigned long long tab_ld(int i) {
    const unsigned long long v = ((const LAS unsigned long long*)((LAS unsigned char*)g_lds + TAB_OFF))[i];
    const unsigned lo = (unsigned)__builtin_amdgcn_readfirstlane((int)(unsigned)v), hi = (unsigned)__builtin_amdgcn_readfirstlane((int)(unsigned)(v >> 32));
    return ((unsigned long long)hi << 32) | lo;
}
__device__ __forceinline__ Frame make_frame() {
    asm volatile("" ::: "memory");
    Frame F;
    F.lds = (LAS unsigned char*)g_lds;
    F.tid = pg8::opaque_tid(); F.lane = F.tid & 63; F.wave = __builtin_amdgcn_readfirstlane(F.tid >> 6);
    F.G = gridDim.x; { int bx = blockIdx.x; asm volatile("" : "+s"(bx)); F.vcu = (F.G % 8 == 0) ? (bx % 8) * (F.G / 8) + bx / 8 : bx; }
#pragma unroll
    for (int i = 0; i < 23; ++i) F.in[i] = (const float*)tab_ld(i);
    F.out = (float*)tab_ld(23); F.ws = (unsigned char*)tab_ld(24); F.ctl = (unsigned*)(F.ws + WS_CTL);
    return F;
}
__device__ __forceinline__ void grid_barrier() {
    const Frame F = make_frame();
    XcdBarrier b; b.bar = F.ctl + CW_BAR; b.x = xb_xcc_id(); b.st = (volatile LAS unsigned*)((LAS unsigned char*)g_lds + MISC_OFF) + 8;
    xcd_barrier(b);
}

__device__ __forceinline__ void transpose_item(const float* W, int K, int N, bf16* WT, int mode, LAS float* scr, int item, int lane) {
    const int nblk = N / 32, kb = item / nblk, nb = item % nblk, k0 = 64 * kb, n0 = 32 * nb;
#pragma unroll 8
    for (int i = 0; i < 32; ++i) { const int kk = 2 * i + (lane >> 5); scr[kk * 33 + (lane & 31)] = W[(size_t)(k0 + kk) * N + n0 + (lane & 31)]; }
    LDS_WAIT(); asm volatile("" ::: "memory");
    const int c = lane & 7;
#pragma unroll
    for (int j = 0; j < 4; ++j) { const int n = (lane >> 3) + 8 * j; const LAS float* s = scr + (8 * c) * 33 + n;
        v4u o; o.x = pk2(s[0 * 33], s[1 * 33]); o.y = pk2(s[2 * 33], s[3 * 33]); o.z = pk2(s[4 * 33], s[5 * 33]); o.w = pk2(s[6 * 33], s[7 * 33]);
        const int nn = n0 + n; int dr = nn;
        if (mode) dr = 256 * (nn >> 7) + 128 * ((nn >> 2) & 1) + 32 * ((nn >> 5) & 3) + 16 * (mode - 1) + 4 * ((nn >> 3) & 3) + (nn & 3);
        *(GAS v4u*)(WT + (size_t)dr * K + k0 + 8 * c) = o; }
    LDS_WAIT(); asm volatile("" ::: "memory");
}

__device__ __forceinline__ void phase_wconv(Frame& F, int l) {
    LAS float* scr = (LAS float*)(F.lds + F.wave * 16384);
    const int gw = F.vcu * NWAVES + F.wave, NGW = F.G * NWAVES;
    constexpr int I_IN = 16 * 96, I_OUT = 16 * 32, I_POOL = 4 * 8, I_R = 16 * 2, I_1 = 65 * 128, I_2 = 65 * 128;
    constexpr int NITEMS = I_IN + I_OUT + I_POOL + I_R + 2 * I_1 + I_2;
    unsigned char* ws = F.ws;
    for (int it = gw; it < NITEMS; it += NGW) {
        int r = it;
        if (r < I_IN) { transpose_item(F.in[8] + (size_t)l * DM * INC, DM, INC, (bf16*)(ws + WS_WIN), 0, scr, r, F.lane); continue; } r -= I_IN;
        if (r < I_OUT) { transpose_item(F.in[13] + (size_t)l * DM * DM, DM, DM, (bf16*)(ws + WS_WOUT), 0, scr, r, F.lane); continue; } r -= I_OUT;
        if (r < I_POOL) { const int g = r / 8; transpose_item(F.in[11] + (size_t)(l * 4 + g) * 128 * 128, 128, 128, (bf16*)(ws + WS_WPOOL) + g * 128 * 128, 0, scr, r % 8, F.lane); continue; } r -= I_POOL;
        if (r < I_R) { transpose_item(F.in[14] + (size_t)l * DM * NE, DM, NE, (bf16*)(ws + WS_WR), 0, scr, r, F.lane); continue; } r -= I_R;
        if (r < 2 * I_1) { const int mat = r / I_1; r -= mat * I_1; const int e = r / 128, ii = r % 128;
            const float* src = (e < 64) ? F.in[mat ? 17 : 16] + ((size_t)l * 64 + e) * DM * 256 : F.in[mat ? 20 : 19] + (size_t)l * DM * 256;
            transpose_item(src, DM, 256, (bf16*)(ws + WS_W13) + (size_t)e * 512 * DM, 1 + mat, scr, ii, F.lane); continue; } r -= 2 * I_1;
        { const int e = r / 128, ii = r % 128;
            const float* src = (e < 64) ? F.in[18] + ((size_t)l * 64 + e) * 256 * DM : F.in[21] + (size_t)l * 256 * DM;
            transpose_item(src, 256, DM, (bf16*)(ws + WS_W2) + (size_t)e * DM * 256, 0, scr, ii, F.lane); }
    }
}

__device__ __forceinline__ void phase_mod(Frame& F) {
    LAS float* sil = (LAS float*)(F.lds + 65536);
    LAS float* part = (LAS float*)(F.lds + 65536 + 36864);
    for (int i = F.tid; i < 9 * 1024; i += 512) { const int r = i >> 10, k = i & 1023; const float v = (r < 8) ? F.in[1][r * 1024 + k] : F.in[3][k]; sil[i] = v * sigmoidf_(v); }
    __syncthreads();
    float* mod = (float*)(F.ws + WS_MOD);
    for (int it = F.vcu; it < 2 * 96; it += F.G) {
        const int l = it / 96, n0 = (it % 96) * 64;
        const float* wa = F.in[6] + (size_t)l * DM * 6144 + n0 + F.lane;
        float acc[9];
#pragma unroll
        for (int r = 0; r < 9; ++r) acc[r] = 0.f;
        const int kb = F.wave * 128;
#pragma unroll 4
        for (int k = 0; k < 128; ++k) { const float w = wa[(size_t)(kb + k) * 6144];
#pragma unroll
            for (int r = 0; r < 9; ++r) acc[r] += sil[r * 1024 + kb + k] * w; }
#pragma unroll
        for (int r = 0; r < 9; ++r) part[(F.wave * 9 + r) * 64 + F.lane] = acc[r];
        __syncthreads();
        for (int i = F.tid; i < 9 * 64; i += 512) { const int r = i >> 6, c = i & 63; float s = 0.f;
#pragma unroll
            for (int w = 0; w < 8; ++w) s += part[(w * 9 + r) * 64 + c];
            mod[((size_t)l * 9 + r) * 6144 + n0 + c] = s + F.in[7][(size_t)l * 6144 + n0 + c]; }
        __syncthreads();
    }
}

__device__ __forceinline__ const float* resid_in_row(Frame& F, int l, int row) {
    if (l == 0) return row < NC ? F.in[2] + (size_t)row * DM : F.in[0] + (size_t)(row - NC) * DM;
    return row < NC ? (const float*)(F.ws + WS_CTXRES) + (size_t)row * DM : F.out + (size_t)(row - NC) * DM;
}
__device__ __forceinline__ float* resid_row(Frame& F, int row) { return row < NC ? (float*)(F.ws + WS_CTXRES) + (size_t)row * DM : F.out + (size_t)(row - NC) * DM; }
__device__ __forceinline__ int mod_row(int row) { return row < NC ? 8 : ((row - NC) >> 12); }

__device__ __forceinline__ void norm_mod_row(Frame& F, const float* xrow, const float* nw, const float* sh, const float* sc, bf16* orow, LAS bf16* lrow) {
    const GAS f32x4* xr = (const GAS f32x4*)xrow + F.lane;
    f32x4 v[4]; float s = 0.f;
#pragma unroll
    for (int j = 0; j < 4; ++j) { v[j] = xr[64 * j]; s += (v[j].x * v[j].x + v[j].y * v[j].y) + (v[j].z * v[j].z + v[j].w * v[j].w); }
    const float r = 1.0f / sqrtf(wave_sum(s, F.lane) * (1.f / DM) + EPSN);
#pragma unroll
    for (int j = 0; j < 4; ++j) {
        const f32x4 w4 = ((const GAS f32x4*)nw)[F.lane + 64 * j], s4 = ((const GAS f32x4*)sc)[F.lane + 64 * j], h4 = ((const GAS f32x4*)sh)[F.lane + 64 * j];
        const f32x4 o = (v[j] * r) * w4 * (s4 + 1.0f) + h4;
        const unsigned long long pk = (unsigned long long)pk2(o.x, o.y) | ((unsigned long long)pk2(o.z, o.w) << 32);
        ((GAS unsigned long long*)orow)[F.lane + 64 * j] = pk;
        if (lrow) *(LAS unsigned long long*)(lrow + 4 * (F.lane + 64 * j)) = pk;
    }
}

__device__ __forceinline__ void phase_hx(Frame& F, int l) {
    const int gw = F.vcu * NWAVES + F.wave, NGW = F.G * NWAVES;
    const float* mod = (const float*)(F.ws + WS_MOD) + (size_t)l * 9 * 6144;
    bf16* HX = (bf16*)(F.ws + WS_HX);
    for (int row = gw; row < NTOK; row += NGW) { const float* md = mod + mod_row(row) * 6144;
        norm_mod_row(F, resid_in_row(F, l, row), F.in[4] + l * DM, md, md + 1024, HX + (size_t)row * DM, nullptr); }
}

__device__ __forceinline__ void gates16(const bf16* zp, float lb, float (&g)[16], float (&kk)[16]) {
    const float lbf = fmaxf(lb, 1e-30f), oml = 1.0f - lb;
#pragma unroll
    for (int j = 0; j < 16; ++j) { const float z = bf2f(zp[(size_t)j * INC]); const float sg = sigmoidf_(z); g[j] = __logf(lbf + oml * sg); kk[j] = oml * (1.0f - sg); }
}
__device__ __forceinline__ float lb_of(Frame& F, int l, int dir, int hch) {
    if (l == 0) return 0.f;
    const float a0 = F.in[9][dir * HW + hch], a1 = F.in[9][2 * HW + dir * HW + hch];
    return 1.0f / (1.0f + __expf(a0 - a1));
}
__device__ __forceinline__ int chunk_row0(int b, int dir, int c) {
    if (c < 4) { const int tc = dir ? 3 - c : c; return b * CTXL + tc * 64; }
    const int tc = dir ? 63 - (c - 4) : (c - 4); return NC + b * SEQL + tc * 64;
}

template <int KS, int NTILE>
__device__ __forceinline__ void mma_rows16(f32x4 (&acc)[NTILE], const LAS bf16* A, int lda, int arow0, const LAS bf16* Bt, int ldb, int brow0, int lane) {
    const int r = lane & 15, q = lane >> 4;
#pragma unroll
    for (int s = 0; s < KS; ++s) {
        const bf16x8 a = *(const LAS bf16x8*)(A + (arow0 + r) * lda + 32 * s + 8 * q);
#pragma unroll
        for (int i = 0; i < NTILE; ++i) { const bf16x8 b = *(const LAS bf16x8*)(Bt + (brow0 + 16 * i + r) * ldb + 32 * s + 8 * q);
            acc[i] = __builtin_amdgcn_mfma_f32_16x16x32_bf16(b, a, acc[i], 0, 0, 0); }
    }
}

__device__ __forceinline__ void phase_h1(Frame& F, int l) {
    LAS bf16* vT = (LAS bf16*)(F.lds); LAS bf16* keT = (LAS bf16*)(F.lds + 18432); LAS float* tot = (LAS float*)(F.lds + 36864);
    const bf16* PX = (const bf16*)(F.ws + WS_PX); bf16* KV = (bf16*)(F.ws + WS_KV); float* DEC = (float*)(F.ws + WS_DEC);
    const int seg = F.tid >> 7, ch = F.tid & 127;
    for (int it = F.vcu; it < NSEQ * NCH; it += F.G) {
        const int seq = it / NCH, c = it % NCH, dir = seq & 1, h = (seq >> 1) & 3, b = seq >> 3;
        const int row0 = chunk_row0(b, dir, c);
        const bf16* base = PX + (size_t)(row0 + seg * 16) * INC;
        float g[16], kk[16];
        gates16(base + dir * HW + h * 128 + ch, lb_of(F, l, dir, h * 128 + ch), g, kk);
        unsigned short vv[16];
#pragma unroll
        for (int j = 0; j < 16; ++j) vv[j] = base[(size_t)j * INC + 2 * HW + h * 128 + ch];
        if (dir == 0) {
#pragma unroll
            for (int j = 1; j < 16; ++j) g[j] += g[j - 1];
            tot[seg * 128 + ch] = g[15];
        } else {
#pragma unroll
            for (int j = 14; j >= 0; --j) g[j] += g[j + 1];
            tot[seg * 128 + ch] = g[0];
        }
        __syncthreads();
        const float t0 = tot[ch], t1 = tot[128 + ch], t2 = tot[256 + ch], t3 = tot[384 + ch];
        const float btot = (t0 + t1) + (t2 + t3);
        float off;
        if (dir == 0) off = (seg > 0 ? t0 : 0.f) + (seg > 1 ? t1 : 0.f) + (seg > 2 ? t2 : 0.f);
        else off = (seg < 3 ? t3 : 0.f) + (seg < 2 ? t2 : 0.f) + (seg < 1 ? t1 : 0.f);
        unsigned pk[8], pv[8];
#pragma unroll
        for (int j = 0; j < 16; j += 2) {
            const float e0 = kk[j] * __expf(btot - (g[j] + off)), e1 = kk[j + 1] * __expf(btot - (g[j + 1] + off));
            pk[j >> 1] = pk2(e0, e1); pv[j >> 1] = (unsigned)vv[j] | ((unsigned)vv[j + 1] << 16);
        }
        *(LAS v4u*)(keT + ch * 72 + seg * 16) = (v4u){pk[0], pk[1], pk[2], pk[3]}; *(LAS v4u*)(keT + ch * 72 + seg * 16 + 8) = (v4u){pk[4], pk[5], pk[6], pk[7]};
        *(LAS v4u*)(vT + ch * 72 + seg * 16) = (v4u){pv[0], pv[1], pv[2], pv[3]}; *(LAS v4u*)(vT + ch * 72 + seg * 16 + 8) = (v4u){pv[4], pv[5], pv[6], pv[7]};
        if (seg == 0) DEC[(size_t)it * 128 + ch] = __expf(btot);
        __syncthreads();
        f32x4 acc[8]; const float zf = opaque_zero();
#pragma unroll
        for (int i = 0; i < 8; ++i) acc[i] = (f32x4){zf, zf, zf, zf};
        mma_rows16<2, 8>(acc, vT, 72, 16 * F.wave, keT, 72, 0, F.lane);
        bf16* dst = KV + (size_t)it * 16384 + (size_t)(16 * F.wave + (F.lane & 15)) * 128 + 4 * (F.lane >> 4);
#pragma unroll
        for (int i = 0; i < 8; ++i) *(GAS unsigned long long*)(dst + 16 * i) = (unsigned long long)pk2(acc[i].x, acc[i].y) | ((unsigned long long)pk2(acc[i].z, acc[i].w) << 32);
        __syncthreads();
    }
}

__device__ __forceinline__ void phase_h2(Frame& F) {
    bf16* KV = (bf16*)(F.ws + WS_KV); const float* DEC = (const float*)(F.ws + WS_DEC);
    for (int it = F.vcu; it < NSEQ * 4; it += F.G) {
        const int seq = it >> 2, e0 = (it & 3) * 4096 + F.tid * 8, k0 = (F.tid * 8) & 127;
        float S[8];
#pragma unroll
        for (int i = 0; i < 8; ++i) S[i] = 0.f;
        GAS v4u* p = (GAS v4u*)(KV + (size_t)seq * NCH * 16384 + e0);
        const GAS f32x4* d = (const GAS f32x4*)(DEC + (size_t)seq * NCH * 128 + k0);
        v4u kv = p[0]; f32x4 d0 = d[0], d1 = d[1];
        for (int c = 0; c < NCH; ++c) {
            v4u kvn = kv; f32x4 d0n = d0, d1n = d1;
            if (c + 1 < NCH) { kvn = p[(size_t)(c + 1) * 2048]; d0n = d[(c + 1) * 32]; d1n = d[(c + 1) * 32 + 1]; }
            p[(size_t)c * 2048] = (v4u){pk2(S[0], S[1]), pk2(S[2], S[3]), pk2(S[4], S[5]), pk2(S[6], S[7])};
            S[0] = S[0] * d0.x + bf2f((unsigned short)(kv.x & 0xffff)); S[1] = S[1] * d0.y + bf2f((unsigned short)(kv.x >> 16));
            S[2] = S[2] * d0.z + bf2f((unsigned short)(kv.y & 0xffff)); S[3] = S[3] * d0.w + bf2f((unsigned short)(kv.y >> 16));
            S[4] = S[4] * d1.x + bf2f((unsigned short)(kv.z & 0xffff)); S[5] = S[5] * d1.y + bf2f((unsigned short)(kv.z >> 16));
            S[6] = S[6] * d1.z + bf2f((unsigned short)(kv.w & 0xffff)); S[7] = S[7] * d1.w + bf2f((unsigned short)(kv.w >> 16));
            kv = kvn; d0 = d0n; d1 = d1n;
        }
    }
}

__device__ __forceinline__ void phase_h3(Frame& F, int l) {
    LAS bf16* Qt = (LAS bf16*)(F.lds); LAS bf16* Qb = (LAS bf16*)(F.lds + 17408); LAS bf16* Kt = (LAS bf16*)(F.lds + 34816); LAS bf16* St = (LAS bf16*)(F.lds + 52224);
    LAS bf16* vT = (LAS bf16*)(F.lds + 87040); LAS bf16* Pm = (LAS bf16*)(F.lds + 105472); LAS float* tot = (LAS float*)(F.lds + 114688); LAS float* ssq = (LAS float*)(F.lds + 116736);
    LAS float* Pin = (LAS float*)(F.lds + 65536); LAS bf16* Pl = Qt; LAS bf16* Wt = Qb;
    const bf16* PX = (const bf16*)(F.ws + WS_PX); const bf16* KV = (const bf16*)(F.ws + WS_KV); bf16* Y = (bf16*)(F.ws + WS_HX);
    const int seg = F.tid >> 7, ch = F.tid & 127, mt = F.wave >> 1, nh = F.wave & 1, lr = F.lane & 15, lq = F.lane >> 4;
    const int tc_lo = (l == 0) ? 0 : 4, ntc = NCH - tc_lo;
    for (int it = F.vcu; it < ntc * NBATCH * 8; it += F.G) {
        const int j = it & 7, b = (it >> 3) & 7, tc = tc_lo + (it >> 6);
        const int row0 = (tc < 4) ? b * CTXL + tc * 64 : NC + b * SEQL + (tc - 4) * 64;
        f32x4 acc[4]; const float zf = opaque_zero();
#pragma unroll
        for (int i = 0; i < 4; ++i) acc[i] = (f32x4){zf, zf, zf, zf};
        if (j < 4) {
            const int h = j;
            const bf16* base = PX + (size_t)(row0 + seg * 16) * INC;
            float qs[16];
            { unsigned short vv[16];
#pragma unroll
              for (int t = 0; t < 16; ++t) { const float q = bf2f(base[(size_t)t * INC + 3 * HW + h * 128 + ch]); qs[t] = q * sigmoidf_(q) * 0.08838834764831845f; vv[t] = base[(size_t)t * INC + 2 * HW + h * 128 + ch]; }
              unsigned pv[8];
#pragma unroll
              for (int t = 0; t < 16; t += 2) pv[t >> 1] = (unsigned)vv[t] | ((unsigned)vv[t + 1] << 16);
              *(LAS v4u*)(vT + ch * 72 + seg * 16) = (v4u){pv[0], pv[1], pv[2], pv[3]}; *(LAS v4u*)(vT + ch * 72 + seg * 16 + 8) = (v4u){pv[4], pv[5], pv[6], pv[7]}; }
            for (int dir = 0; dir < 2; ++dir) {
                const int seq = (b * 4 + h) * 2 + dir;
                const int c = (tc < 4) ? (dir ? 3 - tc : tc) : (dir ? 71 - tc : tc);
                float g[16], kk[16];
                gates16(base + dir * HW + h * 128 + ch, lb_of(F, l, dir, h * 128 + ch), g, kk);
                if (dir == 0) {
#pragma unroll
                    for (int t = 1; t < 16; ++t) g[t] += g[t - 1];
                    tot[seg * 128 + ch] = g[15];
                } else {
#pragma unroll
                    for (int t = 14; t >= 0; --t) g[t] += g[t + 1];
                    tot[seg * 128 + ch] = g[0];
                }
                { const GAS v4u* sp = (const GAS v4u*)(KV + ((size_t)seq * NCH + c) * 16384);
#pragma unroll
                  for (int i = 0; i < 4; ++i) { const int e = F.tid + 512 * i; const int v = e >> 4, kq = e & 15; *(LAS v4u*)(St + v * 136 + kq * 8) = sp[e]; } }
                __syncthreads();
                const float t0 = tot[ch], t1 = tot[128 + ch], t2 = tot[256 + ch], t3 = tot[384 + ch];
                float off, mref;
                if (dir == 0) { off = (seg > 0 ? t0 : 0.f) + (seg > 1 ? t1 : 0.f) + (seg > 2 ? t2 : 0.f); mref = t0 + t1; }
                else { off = (seg < 3 ? t3 : 0.f) + (seg < 2 ? t2 : 0.f) + (seg < 1 ? t1 : 0.f); mref = t3 + t2; }
#pragma unroll
                for (int t = 0; t < 16; ++t) {
                    const float bt = g[t] + off; const int tok = seg * 16 + t;
                    Qt[tok * 136 + ch] = (bf16)f2bf(qs[t] * __expf(clamp80(bt - mref)));
                    Qb[tok * 136 + ch] = (bf16)f2bf(qs[t] * __expf(fmaxf(bt, -80.f)));
                    Kt[tok * 136 + ch] = (bf16)f2bf(kk[t] * __expf(clamp80(mref - bt)));
                }
                __syncthreads();
                { f32x4 pa[2] = {(f32x4){zf, zf, zf, zf}, (f32x4){zf, zf, zf, zf}};
                  mma_rows16<4, 2>(pa, Qt, 136, 16 * mt, Kt, 136, 32 * nh, F.lane);
                  const int t = 16 * mt + lr;
#pragma unroll
                  for (int i = 0; i < 2; ++i) { const int s0 = 32 * nh + 16 * i + 4 * lq; float p[4];
#pragma unroll
                      for (int u = 0; u < 4; ++u) { const int s = s0 + u; const bool keep = dir ? (s >= t) : (s <= t); p[u] = keep ? pa[i][u] : 0.f; }
                      *(LAS unsigned long long*)(Pm + t * 72 + s0) = (unsigned long long)pk2(p[0], p[1]) | ((unsigned long long)pk2(p[2], p[3]) << 32); } }
                __syncthreads();
                mma_rows16<4, 4>(acc, Qb, 136, 16 * mt, St, 136, 64 * nh, F.lane);
                mma_rows16<2, 4>(acc, Pm, 72, 16 * mt, vT, 72, 64 * nh, F.lane);
                __syncthreads();
            }
            float s = 0.f;
#pragma unroll
            for (int i = 0; i < 4; ++i) s += (acc[i].x * acc[i].x + acc[i].y * acc[i].y) + (acc[i].z * acc[i].z + acc[i].w * acc[i].w);
            s += shx(s, 16, F.lane); s += shx(s, 32, F.lane);
            if (lq == 0) ssq[(16 * mt + lr) * 2 + nh] = s;
            __syncthreads();
            const int t = 16 * mt + lr;
            const float rn = 1.0f / sqrtf((ssq[t * 2] + ssq[t * 2 + 1]) * (1.f / 128.f) + EPSN);
            const bf16* ogp = PX + (size_t)(row0 + t) * INC + 4 * HW + h * 128 + 64 * nh + 4 * lq;
            const float* gw = F.in[10] + l * 128 + 64 * nh + 4 * lq;
            bf16* yp = Y + (size_t)(row0 + t) * DM + h * 128 + 64 * nh + 4 * lq;
#pragma unroll
            for (int i = 0; i < 4; ++i) { const unsigned long long ob = *(const GAS unsigned long long*)(ogp + 16 * i); const f32x4 w4 = *(const GAS f32x4*)(gw + 16 * i);
                const float o0 = bf2f((unsigned short)(ob & 0xffff)), o1 = bf2f((unsigned short)((ob >> 16) & 0xffff)), o2 = bf2f((unsigned short)((ob >> 32) & 0xffff)), o3 = bf2f((unsigned short)(ob >> 48));
                const float y0 = acc[i].x * rn * w4.x * (o0 * sigmoidf_(o0)), y1 = acc[i].y * rn * w4.y * (o1 * sigmoidf_(o1)), y2 = acc[i].z * rn * w4.z * (o2 * sigmoidf_(o2)), y3 = acc[i].w * rn * w4.w * (o3 * sigmoidf_(o3));
                *(GAS unsigned long long*)(yp + 16 * i) = (unsigned long long)pk2(y0, y1) | ((unsigned long long)pk2(y2, y3) << 32); }
            __syncthreads();
        } else {
            const int gi = j - 4, wdw = 2 << gi, hw2 = wdw >> 1;
            const int lo_b = (tc < 4) ? -tc * 64 : 0, hi_b = (tc < 4) ? (4 - tc) * 64 : 64;
            for (int e = F.tid; e < 80 * 128; e += 512) { const int r = (e >> 7) - 8, cc = e & 127;
                Pin[e] = (r >= lo_b && r < hi_b) ? bf2f(PX[(size_t)(row0 + r) * INC + 5 * HW + gi * 128 + cc]) : 0.f; }
            { const GAS v4u* wp = (const GAS v4u*)((const bf16*)(F.ws + WS_WPOOL) + gi * 128 * 128);
#pragma unroll
              for (int i = 0; i < 4; ++i) { const int e = F.tid + 512 * i; const int d = e >> 4, kq = e & 15; *(LAS v4u*)(Wt + d * 136 + kq * 8) = wp[e]; } }
            __syncthreads();
#pragma unroll 4
            for (int t = 0; t < 16; ++t) { const int i = seg * 16 + t; int lo = i - hw2, hi = i + hw2; lo = lo < lo_b ? lo_b : lo; hi = hi > hi_b ? hi_b : hi;
                float sm = 0.f; for (int r = lo; r < hi; ++r) sm += Pin[(r + 8) * 128 + ch];
                Pl[i * 136 + ch] = (bf16)f2bf(sm / (float)(hi - lo) - Pin[(i + 8) * 128 + ch]); }
            __syncthreads();
            mma_rows16<4, 4>(acc, Pl, 136, 16 * mt, Wt, 136, 64 * nh, F.lane);
            const int t = 16 * mt + lr;
            const float* ps = F.in[12] + l * HW + gi * 128 + 64 * nh + 4 * lq;
            bf16* yp = Y + (size_t)(row0 + t) * DM + HW + gi * 128 + 64 * nh + 4 * lq;
#pragma unroll
            for (int i = 0; i < 4; ++i) { const f32x4 w4 = *(const GAS f32x4*)(ps + 16 * i);
                *(GAS unsigned long long*)(yp + 16 * i) = (unsigned long long)pk2(acc[i].x * w4.x, acc[i].y * w4.y) | ((unsigned long long)pk2(acc[i].z * w4.z, acc[i].w * w4.w) << 32); }
            __syncthreads();
        }
    }
}

__device__ __forceinline__ int moe_row_base(int l) { return l == 0 ? 0 : NC; }
__device__ __forceinline__ int moe_half_rows(int l) { return l == 0 ? NTOK / 2 : NX / 2; }

__device__ __forceinline__ void phase_route(Frame& F, int l) {
    LAS bf16* Xt = (LAS bf16*)(F.lds);
    LAS float* Lg = (LAS float*)(F.lds + 32 * 2064);
    LAS unsigned* lcnt = (LAS unsigned*)(F.lds + 32 * 2064 + 8192);
    const float* mod = (const float*)(F.ws + WS_MOD) + (size_t)l * 9 * 6144;
    bf16* HX = (bf16*)(F.ws + WS_HX); const bf16* WrT = (const bf16*)(F.ws + WS_WR);
    int* IDX = (int*)(F.ws + RT_IDX); float* GATE = (float*)(F.ws + RT_GATE);
    const int rb = moe_row_base(l), nhalf = moe_half_rows(l), ntiles = 2 * nhalf / 32;
    const int lr = F.lane & 15, lq = F.lane >> 4;
    if (F.tid < 128) lcnt[F.tid] = 0u;
    if (F.vcu == 0) { for (int i = F.tid; i < DM / 8; i += 512) ((GAS v4u*)(HX + (size_t)NTOK * DM))[i] = (v4u){0u, 0u, 0u, 0u}; }
    __syncthreads();
    const float rbias = F.in[15][l * NE + F.lane];
    for (int it = F.vcu; it < ntiles; it += F.G) {
        const int row0 = rb + it * 32;
#pragma unroll
        for (int i = 0; i < 4; ++i) { const int lrow = F.wave * 4 + i, row = row0 + lrow; const float* md = mod + mod_row(row) * 6144;
            norm_mod_row(F, resid_row(F, row), F.in[5] + l * DM, md + 3072, md + 4096, HX + (size_t)row * DM, Xt + lrow * 1032); }
        __syncthreads();
        { const int mt = F.wave >> 2, nt = F.wave & 3; const float zf = opaque_zero(); f32x4 a4 = (f32x4){zf, zf, zf, zf};
          const bf16* wp = WrT + (size_t)(16 * nt + lr) * DM + 8 * lq;
#pragma unroll 8
          for (int s = 0; s < 32; ++s) { const bf16x8 a = *(const LAS bf16x8*)(Xt + (16 * mt + lr) * 1032 + 32 * s + 8 * lq); const bf16x8 bb = *(const GAS bf16x8*)(wp + 32 * s);
              a4 = __builtin_amdgcn_mfma_f32_16x16x32_bf16(bb, a, a4, 0, 0, 0); }
          *(LAS f32x4*)(Lg + (16 * mt + lr) * 64 + 16 * nt + 4 * lq) = a4; }
        __syncthreads();
#pragma unroll 1
        for (int i = 0; i < 4; ++i) {
            const int lrow = F.wave * 4 + i, row = row0 + lrow;
            const float sc = sigmoidf_(Lg[lrow * 64 + F.lane]); const float bs = sc + rbias;
            float m1 = bs; m1 = fmaxf(m1, shx(m1, 1, F.lane)); m1 = fmaxf(m1, shx(m1, 2, F.lane)); m1 = fmaxf(m1, shx(m1, 4, F.lane));
            const unsigned long long bal = __ballot(bs == m1); const int gb = F.lane & ~7; const unsigned gm = (unsigned)((bal >> gb) & 0xffull);
            const int first = gb + __ffs((int)gm) - 1;
            float m2 = (F.lane == first) ? -3.0e38f : bs; m2 = fmaxf(m2, shx(m2, 1, F.lane)); m2 = fmaxf(m2, shx(m2, 2, F.lane)); m2 = fmaxf(m2, shx(m2, 4, F.lane));
            const float gs = m1 + m2; const int myg = F.lane >> 3; int rank = 0;
#pragma unroll
            for (int g2 = 0; g2 < 8; ++g2) { const float og = shl(gs, g2 * 8); rank += ((og > gs) || (og == gs && g2 < myg)) ? 1 : 0; }
            float msk = (rank < 4) ? bs : -1.0e4f;
            int wi[6]; float ws[6]; float ssum = 0.f; bool sel = false;
#pragma unroll
            for (int jj = 0; jj < 6; ++jj) { const float mx = wave_max(msk, F.lane); const unsigned long long b2 = __ballot(msk == mx); const int win = __ffsll((long long)b2) - 1;
                wi[jj] = win; ws[jj] = shl(sc, win); ssum += ws[jj]; if (F.lane == win) { msk = -3.0e38f; sel = true; } }
            const float inv = 2.5f / ssum;
            int myi = wi[0]; float myg2 = ws[0];
#pragma unroll
            for (int jj = 1; jj < 6; ++jj) { if (F.lane == jj) { myi = wi[jj]; myg2 = ws[jj]; } }
            if (F.lane < 6) { IDX[(size_t)row * 6 + F.lane] = myi; GATE[(size_t)row * 6 + F.lane] = myg2 * inv; }
            const int half = (row - rb) >= nhalf ? 1 : 0;
            if (sel) __hip_atomic_fetch_add(&lcnt[half * 64 + F.lane], 1u, __ATOMIC_RELAXED, __HIP_MEMORY_SCOPE_WORKGROUP);
        }
        __syncthreads();
    }
    __syncthreads();
    if (F.tid < 128) { const unsigned v = lcnt[F.tid]; if (v) atomicAdd(F.ctl + CW_CNT + l * 128 + F.tid, v); }
}

__device__ __forceinline__ void phase_slots(Frame& F, int l) {
    LAS int* pstart = (LAS int*)(F.lds);
    LAS int* cntl = (LAS int*)(F.lds + 1024);
    LAS unsigned* lc = (LAS unsigned*)(F.lds + 2048);
    LAS unsigned* lbase = (LAS unsigned*)(F.lds + 2560);
    const int rb = moe_row_base(l), nhalf = moe_half_rows(l);
    const int* IDX = (const int*)(F.ws + RT_IDX); int* TSLOT = (int*)(F.ws + RT_TSLOT); int* STOK = (int*)(F.ws + RT_STOK); int* BLKE = (int*)(F.ws + RT_BLKE); int* MISC = (int*)(F.ws + RT_MISC);
    if (F.tid < 128) cntl[F.tid] = (int)__hip_atomic_load(F.ctl + CW_CNT + l * 128 + F.tid, __ATOMIC_RELAXED, __HIP_MEMORY_SCOPE_AGENT);
    __syncthreads();
    if (F.tid < 2) { int s = 0; for (int e = 0; e < 64; ++e) { pstart[F.tid * 66 + e] = s; s += (cntl[F.tid * 64 + e] + 255) & ~255; } pstart[F.tid * 66 + 64] = s; pstart[F.tid * 66 + 65] = s + nhalf; }
    __syncthreads();
    for (int w = F.vcu; w < 2 * 65; w += F.G) {
        const int half = w / 65, e = w % 65; int* stok = STOK + half * MAXSLOT; int* blke = BLKE + half * MAXBLK;
        const int ps = pstart[half * 66 + e], pe = pstart[half * 66 + e + 1];
        for (int b = ps / 256 + F.tid; b < pe / 256; b += 512) blke[b] = e;
        if (e < 64) { for (int s = ps + cntl[half * 64 + e] + F.tid; s < pe; s += 512) stok[s] = NTOK; }
        else { for (int i = F.tid; i < nhalf; i += 512) stok[ps + i] = rb + half * nhalf + i;
               if (F.tid == 0) { MISC[half] = pe / 256; MISC[2 + half] = ps; } }
    }
    const int tpc = 2 * nhalf / 256;
    for (int ck = F.vcu; ck < 256; ck += F.G) {
        const int half = ck >> 7, tok0 = rb + ck * tpc; int* stok = STOK + half * MAXSLOT;
        if (F.tid < 64) lc[F.tid] = 0u;
        __syncthreads();
        int e0 = -1, e1 = -1; unsigned p0 = 0, p1 = 0; const int a0 = F.tid, a1 = F.tid + 512;
        if (a0 < tpc * 6) { e0 = IDX[(size_t)tok0 * 6 + a0]; p0 = __hip_atomic_fetch_add(&lc[e0], 1u, __ATOMIC_RELAXED, __HIP_MEMORY_SCOPE_WORKGROUP); }
        if (a1 < tpc * 6) { e1 = IDX[(size_t)tok0 * 6 + a1]; p1 = __hip_atomic_fetch_add(&lc[e1], 1u, __ATOMIC_RELAXED, __HIP_MEMORY_SCOPE_WORKGROUP); }
        __syncthreads();
        if (F.tid < 64) { const unsigned n = lc[F.tid]; lbase[F.tid] = n ? atomicAdd(F.ctl + CW_CUR + l * 128 + half * 64 + F.tid, n) : 0u; }
        __syncthreads();
        if (e0 >= 0) { const int slot = pstart[half * 66 + e0] + (int)(lbase[e0] + p0); stok[slot] = tok0 + a0 / 6; TSLOT[(size_t)tok0 * 6 + a0] = slot; }
        if (e1 >= 0) { const int slot = pstart[half * 66 + e1] + (int)(lbase[e1] + p1); stok[slot] = tok0 + a1 / 6; TSLOT[(size_t)tok0 * 6 + a1] = slot; }
        __syncthreads();
    }
}

__device__ __forceinline__ void phase_combine(Frame& F, int l, int half) {
    const int gw = F.vcu * NWAVES + F.wave, NGW = F.G * NWAVES;
    const int rb = moe_row_base(l), nhalf = moe_half_rows(l);
    const float* mod = (const float*)(F.ws + WS_MOD) + (size_t)l * 9 * 6144;
    const int* TSLOT = (const int*)(F.ws + RT_TSLOT); const float* GATE = (const float*)(F.ws + RT_GATE); const int* MISC = (const int*)(F.ws + RT_MISC);
    const bf16* YS = (const bf16*)(F.ws + WS_YS);
    const int shs = MISC[2 + half];
    for (int i = gw; i < nhalf; i += NGW) {
        const int row = rb + half * nhalf + i;
        float* xr = resid_row(F, row); const float* gt = mod + mod_row(row) * 6144 + 5120;
        int sl[7]; float gj[7];
#pragma unroll
        for (int j = 0; j < 6; ++j) { sl[j] = TSLOT[(size_t)row * 6 + j]; gj[j] = GATE[(size_t)row * 6 + j]; }
        sl[6] = shs + i; gj[6] = 1.0f;
        f32x4 y[4]; const float zf = opaque_zero();
#pragma unroll
        for (int q = 0; q < 4; ++q) y[q] = (f32x4){zf, zf, zf, zf};
#pragma unroll
        for (int j = 0; j < 7; ++j) { const GAS unsigned long long* yp = (const GAS unsigned long long*)(YS + (size_t)sl[j] * DM);
#pragma unroll
            for (int q = 0; q < 4; ++q) { const unsigned long long v = yp[F.lane + 64 * q];
                y[q].x += gj[j] * bf2f((unsigned short)(v & 0xffff)); y[q].y += gj[j] * bf2f((unsigned short)((v >> 16) & 0xffff));
                y[q].z += gj[j] * bf2f((unsigned short)((v >> 32) & 0xffff)); y[q].w += gj[j] * bf2f((unsigned short)(v >> 48)); } }
        f32x4 xv[4]; float ss = 0.f;
#pragma unroll
        for (int q = 0; q < 4; ++q) { const f32x4 g4 = ((const GAS f32x4*)gt)[F.lane + 64 * q]; xv[q] = ((const GAS f32x4*)xr)[F.lane + 64 * q] + g4 * y[q];
            ss += (xv[q].x * xv[q].x + xv[q].y * xv[q].y) + (xv[q].z * xv[q].z + xv[q].w * xv[q].w); }
        if (l == 1) { const float r = 1.0f / sqrtf(wave_sum(ss, F.lane) * (1.f / DM) + EPSN);
#pragma unroll
            for (int q = 0; q < 4; ++q) { const f32x4 w4 = ((const GAS f32x4*)F.in[22])[F.lane + 64 * q]; ((GAS f32x4*)xr)[F.lane + 64 * q] = xv[q] * r * w4; } }
        else {
#pragma unroll
            for (int q = 0; q < 4; ++q) ((GAS f32x4*)xr)[F.lane + 64 * q] = xv[q]; }
    }
}

constexpr int PH_PER_LAYER = 14, N_PHASES = 1 + 2 * PH_PER_LAYER;
#ifndef MK_PER_PHASE
#define MK_PER_PHASE 0
#endif
struct Args { const float* in[23]; float* out; unsigned char* ws; int ph_lo, ph_hi; };
__global__ void __launch_bounds__(NWAVES * 64, 2) mk_fwd(Args args) {
    {
        LAS unsigned char* lds = (LAS unsigned char*)g_lds;
        for (int u = threadIdx.x; u < (LDS_BYTES - LDSCTL_OFF) / 4; u += NWAVES * 64) ((LAS unsigned*)(lds + LDSCTL_OFF))[u] = 0u;
        __syncthreads();
        LAS unsigned long long* tab = (LAS unsigned long long*)(lds + TAB_OFF);
        if (threadIdx.x < 23) tab[threadIdx.x] = (unsigned long long)args.in[threadIdx.x];
        if (threadIdx.x == 23) tab[23] = (unsigned long long)args.out;
        if (threadIdx.x == 24) tab[24] = (unsigned long long)args.ws;
        __syncthreads();
#if !MK_PER_PHASE
        if (threadIdx.x == 0) (void)xb_add((unsigned*)(args.ws + WS_CTL) + CW_BAR + XB_XCNT(xb_xcc_id()), 1u);
#endif
    }
#if MK_PER_PHASE
    const int lo = args.ph_lo, hi = args.ph_hi;
#define IN(k) (lo <= (k) && (k) < hi)
#define SEAM(k) do { } while (0)
#else
#define IN(k) true
#define SEAM(k) grid_barrier()
#endif
#ifndef PH_MASK
#define PH_MASK 0xffffffffu
#endif
#define INM(k, c) (IN(k) && ((PH_MASK >> (c)) & 1u))
    if (INM(0, 0)) { Frame F = make_frame(); phase_mod(F); __syncthreads(); phase_wconv(F, 0); }
    SEAM(0);
#pragma unroll 1
    for (int l = 0; l < 2; ++l) {
        const int P = 1 + l * PH_PER_LAYER; (void)P;
        if (INM(P + 0, 1)) { Frame F = make_frame(); phase_hx(F, l); }
        SEAM(P + 0);
        if (INM(P + 1, 2)) {
            Frame F = make_frame(); unsigned char* ws = F.ws;
            pg8::Gemm g{(const bf16*)(ws + WS_HX), (const bf16*)(ws + WS_WIN), DM, nullptr}; pg8::StaticOrder S; S.init(NTOK, INC, F.G, (int)blockIdx.x);
            pg8::EpiB16 E{(bf16*)(ws + WS_PX), INC, 0xffff};
            pg8::gemm_phase<pg8::EpiB16, pg8::StaticOrder, true, false>(F.lds, g, S, E);
        }
        SEAM(P + 1);
        if (INM(P + 2, 3)) { Frame F = make_frame(); phase_h1(F, l); }
        SEAM(P + 2);
        if (INM(P + 3, 4)) { Frame F = make_frame(); phase_h2(F); }
        SEAM(P + 3);
        if (INM(P + 4, 5)) { Frame F = make_frame(); phase_h3(F, l); }
        SEAM(P + 4);
        if (INM(P + 5, 6)) {
            Frame F = make_frame(); unsigned char* ws = F.ws;
            const int rbase = l == 0 ? 0 : NC;
            pg8::Gemm g{(const bf16*)(ws + WS_HX) + (size_t)rbase * DM, (const bf16*)(ws + WS_WOUT), DM, nullptr}; pg8::StaticOrder S; S.init(NTOK - rbase, DM, F.G, (int)blockIdx.x);
            pg8::EpiRes E{l == 0 ? F.in[2] : (const float*)(ws + WS_CTXRES), l == 0 ? F.in[0] : (const float*)F.out, (float*)(ws + WS_CTXRES), F.out, (const float*)(ws + WS_MOD) + (size_t)l * 9 * 6144, 2048, rbase};
            pg8::gemm_phase<pg8::EpiRes, pg8::StaticOrder, true, false>(F.lds, g, S, E);
        }
        SEAM(P + 5);
        if (INM(P + 6, 7)) { Frame F = make_frame(); phase_route(F, l); }
        SEAM(P + 6);
        if (INM(P + 7, 8)) { Frame F = make_frame(); phase_slots(F, l); }
        SEAM(P + 7);
#pragma unroll 1
        for (int half = 0; half < 2; ++half) {
            const int Q = P + 8 + 3 * half; (void)Q;
            if (INM(Q + 0, 9)) {
                Frame F = make_frame(); unsigned char* ws = F.ws;
                const int* blke = (const int*)(ws + RT_BLKE) + half * MAXBLK; const int* stok = (const int*)(ws + RT_STOK) + half * MAXSLOT;
                const int nblk = __builtin_amdgcn_readfirstlane(((const int*)(ws + RT_MISC))[half]);
                pg8::Gemm g{(const bf16*)(ws + WS_HX), (const bf16*)(ws + WS_W13), DM, stok}; pg8::MoeOrder S{blke, nblk, 2, F.G, F.vcu};
                pg8::EpiSwiglu E{(bf16*)(ws + WS_HS)};
                pg8::gemm_phase<pg8::EpiSwiglu, pg8::MoeOrder, true, true>(F.lds, g, S, E);
            }
            SEAM(Q + 0);
            if (INM(Q + 1, 10)) {
                Frame F = make_frame(); unsigned char* ws = F.ws;
                const int* blke = (const int*)(ws + RT_BLKE) + half * MAXBLK;
                const int nblk = __builtin_amdgcn_readfirstlane(((const int*)(ws + RT_MISC))[half]);
                int k2 = 256; asm volatile("" : "+s"(k2));
                pg8::Gemm g{(const bf16*)(ws + WS_HS), (const bf16*)(ws + WS_W2), k2, nullptr}; pg8::MoeOrder S{blke, nblk, 4, F.G, F.vcu};
                pg8::EpiB16 E{(bf16*)(ws + WS_YS), DM, 3};
                pg8::gemm_phase<pg8::EpiB16, pg8::MoeOrder, true, false>(F.lds, g, S, E);
            }
            SEAM(Q + 1);
            if (INM(Q + 2, 11)) { Frame F = make_frame(); phase_combine(F, l, half); if (l == 0 && half == 1) phase_wconv(F, 1); }
            if (!(l == 1 && half == 1)) SEAM(Q + 2);
        }
    }
#undef IN
#undef INM
#undef SEAM
}

extern "C" void kernel_launch(void* const* d_in, const int* in_sizes, int n_in, void* d_out, int out_size, void* d_ws, size_t ws_size, hipStream_t stream) {
    static int grid = 0;
    if (grid == 0) {
        if (n_in != 23 || out_size != NX * DM || ws_size < WS_END) { fprintf(stderr, "kernel_launch: unexpected shapes (n_in %d, out %d, ws %zu); nothing launched\n", n_in, out_size, ws_size); grid = -1; return; }
        int dev = 0, cus = 0;
        if (hipGetDevice(&dev) != hipSuccess || hipDeviceGetAttribute(&cus, hipDeviceAttributeMultiprocessorCount, dev) != hipSuccess) { grid = -1; return; }
        if (hipFuncSetAttribute((const void*)mk_fwd, hipFuncAttributeMaxDynamicSharedMemorySize, LDS_BYTES) != hipSuccess) { fprintf(stderr, "kernel_launch: hipFuncSetAttribute failed\n"); grid = -1; return; }
        (void)hipGetLastError();
        grid = cus;
    }
    if (grid < 0) return;
    if (hipMemsetAsync((char*)d_ws + WS_CTL, 0, CTL_ZERO_BYTES, stream) != hipSuccess) { fprintf(stderr, "kernel_launch: memset failed\n"); return; }
    Args a{};
    for (int i = 0; i < 23; ++i) a.in[i] = (const float*)d_in[i];
    a.out = (float*)d_out; a.ws = (unsigned char*)d_ws;
#if MK_PER_PHASE
    for (int p = 0; p < N_PHASES; ++p) { a.ph_lo = p; a.ph_hi = p + 1; hipLaunchKernelGGL(mk_fwd, dim3(grid), dim3(NWAVES * 64), LDS_BYTES, stream, a); }
#else
    a.ph_lo = 0; a.ph_hi = N_PHASES;
    hipLaunchKernelGGL(mk_fwd, dim3(grid), dim3(NWAVES * 64), LDS_BYTES, stream, a);
#endif
    const hipError_t le = hipPeekAtLastError();
    if (le != hipSuccess) fprintf(stderr, "kernel_launch: launch failed: %s\n", hipGetErrorName(le));
}
```

```cpp
#include <hip/hip_runtime.h>
#include <cstdio>
#include <cstdint>
namespace pg8 {
#define PG8_LAS __attribute__((address_space(3)))
typedef unsigned short bf16_t;
typedef short bf16x8 __attribute__((ext_vector_type(8)));
typedef float f32x4 __attribute__((ext_vector_type(4)));
typedef unsigned u32x4 __attribute__((ext_vector_type(4)));
typedef int v4i_t __attribute__((ext_vector_type(4)));
typedef int v8i_t __attribute__((ext_vector_type(8)));
__device__ __forceinline__ int opaque_tid() { int t = threadIdx.x; asm volatile("" : "+v"(t)); return t; }
constexpr int BM = 256, BK = 64, HALF = 128, HTB = HALF * BK * 2  , STAGE_BYTES = 8 * HTB, NXCD = 8, WGM = 8;

__host__ __device__ __forceinline__ int lds_byte(int r, int c) { const int st = (r >> 4) * 2 + (c >> 5), rr = r & 15, cc = c & 31, ob = rr * 64 + cc * 2; return st * 1024 + (ob ^ (((ob >> 9) & 1) << 5)); }
__host__ __device__ __forceinline__ void stage_rc(int b, int& R, int& C) { const int st = b / 1024, sb = b % 1024, swz = sb ^ (((sb >> 9) & 1) << 5); R = (st >> 1) * 16 + swz / 64; C = (st & 1) * 32 + (swz % 64) / 2; }
__host__ __device__ __forceinline__ int perm32(int rho) { const int n = rho >> 4, i = rho & 15; return 8 * (i >> 2) + 4 * n + (i & 3); }

struct Unit { int pm, pn; };
struct Gemm { const bf16_t* A; const bf16_t* Bt; int K; const int* rowidx; };

struct StaticOrder {
    int nM, nN, nwg, G, c;
    __host__ __device__ void init(int M, int N, int G_, int c_) { nM = M / BM; nN = N / BM; nwg = nM * nN; G = G_; c = c_; }
    __host__ __device__ bool next(int i, Unit& u) const {
        const long L = (long)i * G + c; if (L >= nwg) return false;
        int wgid = (int)L; { const int q = nwg / NXCD, r = nwg % NXCD, xcd = wgid % NXCD, off = wgid / NXCD; wgid = (xcd < r ? xcd * (q + 1) : r * (q + 1) + (xcd - r) * q) + off; }
        const int nig = WGM * nN, gid = wgid / nig, fm = gid * WGM, gsz = (nM - fm) < WGM ? (nM - fm) : WGM;
        u.pm = fm + ((wgid % nig) % gsz); u.pn = (wgid % nig) / gsz; return true;
    }
};
struct MoeOrder {
    const int* blk_e; int nblk, NT, G, c;
    __device__ __forceinline__ bool next(int i, Unit& u) const {
        const long L = (long)i * G + c; if (L >= (long)nblk * NT) return false;
        const int blk = (int)(L / NT), pnl = (int)(L % NT); const int e = __builtin_amdgcn_readfirstlane(blk_e[blk]);
        u.pm = blk; u.pn = e * NT + pnl; return true;
    }
};

typedef __bf16 bf16v2_t __attribute__((ext_vector_type(2)));
typedef float f32v2_t __attribute__((ext_vector_type(2)));
__device__ __forceinline__ unsigned cvt_pk_bf16(float lo, float hi) { const f32v2_t v = {lo, hi}; return __builtin_bit_cast(unsigned, __builtin_convertvector(v, bf16v2_t)); }

#ifndef DEG_PX
#define DEG_PX 0
#endif
struct EpiB16 {
    static constexpr bool PERM = true;
    bf16_t* O; int ldc; int pn_mask; int dry = 0;
    __device__ __forceinline__ void operator()(const f32x4 (&acc)[2][2][4][2], const Unit& u, int wr, int wc, int fr, int fq) const {
        const int row0 = u.pm * BM + wr * 64 + fr; const int col0 = (u.pn & pn_mask) * BM + wc * 32 + 8 * fq;
#pragma unroll
        for (int ai = 0; ai < 2; ++ai)
#pragma unroll
            for (int m = 0; m < 4; ++m) { bf16_t* rowp = O + (size_t)(row0 + ai * HALF + m * 16) * ldc + col0;
#pragma unroll
                for (int bj = 0; bj < 2; ++bj) { const f32x4 v0 = acc[ai][bj][m][0], v1 = acc[ai][bj][m][1];
                    u32x4 w; w.x = cvt_pk_bf16(v0[0], v0[1]); w.y = cvt_pk_bf16(v0[2], v0[3]); w.z = cvt_pk_bf16(v1[0], v1[1]); w.w = cvt_pk_bf16(v1[2], v1[3]);
                    if (DEG_PX && pn_mask == 0xffff) { w.x &= 0xfffcfffcu; w.y &= 0xfffcfffcu; w.z &= 0xfffcfffcu; w.w &= 0xfffcfffcu; }
                    if (dry) asm volatile("" :: "v"(w.x), "v"(w.y), "v"(w.z), "v"(w.w)); else *(u32x4*)(rowp + bj * HALF) = w; } }
    }
};
constexpr float YS_SCALE = 8.0f;
struct EpiF8 {
    static constexpr bool PERM = true;
    unsigned char* O; int pn_mask; int dry = 0;
    __device__ __forceinline__ void operator()(const f32x4 (&acc)[2][2][4][2], const Unit& u, int wr, int wc, int fr, int fq) const {
        const int row0 = u.pm * BM + wr * 64 + fr; const int col0 = (u.pn & pn_mask) * BM + wc * 32 + 8 * fq;
#pragma unroll
        for (int ai = 0; ai < 2; ++ai)
#pragma unroll
            for (int m = 0; m < 4; ++m) { unsigned char* rowp = O + (size_t)(row0 + ai * HALF + m * 16) * 1024 + col0;
#pragma unroll
                for (int bj = 0; bj < 2; ++bj) { const f32x4 v0 = acc[ai][bj][m][0], v1 = acc[ai][bj][m][1];
                    int w0 = 0, w1 = 0;
                    w0 = __builtin_amdgcn_cvt_pk_fp8_f32(v0[0], v0[1], w0, false); w0 = __builtin_amdgcn_cvt_pk_fp8_f32(v0[2], v0[3], w0, true);
                    w1 = __builtin_amdgcn_cvt_pk_fp8_f32(v1[0], v1[1], w1, false); w1 = __builtin_amdgcn_cvt_pk_fp8_f32(v1[2], v1[3], w1, true);
                    const unsigned long long pk = (unsigned long long)(unsigned)w0 | ((unsigned long long)(unsigned)w1 << 32);
                    if (dry) asm volatile("" :: "v"(w0), "v"(w1)); else *(unsigned long long*)(rowp + bj * HALF) = pk; }
                asm volatile("" ::: "memory"); }
    }
};
struct EpiRes {
    static constexpr bool PERM = false;
    const float* base_c; const float* base_x; float* out_c; float* out_x; const float* mod; int gt_off; int row_base;
    __device__ __forceinline__ void operator()(const f32x4 (&acc)[2][2][4][2], const Unit& u, int wr, int wc, int fr, int fq) const {
        const int trow = row_base + u.pm * BM;
        const float* bp; float* op; int mr;
        if (trow < 2048) { mr = 8; bp = base_c + (size_t)trow * 1024; op = out_c + (size_t)trow * 1024; }
        else { mr = (trow - 2048) >> 12; bp = base_x + (size_t)(trow - 2048) * 1024; op = out_x + (size_t)(trow - 2048) * 1024; }
        const float* gate = mod + mr * 6144 + gt_off;
        const int r0 = wr * 64 + fr, col0 = u.pn * BM + wc * 32 + 4 * fq;
        f32x4 gv[2][2];
#pragma unroll
        for (int bj = 0; bj < 2; ++bj)
#pragma unroll
            for (int n = 0; n < 2; ++n) gv[bj][n] = *(const f32x4*)(gate + col0 + bj * HALF + n * 16);
#pragma unroll
        for (int ai = 0; ai < 2; ++ai)
#pragma unroll
            for (int m = 0; m < 4; ++m) { const size_t off = (size_t)(r0 + ai * HALF + m * 16) * 1024 + col0;
#pragma unroll
                for (int bj = 0; bj < 2; ++bj)
#pragma unroll
                    for (int n = 0; n < 2; ++n) { const f32x4 b = *(const f32x4*)(bp + off + bj * HALF + n * 16); *(f32x4*)(op + off + bj * HALF + n * 16) = b + gv[bj][n] * acc[ai][bj][m][n]; }
                asm volatile("" ::: "memory"); }
    }
};
struct EpiSwiglu {
    static constexpr bool PERM = false;
    bf16_t* HS;
    __device__ __forceinline__ void operator()(const f32x4 (&acc)[2][2][4][2], const Unit& u, int wr, int wc, int fr, int fq) const {
        const int row0 = u.pm * BM + wr * 64 + fr, hid0 = (u.pn & 1) * 128 + wc * 32 + fq * 8;
#pragma unroll
        for (int ai = 0; ai < 2; ++ai)
#pragma unroll
            for (int m = 0; m < 4; ++m) {
                float h[8];
#pragma unroll
                for (int bj = 0; bj < 2; ++bj)
#pragma unroll
                    for (int i = 0; i < 4; ++i) { const float a = acc[ai][bj][m][0][i], b = acc[ai][bj][m][1][i]; h[bj * 4 + i] = a * __builtin_amdgcn_rcpf(1.0f + __expf(-a)) * b; }
                u32x4 w; w.x = cvt_pk_bf16(h[0], h[1]); w.y = cvt_pk_bf16(h[2], h[3]); w.z = cvt_pk_bf16(h[4], h[5]); w.w = cvt_pk_bf16(h[6], h[7]);
                *(u32x4*)(HS + (size_t)(row0 + ai * HALF + m * 16) * 256 + hid0) = w; }
    }
};

template <class Epi, class Sched, bool ALIGN_EPI, bool GATHER, bool F8 = false>
__device__ __forceinline__ void gemm_phase(PG8_LAS unsigned char* lds, const Gemm g, const Sched& S, const Epi& E) {
    const int tid = opaque_tid(), wid = __builtin_amdgcn_readfirstlane(tid >> 6), lane = tid & 63, wr = wid >> 2, wc = wid & 3, fr = lane & 15, fq = lane >> 4;
    const int K = g.K, nt = K / BK;
    unsigned voffA[2], voffB[2];
#pragma unroll
    for (int i = 0; i < 2; ++i) { int R, C; stage_rc(tid * 16 + i * 8192, R, C); const int Rb = Epi::PERM ? ((R & ~31) + perm32(R & 31)) : R;
        voffA[i] = (unsigned)(R * K + C) * 2u; voffB[i] = (unsigned)(Rb * K + C) * 2u; }
    const size_t kstep = (size_t)(BK * 2);
    const size_t hstep = (size_t)HALF * K * 2;
    const size_t tstep = 2 * hstep;
    const unsigned ldsw = (unsigned)wid * 1024u;
    const int aoff = lds_byte(wr * 64 + fr, fq * 8), boff = lds_byte(wc * 32 + fr, fq * 8);
#define PG8_SA(b, h) (((b) * 2 + (h)) * HTB)
#define PG8_SB(b, h) ((4 + (b) * 2 + (h)) * HTB)
#define PG8_STAGE(bufoff, gbase, voff) do { _Pragma("unroll") for (int _i = 0; _i < 2; ++_i) \
        __builtin_amdgcn_global_load_lds((const unsigned*)((const char*)(gbase) + (voff)[_i]), (PG8_LAS unsigned*)(lds + (bufoff) + ldsw + _i * 8192), 16, 0, 0); } while (0)
#define PG8_STAGE2(bufoff, gbase, o0, o1) do { \
        __builtin_amdgcn_global_load_lds((const unsigned*)((const char*)(gbase) + (o0)), (PG8_LAS unsigned*)(lds + (bufoff) + ldsw), 16, 0, 0); \
        __builtin_amdgcn_global_load_lds((const unsigned*)((const char*)(gbase) + (o1)), (PG8_LAS unsigned*)(lds + (bufoff) + ldsw + 8192), 16, 0, 0); } while (0)
#define PG8_LD2(p) __builtin_shufflevector(*(const PG8_LAS v4i_t*)(p), *(const PG8_LAS v4i_t*)((p) + 1024), 0, 1, 2, 3, 4, 5, 6, 7)
#define PG8_LDA(dst, b, h) do { _Pragma("unroll") for (int m = 0; m < 4; ++m) dst[m] = PG8_LD2(lds + PG8_SA(b, h) + aoff + m * 2048); } while (0)
#define PG8_LDB(dst, b, h) do { _Pragma("unroll") for (int n = 0; n < 2; ++n) dst[n] = PG8_LD2(lds + PG8_SB(b, h) + boff + n * 2048); } while (0)
#define PG8_HALF(v, k) __builtin_bit_cast(bf16x8, __builtin_shufflevector(v, v, 4 * (k), 4 * (k) + 1, 4 * (k) + 2, 4 * (k) + 3))
#define PG8_MMA(ai, bj, At, Bt) do { __builtin_amdgcn_s_setprio(1); _Pragma("unroll") for (int m = 0; m < 4; ++m) _Pragma("unroll") for (int n = 0; n < 2; ++n) { \
        acc[ai][bj][m][n] = __builtin_amdgcn_mfma_f32_16x16x32_bf16(PG8_HALF(Bt[n], 0), PG8_HALF(At[m], 0), acc[ai][bj][m][n], 0, 0, 0); \
        acc[ai][bj][m][n] = __builtin_amdgcn_mfma_f32_16x16x32_bf16(PG8_HALF(Bt[n], 1), PG8_HALF(At[m], 1), acc[ai][bj][m][n], 0, 0, 0); } __builtin_amdgcn_s_setprio(0); } while (0)
#define PG8_MMA8(ai, bj, At, Bt) do { __builtin_amdgcn_s_setprio(1); _Pragma("unroll") for (int m = 0; m < 4; ++m) _Pragma("unroll") for (int n = 0; n < 2; ++n) { \
        asm volatile("v_mfma_scale_f32_16x16x128_f8f6f4 %0, %1, %2, %0, %3, %4 op_sel_hi:[0,0,0]" : "+v"(acc[ai][bj][m][n]) : "v"(Bt[n]), "v"(At[m]), "v"(scw), "v"(scx)); }     __builtin_amdgcn_s_setprio(0); } while (0)
#define PG8_MM(ai, bj, At, Bt) do { if constexpr (F8) PG8_MMA8(ai, bj, At, Bt); else PG8_MMA(ai, bj, At, Bt); } while (0)
#define PG8_F8PAD do { if constexpr (F8) asm volatile("s_nop 15\n\ts_nop 15\n\ts_nop 15\n\ts_nop 15" ::: "memory"); } while (0)
#define PG8_WAIT_V(n) asm volatile("s_waitcnt vmcnt(" #n ")" ::: "memory")
#define PG8_WAIT_L(n) asm volatile("s_waitcnt lgkmcnt(" #n ")" ::: "memory")
#define PG8_BAR __builtin_amdgcn_s_barrier()
#define PG8_SCHED __builtin_amdgcn_sched_barrier(0)
    Unit cur, nxt; int ui = 0;
    if (!S.next(0, cur)) return;
    float zf = 0.f; asm volatile("" : "+v"(zf));
    f32x4 acc[2][2][4][2];
#pragma unroll
    for (int a = 0; a < 2; ++a)
#pragma unroll
        for (int b = 0; b < 2; ++b)
#pragma unroll
            for (int m = 0; m < 4; ++m)
#pragma unroll
                for (int n = 0; n < 2; ++n) acc[a][b][m][n] = (f32x4){zf, zf, zf, zf};
    v8i_t At[4], B0[2], B1[2];
    int scw = 0x7a7a7a7a, scx = 0x7f7f7f7f;
    if constexpr (F8) { asm volatile("" : "+v"(scw), "+v"(scx)); }
    unsigned oc00 = 0, oc01 = 0, oc10 = 0, oc11 = 0, on00 = 0, on01 = 0, on10 = 0, on11 = 0;
    const char* cA = GATHER ? (const char*)g.A : (const char*)g.A + (size_t)cur.pm * tstep; const char* cB = (const char*)g.Bt + (size_t)cur.pn * tstep;
#define PG8_ROWCOL() int rowA[2]; unsigned colA[2]; { int t_ = tid; asm volatile("" : "+v"(t_)); _Pragma("unroll") for (int i = 0; i < 2; ++i) { int R, C; stage_rc(t_ * 16 + i * 8192, R, C); rowA[i] = R; colA[i] = (unsigned)C * 2u; } }
    if constexpr (GATHER) { PG8_ROWCOL(); const int* ri = g.rowidx + cur.pm * BM; const unsigned rb = (unsigned)K * 2u;
        oc00 = (unsigned)ri[rowA[0]] * rb + colA[0]; oc01 = (unsigned)ri[rowA[1]] * rb + colA[1]; oc10 = (unsigned)ri[HALF + rowA[0]] * rb + colA[0]; oc11 = (unsigned)ri[HALF + rowA[1]] * rb + colA[1]; }
    PG8_STAGE(PG8_SB(0, 0), cB, voffB); PG8_STAGE(PG8_SB(0, 1), cB + hstep, voffB);
    if constexpr (GATHER) { PG8_STAGE2(PG8_SA(0, 0), cA, oc00, oc01); PG8_STAGE2(PG8_SA(0, 1), cA, oc10, oc11); }
    else { PG8_STAGE(PG8_SA(0, 0), cA, voffA); PG8_STAGE(PG8_SA(0, 1), cA + hstep, voffA); }
    if (wr == 1) PG8_BAR;
    PG8_WAIT_V(2); PG8_BAR;
    PG8_STAGE(PG8_SB(1, 0), cB + kstep, voffB);
    if constexpr (GATHER) { PG8_STAGE2(PG8_SA(1, 0), cA + kstep, oc00, oc01); } else { PG8_STAGE(PG8_SA(1, 0), cA + kstep, voffA); }
    PG8_STAGE(PG8_SB(1, 1), cB + hstep + kstep, voffB);
    PG8_WAIT_V(6); PG8_BAR;
    for (;;) {
        const bool has_next = S.next(ui + 1, nxt);
        const char* nA = GATHER ? cA : (has_next ? (const char*)g.A + (size_t)nxt.pm * tstep : cA); const char* nB = has_next ? (const char*)g.Bt + (size_t)nxt.pn * tstep : cB;
        if constexpr (GATHER) {
            if (has_next) { PG8_ROWCOL(); const int* ri = g.rowidx + nxt.pm * BM; const unsigned rb = (unsigned)K * 2u;
                on00 = (unsigned)ri[rowA[0]] * rb + colA[0]; on01 = (unsigned)ri[rowA[1]] * rb + colA[1]; on10 = (unsigned)ri[HALF + rowA[0]] * rb + colA[0]; on11 = (unsigned)ri[HALF + rowA[1]] * rb + colA[1]; }
            else { on00 = oc00; on01 = oc01; on10 = oc10; on11 = oc11; }
        }
        for (int t = 0; t < nt; t += 2) {
            const bool last = (t == nt - 2);
            const char* a1 = cA + (size_t)(t + 1) * kstep;
            const char* a2 = last ? nA : cA + (size_t)(t + 2) * kstep; const char* b2 = last ? nB : cB + (size_t)(t + 2) * kstep;
            const char* a3 = a2 + kstep; const char* b3 = b2 + kstep;
            const unsigned s00 = last ? on00 : oc00, s01 = last ? on01 : oc01, s10 = last ? on10 : oc10, s11 = last ? on11 : oc11;
            PG8_LDB(B0, 0, 0); PG8_LDB(B1, 0, 1); PG8_SCHED; PG8_LDA(At, 0, 0);
            if constexpr (GATHER) { PG8_STAGE2(PG8_SA(1, 1), a1, oc10, oc11); } else { PG8_STAGE(PG8_SA(1, 1), a1 + hstep, voffA); }
            PG8_WAIT_V(8); PG8_WAIT_L(0); PG8_BAR; PG8_MM(0, 0, At, B0); PG8_MM(0, 1, At, B1); PG8_F8PAD; PG8_BAR; PG8_SCHED;
            PG8_LDA(At, 0, 1); PG8_STAGE(PG8_SB(0, 0), b2, voffB); PG8_STAGE(PG8_SB(0, 1), b2 + hstep, voffB);
            if constexpr (GATHER) { PG8_STAGE2(PG8_SA(0, 0), a2, s00, s01); } else { PG8_STAGE(PG8_SA(0, 0), a2, voffA); }
            PG8_WAIT_V(8); PG8_WAIT_L(0); PG8_BAR; PG8_MM(1, 0, At, B0); PG8_MM(1, 1, At, B1); PG8_F8PAD; PG8_BAR; PG8_SCHED;
            PG8_LDB(B0, 1, 0); PG8_LDB(B1, 1, 1); PG8_SCHED; PG8_LDA(At, 1, 0);
            if constexpr (GATHER) { PG8_STAGE2(PG8_SA(0, 1), a2, s10, s11); } else { PG8_STAGE(PG8_SA(0, 1), a2 + hstep, voffA); }
            PG8_WAIT_V(8); PG8_WAIT_L(0); PG8_BAR; PG8_MM(0, 0, At, B0); PG8_MM(0, 1, At, B1); PG8_F8PAD; PG8_BAR; PG8_SCHED;
            PG8_LDA(At, 1, 1); PG8_STAGE(PG8_SB(1, 0), b3, voffB); PG8_STAGE(PG8_SB(1, 1), b3 + hstep, voffB);
            if constexpr (GATHER) { PG8_STAGE2(PG8_SA(1, 0), a3, s00, s01); } else { PG8_STAGE(PG8_SA(1, 0), a3, voffA); }
            PG8_WAIT_V(8); PG8_WAIT_L(0); PG8_BAR; PG8_MM(1, 0, At, B0); PG8_MM(1, 1, At, B1); PG8_F8PAD; PG8_BAR; PG8_SCHED;
        }
        if constexpr (ALIGN_EPI) { if (wr == 0) PG8_BAR; }
        if constexpr (F8) { asm volatile("s_nop 15\n\ts_nop 15\n\ts_nop 15\n\ts_nop 15\n\ts_nop 15\n\ts_nop 15\n\ts_nop 15\n\ts_nop 15\n\ts_nop 15\n\ts_nop 15\n\ts_nop 15\n\ts_nop 15" ::: "memory"); }
        E(acc, cur, wr, wc, fr, fq);
        if (!has_next) break;
#pragma unroll
        for (int a = 0; a < 2; ++a)
#pragma unroll
            for (int b = 0; b < 2; ++b)
#pragma unroll
                for (int m = 0; m < 4; ++m)
#pragma unroll
                    for (int n = 0; n < 2; ++n) acc[a][b][m][n] = (f32x4){zf, zf, zf, zf};
        cur = nxt; cA = nA; cB = nB; ++ui; oc00 = on00; oc01 = on01; oc10 = on10; oc11 = on11;
        if constexpr (ALIGN_EPI) { if (wr == 1) PG8_BAR; }
    }
    PG8_WAIT_V(0);
    if constexpr (!ALIGN_EPI) { if (wr == 0) PG8_BAR; }
    PG8_BAR;
#undef PG8_SA
#undef PG8_SB
#undef PG8_STAGE
#undef PG8_STAGE2
#undef PG8_LDA
#undef PG8_ROWCOL
#undef PG8_LD2
#undef PG8_HALF
#undef PG8_LDB
#undef PG8_MMA
#undef PG8_MMA8
#undef PG8_MM
#undef PG8_F8PAD
#undef PG8_WAIT_V
#undef PG8_WAIT_L
#undef PG8_BAR
#undef PG8_SCHED
}
}
#define GAS __attribute__((address_space(1)))
#define LAS __attribute__((address_space(3)))
typedef unsigned short bf16;
typedef unsigned v4u __attribute__((ext_vector_type(4)));
typedef float f32x4 __attribute__((ext_vector_type(4)));
typedef short bf16x8 __attribute__((ext_vector_type(8)));
typedef GAS unsigned gu32;
typedef GAS unsigned long long gu64;
#define RLX_AGENT __ATOMIC_RELAXED, __HIP_MEMORY_SCOPE_AGENT
#define LDS_WAIT() asm volatile("s_waitcnt lgkmcnt(0)" ::: "memory")
#define VM_WAIT() asm volatile("s_waitcnt vmcnt(0)" ::: "memory")
__device__ __forceinline__ unsigned long long rt() { return __builtin_amdgcn_s_memrealtime(); }
__device__ __forceinline__ unsigned f2bf(float f) { return (unsigned)__builtin_bit_cast(unsigned short, (__bf16)f); }
__device__ __forceinline__ unsigned pk2(float lo, float hi) { return pg8::cvt_pk_bf16(lo, hi); }

#define XB_TMO      128
#define XB_XCNT(j)  (256  + 64 * (j))
#define XB_XSUB(j)  (1280 + 64 * (j))
#define XB_XGEN(j)  (2304 + 64 * (j))
#define XB_TOP      3328
#define XB_TOPGEN   3392
#define XCD_BAR_WORDS 3456
#define XB_SPIN_CAP (1u << 18)

__device__ __forceinline__ unsigned xb_ld(unsigned* p)              { return __hip_atomic_load(p, __ATOMIC_RELAXED, __HIP_MEMORY_SCOPE_AGENT); }
__device__ __forceinline__ unsigned xb_add(unsigned* p, unsigned v) { return __hip_atomic_fetch_add(p, v, __ATOMIC_RELAXED, __HIP_MEMORY_SCOPE_AGENT); }
__device__ __forceinline__ unsigned xb_xcc_id() { return (unsigned)__builtin_amdgcn_s_getreg((3 << 11) | 20) & 0xFu; }
#define XB_SPIN(cond, bar) do { unsigned _sp = 0; while (cond) { __builtin_amdgcn_s_sleep(1); \
    if ((++_sp & 255u) == 0u) { if (xb_ld(&(bar)[XB_TMO])) break; if (_sp > XB_SPIN_CAP) { atomicAdd(&(bar)[XB_TMO], 1u); break; } } } } while (0)

struct XcdBarrier {
    unsigned* bar; unsigned x;
    volatile LAS unsigned* st;
};

__device__ __forceinline__ XcdBarrier xcd_barrier_post(unsigned* bar, volatile LAS unsigned* st) {
    XcdBarrier b; b.bar = bar; b.x = xb_xcc_id(); b.st = st;
    if (threadIdx.x == 0) (void)xb_add(&bar[XB_XCNT(b.x)], 1u);
    return b;
}
__device__ __forceinline__ void xcd_barrier_complete(unsigned* bar, unsigned x, unsigned& nloc, unsigned& nx) {
    const unsigned G = gridDim.x * gridDim.y * gridDim.z;
    unsigned sum, cnt, mine, sp = 0u;
    for (;;) {
        sum = 0u; cnt = 0u; mine = 0u;
#pragma unroll
        for (unsigned j = 0; j < 16; ++j) { const unsigned c = xb_ld(&bar[XB_XCNT(j)]); sum += c; cnt += (c > 0u) ? 1u : 0u; mine = (j == x) ? c : mine; }
        if (sum == G) break;
        __builtin_amdgcn_s_sleep(1);
        if ((++sp & 255u) == 0u) { if (xb_ld(&bar[XB_TMO])) break; if (sp > XB_SPIN_CAP) { atomicAdd(&bar[XB_TMO], 1u); break; } }
    }
    nloc = mine > 0u ? mine : 1u; nx = cnt > 0u ? cnt : 1u;
}

__device__ __forceinline__ void xcd_barrier(const XcdBarrier& b) {
    asm volatile("s_waitcnt vmcnt(0)" ::: "memory");
    __syncthreads();
    if (threadIdx.x == 0) {
        unsigned* bar = b.bar;
        __builtin_amdgcn_s_waitcnt(0);
        unsigned nloc = b.st[0], nx = b.st[1];
        if (nloc == 0u) { xcd_barrier_complete(bar, b.x, nloc, nx); b.st[0] = nloc; b.st[1] = nx; }
        const unsigned old = xb_add(&bar[XB_XSUB(b.x)], 1u);
        const unsigned gen = old / nloc;
        if (old + 1u == (gen + 1u) * nloc) {
            __builtin_amdgcn_fence(__ATOMIC_RELEASE, "agent");
            asm volatile("s_waitcnt vmcnt(0)" ::: "memory");
            const unsigned og = xb_add(&bar[XB_TOP], 1u);
            const unsigned tg = og / nx;
            if (og + 1u == (tg + 1u) * nx) xb_add(&bar[XB_TOPGEN], 1u);
            else XB_SPIN(xb_ld(&bar[XB_TOPGEN]) == tg, bar);
            __builtin_amdgcn_fence(__ATOMIC_ACQUIRE, "agent");
            xb_add(&bar[XB_XGEN(b.x)], 1u);
            asm volatile("s_waitcnt vmcnt(0)" ::: "memory");
        } else {
            XB_SPIN(xb_ld(&bar[XB_XGEN(b.x)]) == gen, bar);
            __builtin_amdgcn_fence(__ATOMIC_ACQUIRE, "agent");
            asm volatile("s_waitcnt vmcnt(0)" ::: "memory");
        }
    }
    __syncthreads();
}

constexpr int NWAVES = 8;
constexpr int DM = 1024, NBATCH = 8, SEQL = 4096, CTXL = 256;
constexpr int NC = NBATCH * CTXL, NX = NBATCH * SEQL, NTOK = NC + NX;
constexpr int HW = 512, INC = 3072, NE = 64, TOPK = 6;
constexpr int NCH = 68;
constexpr int NSEQ = NBATCH * 4 * 2;
constexpr float EPSN = 1e-6f;
constexpr int NHALF = 1;
constexpr int MAXBLK = 1024;
constexpr int MAXSLOT = 1016 * 256;

constexpr size_t MiB = 1u << 20;
constexpr size_t WS_CTL = 0, CTL_ZERO_BYTES = 1 * MiB;
constexpr size_t WS_MOD = 1 * MiB;
constexpr size_t WS_RT = 2 * MiB;
constexpr size_t RT_IDX = WS_RT, RT_GATE = WS_RT + 1 * MiB, RT_TSLOT = WS_RT + 2 * MiB, RT_STOK = WS_RT + 3 * MiB, RT_BLKE = WS_RT + 4 * MiB + 512 * 1024, RT_MISC = RT_BLKE + 8192;
constexpr size_t WS_CTXRES = 8 * MiB;
constexpr size_t WS_WIN = 16 * MiB, WS_WOUT = 22 * MiB, WS_WPOOL = 24 * MiB, WS_WR = 25 * MiB, WS_W13 = 26 * MiB, WS_W2 = 91 * MiB;
constexpr size_t WS_HX = 124 * MiB;
constexpr size_t WS_PX = 193 * MiB;
constexpr size_t WS_KV = 397 * MiB;
constexpr size_t WS_DEC = 533 * MiB;
constexpr size_t WS_HS = 193 * MiB, WS_YS = 320 * MiB;
constexpr size_t WS_END = 574 * MiB;
static_assert(WS_HS + (size_t)MAXSLOT * 512 <= WS_YS && WS_YS + (size_t)MAXSLOT * 1024 <= WS_END && WS_HX + (size_t)(NTOK + 1) * 2048 <= WS_PX && WS_PX + (size_t)NTOK * INC * 2 <= WS_KV, "ws map");
constexpr int CW_BAR = 4096, CW_CNT = 8192, CW_CUR = 8448;

constexpr int RING_BYTES = 131072, LDSCTL_OFF = RING_BYTES, MISC_OFF = LDSCTL_OFF + 320, LDS_BYTES = 147456;

__device__ __forceinline__ float bf2f(unsigned short u) { return __builtin_bit_cast(float, ((unsigned)u) << 16); }
__device__ __forceinline__ float shx(float v, int o, int lane) { return __builtin_bit_cast(float, __builtin_amdgcn_ds_bpermute((lane ^ o) << 2, __builtin_bit_cast(int, v))); }
__device__ __forceinline__ float shl(float v, int src) { return __builtin_bit_cast(float, __builtin_amdgcn_ds_bpermute(src << 2, __builtin_bit_cast(int, v))); }
__device__ __forceinline__ float wave_sum(float v, int lane) {
#pragma unroll
    for (int o = 1; o < 64; o <<= 1) v += shx(v, o, lane);
    return v;
}
__device__ __forceinline__ float wave_max(float v, int lane) {
#pragma unroll
    for (int o = 1; o < 64; o <<= 1) v = fmaxf(v, shx(v, o, lane));
    return v;
}
__device__ __forceinline__ float opaque_zero() { float z = 0.f; asm volatile("" : "+v"(z)); return z; }
__device__ __forceinline__ float sigmoidf_(float x) { return __builtin_amdgcn_rcpf(1.0f + __expf(-x)); }
__device__ __forceinline__ float clamp80(float x) { return fminf(fmaxf(x, -80.f), 80.f); }

struct Frame {
    LAS unsigned char* lds;
    unsigned* ctl;
    int tid, lane, wave, vcu, G;
    const float* in[23];
    float* out; unsigned char* ws;
};
extern __shared__ __attribute__((aligned(16))) unsigned char g_lds[];
constexpr int TAB_OFF = MISC_OFF + 128;
__device__ __forceinline__ unsigned long long tab_ld(int i) {
    const unsigned long long v = ((const LAS unsigned long long*)((LAS unsigned char*)g_lds + TAB_OFF))[i];
    const unsigned lo = (unsigned)__builtin_amdgcn_readfirstlane((int)(unsigned)v), hi = (unsigned)__builtin_amdgcn_readfirstlane((int)(unsigned)(v >> 32));
    return ((unsigned long long)hi << 32) | lo;
}
__device__ __forceinline__ Frame make_frame() {
    asm volatile("" ::: "memory");
    Frame F;
    F.lds = (LAS unsigned char*)g_lds;
    F.tid = pg8::opaque_tid(); F.lane = F.tid & 63; F.wave = __builtin_amdgcn_readfirstlane(F.tid >> 6);
    F.G = gridDim.x; { int bx = blockIdx.x; asm volatile("" : "+s"(bx)); F.vcu = (F.G % 8 == 0) ? (bx % 8) * (F.G / 8) + bx / 8 : bx; }
#pragma unroll
    for (int i = 0; i < 23; ++i) F.in[i] = (const float*)tab_ld(i);
    F.out = (float*)tab_ld(23); F.ws = (unsigned char*)tab_ld(24); F.ctl = (unsigned*)(F.ws + WS_CTL);
    return F;
}
__device__ __forceinline__ void grid_barrier() {
    const Frame F = make_frame();
    XcdBarrier b; b.bar = F.ctl + CW_BAR; b.x = xb_xcc_id(); b.st = (volatile LAS unsigned*)((LAS unsigned char*)g_lds + MISC_OFF) + 8;
    xcd_barrier(b);
}

__device__ __forceinline__ void transpose_item(const float* W, int K, int N, bf16* WT, int mode, LAS float* scr, int item, int lane, float wscale = 1.0f, bool f8 = false) {
    (void)scr;
    const int nblk = N / 32, kb = item / nblk, nb = item % nblk, k0 = 64 * kb, n0 = 32 * nb, c = lane >> 3, n4 = lane & 7;
    const GAS f32x4* src = (const GAS f32x4*)(W + (size_t)(k0 + 8 * c) * N + n0 + 4 * n4);
    f32x4 v[8];
#pragma unroll
    for (int j = 0; j < 8; ++j) v[j] = src[(size_t)j * (N / 4)] * wscale;
#pragma unroll
    for (int i = 0; i < 4; ++i) {
        const v4u o = (v4u){pk2(v[0][i], v[1][i]), pk2(v[2][i], v[3][i]), pk2(v[4][i], v[5][i]), pk2(v[6][i], v[7][i])};
        const int nn = n0 + 4 * n4 + i; int dr = nn;
        if (mode) dr = 256 * (nn >> 7) + 128 * ((nn >> 2) & 1) + 32 * ((nn >> 5) & 3) + 16 * (mode - 1) + 4 * ((nn >> 3) & 3) + (nn & 3);
        if (!f8) *(GAS v4u*)(WT + (size_t)dr * K + k0 + 8 * c) = o;
        else { int lo8 = 0, hi8 = 0;
            lo8 = __builtin_amdgcn_cvt_pk_fp8_f32(v[0][i], v[1][i], lo8, false); lo8 = __builtin_amdgcn_cvt_pk_fp8_f32(v[2][i], v[3][i], lo8, true);
            hi8 = __builtin_amdgcn_cvt_pk_fp8_f32(v[4][i], v[5][i], hi8, false); hi8 = __builtin_amdgcn_cvt_pk_fp8_f32(v[6][i], v[7][i], hi8, true);
            *(GAS unsigned long long*)((GAS unsigned char*)WT + (size_t)dr * K + k0 + 8 * c) = (unsigned long long)(unsigned)lo8 | ((unsigned long long)(unsigned)hi8 << 32); } }
}

__device__ __forceinline__ void phase_wconv(Frame& F, int l) {
    LAS float* scr = (LAS float*)(F.lds + F.wave * 16384);
    const int gw = F.vcu * NWAVES + F.wave, NGW = F.G * NWAVES;
    constexpr int I_IN = 16 * 96, I_OUT = 16 * 32, I_POOL = 4 * 8, I_R = 16 * 2, I_1 = 65 * 128, I_2 = 65 * 128;
    constexpr int NITEMS = I_IN + I_OUT + I_POOL + I_R + 2 * I_1 + I_2;
    unsigned char* ws = F.ws;
    for (int it = gw; it < NITEMS; it += NGW) {
        int r = it;
        if (r < I_IN) { transpose_item(F.in[8] + (size_t)l * DM * INC, DM, INC, (bf16*)(ws + WS_WIN), 0, scr, r, F.lane); continue; } r -= I_IN;
        if (r < I_OUT) { transpose_item(F.in[13] + (size_t)l * DM * DM, DM, DM, (bf16*)(ws + WS_WOUT), 0, scr, r, F.lane); continue; } r -= I_OUT;
        if (r < I_POOL) { const int g = r / 8; transpose_item(F.in[11] + (size_t)(l * 4 + g) * 128 * 128, 128, 128, (bf16*)(ws + WS_WPOOL) + g * 128 * 128, 0, scr, r % 8, F.lane); continue; } r -= I_POOL;
        if (r < I_R) { transpose_item(F.in[14] + (size_t)l * DM * NE, DM, NE, (bf16*)(ws + WS_WR), 0, scr, r, F.lane); continue; } r -= I_R;
        if (r < 2 * I_1) { const int mat = r / I_1; r -= mat * I_1; const int e = r / 128, ii = r % 128;
            const float* src = (e < 64) ? F.in[mat ? 17 : 16] + ((size_t)l * 64 + e) * DM * 256 : F.in[mat ? 20 : 19] + (size_t)l * DM * 256;
            transpose_item(src, DM, 256, (bf16*)((unsigned char*)(ws + WS_W13) + (size_t)e * 512 * DM), 1 + mat, scr, ii, F.lane, 32.0f, true); continue; } r -= 2 * I_1;
        { const int e = r / 128, ii = r % 128;
            const float* src = (e < 64) ? F.in[18] + ((size_t)l * 64 + e) * 256 * DM : F.in[21] + (size_t)l * 256 * DM;
            transpose_item(src, 256, DM, (bf16*)(ws + WS_W2) + (size_t)e * DM * 256, 0, scr, ii, F.lane, pg8::YS_SCALE); }
    }
}

__device__ __forceinline__ void phase_mod(Frame& F) {
    LAS float* sil = (LAS float*)(F.lds + 65536);
    LAS float* part = (LAS float*)(F.lds + 65536 + 36864);
    for (int i = F.tid; i < 9 * 1024; i += 512) { const int r = i >> 10, k = i & 1023; const float v = (r < 8) ? F.in[1][r * 1024 + k] : F.in[3][k]; sil[i] = v * sigmoidf_(v); }
    __syncthreads();
    float* mod = (float*)(F.ws + WS_MOD);
    for (int it = F.vcu; it < 2 * 96; it += F.G) {
        const int l = it / 96, n0 = (it % 96) * 64;
        const float* wa = F.in[6] + (size_t)l * DM * 6144 + n0 + F.lane;
        float acc[9];
#pragma unroll
        for (int r = 0; r < 9; ++r) acc[r] = 0.f;
        const int kb = F.wave * 128;
#pragma unroll 4
        for (int k = 0; k < 128; ++k) { const float w = wa[(size_t)(kb + k) * 6144];
#pragma unroll
            for (int r = 0; r < 9; ++r) acc[r] += sil[r * 1024 + kb + k] * w; }
#pragma unroll
        for (int r = 0; r < 9; ++r) part[(F.wave * 9 + r) * 64 + F.lane] = acc[r];
        __syncthreads();
        for (int i = F.tid; i < 9 * 64; i += 512) { const int r = i >> 6, c = i & 63; float s = 0.f;
#pragma unroll
            for (int w = 0; w < 8; ++w) s += part[(w * 9 + r) * 64 + c];
            mod[((size_t)l * 9 + r) * 6144 + n0 + c] = s + F.in[7][(size_t)l * 6144 + n0 + c]; }
        __syncthreads();
    }
}

__device__ __forceinline__ const float* resid_in_row(Frame& F, int l, int row) {
    if (l == 0) return row < NC ? F.in[2] + (size_t)row * DM : F.in[0] + (size_t)(row - NC) * DM;
    return row < NC ? (const float*)(F.ws + WS_CTXRES) + (size_t)row * DM : F.out + (size_t)(row - NC) * DM;
}
__device__ __forceinline__ float* resid_row(Frame& F, int row) { return row < NC ? (float*)(F.ws + WS_CTXRES) + (size_t)row * DM : F.out + (size_t)(row - NC) * DM; }
__device__ __forceinline__ int mod_row(int row) { return row < NC ? 8 : ((row - NC) >> 12); }

#ifndef DIAG_ZERO_CTXSTATE
#define DIAG_ZERO_CTXSTATE 0
#endif
#ifndef DEG_HX
#define DEG_HX 0
#endif
#ifndef DEG_Y
#define DEG_Y 0
#endif
__device__ __forceinline__ void norm_mod_row(Frame& F, const float* xrow, const float* nw, const float* sh, const float* sc, bf16* orow, LAS bf16* lrow, LAS float* frow = nullptr) {
    const GAS f32x4* xr = (const GAS f32x4*)xrow + F.lane;
    f32x4 v[4]; float s = 0.f;
#pragma unroll
    for (int j = 0; j < 4; ++j) { v[j] = xr[64 * j]; s += (v[j].x * v[j].x + v[j].y * v[j].y) + (v[j].z * v[j].z + v[j].w * v[j].w); }
    const float r = 1.0f / sqrtf(wave_sum(s, F.lane) * (1.f / DM) + EPSN);
#pragma unroll
    for (int j = 0; j < 4; ++j) {
        const f32x4 w4 = ((const GAS f32x4*)nw)[F.lane + 64 * j], s4 = ((const GAS f32x4*)sc)[F.lane + 64 * j], h4 = ((const GAS f32x4*)sh)[F.lane + 64 * j];
        const f32x4 o = (v[j] * r) * w4 * (s4 + 1.0f) + h4;
        unsigned long long pk = (unsigned long long)pk2(o.x, o.y) | ((unsigned long long)pk2(o.z, o.w) << 32);
        if (DEG_HX) pk &= 0xfffcfffcfffcfffcull;
        ((GAS unsigned long long*)orow)[F.lane + 64 * j] = pk;
        if (lrow) *(LAS unsigned long long*)(lrow + 4 * (F.lane + 64 * j)) = pk;
        if (frow) *(LAS f32x4*)(frow + 4 * (F.lane + 64 * j)) = o;
    }
}

__device__ __forceinline__ void phase_hx(Frame& F, int l) {
    const int gw = F.vcu * NWAVES + F.wave, NGW = F.G * NWAVES;
    const float* mod = (const float*)(F.ws + WS_MOD) + (size_t)l * 9 * 6144;
    bf16* HX = (bf16*)(F.ws + WS_HX);
    for (int row = gw; row < NTOK; row += NGW) { const float* md = mod + mod_row(row) * 6144;
        norm_mod_row(F, resid_in_row(F, l, row), F.in[4] + l * DM, md, md + 1024, HX + (size_t)row * DM, nullptr); }
}

__device__ __forceinline__ void gates16(const bf16* zp, float lb, float (&g)[16], float (&kk)[16]) {
    const float lbf = fmaxf(lb, 1e-30f), oml = 1.0f - lb;
#pragma unroll
    for (int j = 0; j < 16; ++j) { const float z = bf2f(zp[(size_t)j * INC]); const float sg = sigmoidf_(z); g[j] = __logf(lbf + oml * sg); kk[j] = oml * (1.0f - sg); }
}
__device__ __forceinline__ float lb_of(Frame& F, int l, int dir, int hch) {
    if (l == 0) return 0.f;
    const float a0 = F.in[9][dir * HW + hch], a1 = F.in[9][2 * HW + dir * HW + hch];
    return 1.0f / (1.0f + __expf(a0 - a1));
}
__device__ __forceinline__ int chunk_row0(int b, int dir, int c) {
    if (c < 4) { const int tc = dir ? 3 - c : c; return b * CTXL + tc * 64; }
    const int tc = dir ? 63 - (c - 4) : (c - 4); return NC + b * SEQL + tc * 64;
}

template <int KS, int NTILE>
__device__ __forceinline__ void mma_rows16(f32x4 (&acc)[NTILE], const LAS bf16* A, int lda, int arow0, const LAS bf16* Bt, int ldb, int brow0, int lane) {
    const int r = lane & 15, q = lane >> 4;
    bf16x8 af[KS], bfr[KS][NTILE];
#pragma unroll
    for (int s = 0; s < KS; ++s) { af[s] = *(const LAS bf16x8*)(A + (arow0 + r) * lda + 32 * s + 8 * q);
#pragma unroll
        for (int i = 0; i < NTILE; ++i) bfr[s][i] = *(const LAS bf16x8*)(Bt + (brow0 + 16 * i + r) * ldb + 32 * s + 8 * q); }
#pragma unroll
    for (int s = 0; s < KS; ++s)
#pragma unroll
        for (int i = 0; i < NTILE; ++i) acc[i] = __builtin_amdgcn_mfma_f32_16x16x32_bf16(bfr[s][i], af[s], acc[i], 0, 0, 0);
}

__device__ __forceinline__ void pool_load(Frame& F, int b, int tc, int gi, v4u (&r)[3]) {
    const GAS bf16* PX = (const GAS bf16*)(F.ws + WS_PX);
    const int row0 = (tc < 4) ? b * CTXL + tc * 64 : NC + b * SEQL + (tc - 4) * 64;
    const int lo_b = (tc < 4) ? -tc * 64 : 0, hi_b = (tc < 4) ? (4 - tc) * 64 : 64;
#pragma unroll
    for (int j = 0; j < 3; ++j) { const int e = F.tid + 512 * j; const int rr = (e >> 4) - 8; r[j] = (v4u){0u, 0u, 0u, 0u};
        if (e < 1280 && rr >= lo_b && rr < hi_b) r[j] = *(const GAS v4u*)(PX + (size_t)(row0 + rr) * INC + 5 * HW + gi * 128 + (e & 15) * 8); }
}
__device__ __forceinline__ void pool_item(Frame& F, int l, int b, int tc, int gi, v4u (&pr)[3], bool has_next, int nb, int ntc, int ngi) {
    LAS bf16* Pin = (LAS bf16*)(F.lds + 65536); LAS bf16* Pl = (LAS bf16*)(F.lds); LAS bf16* Wt = (LAS bf16*)(F.lds + 17408);
    bf16* Y = (bf16*)(F.ws + WS_HX);
    const int seg = F.tid >> 7, ch = F.tid & 127, mt = F.wave >> 1, nh = F.wave & 1, lr = F.lane & 15, lq = F.lane >> 4;
    const int row0 = (tc < 4) ? b * CTXL + tc * 64 : NC + b * SEQL + (tc - 4) * 64;
    const int wdw = 2 << gi, hw2 = wdw >> 1;
    const int lo_b = (tc < 4) ? -tc * 64 : 0, hi_b = (tc < 4) ? (4 - tc) * 64 : 64;
#pragma unroll
    for (int j = 0; j < 3; ++j) { const int e = F.tid + 512 * j; if (e < 1280) *(LAS v4u*)(Pin + (e >> 4) * 128 + (e & 15) * 8) = pr[j]; }
    { const GAS v4u* wp = (const GAS v4u*)((const bf16*)(F.ws + WS_WPOOL) + gi * 128 * 128);
#pragma unroll
      for (int i = 0; i < 4; ++i) { const int e = F.tid + 512 * i; const int d = e >> 4, kq = e & 15; *(LAS v4u*)(Wt + d * 136 + kq * 8) = wp[e]; } }
    if (has_next) pool_load(F, nb, ntc, ngi, pr);
    __syncthreads();
#pragma unroll 4
    for (int t = 0; t < 16; ++t) { const int i = seg * 16 + t; int lo = i - hw2, hi = i + hw2; lo = lo < lo_b ? lo_b : lo; hi = hi > hi_b ? hi_b : hi;
        float sm = 0.f; for (int r = lo; r < hi; ++r) sm += bf2f(Pin[(r + 8) * 128 + ch]);
        Pl[i * 136 + ch] = (bf16)f2bf(sm / (float)(hi - lo) - bf2f(Pin[(i + 8) * 128 + ch])); }
    __syncthreads();
    f32x4 acc[4]; const float zf = opaque_zero();
#pragma unroll
    for (int i = 0; i < 4; ++i) acc[i] = (f32x4){zf, zf, zf, zf};
    mma_rows16<4, 4>(acc, Pl, 136, 16 * mt, Wt, 136, 64 * nh, F.lane);
    const int t = 16 * mt + lr;
    const float* ps = F.in[12] + l * HW + gi * 128 + 64 * nh + 4 * lq;
    bf16* yp = Y + (size_t)(row0 + t) * DM + HW + gi * 128 + 64 * nh + 4 * lq;
#pragma unroll
    for (int i = 0; i < 4; ++i) { const f32x4 w4 = *(const GAS f32x4*)(ps + 16 * i);
        *(GAS unsigned long long*)(yp + 16 * i) = (unsigned long long)pk2(acc[i].x * w4.x, acc[i].y * w4.y) | ((unsigned long long)pk2(acc[i].z * w4.z, acc[i].w * w4.w) << 32); }
    __syncthreads();
}

#ifndef USE_OLD_SCAN
#define USE_OLD_SCAN 0
#endif
#ifndef PREP_INPLACE
#define PREP_INPLACE 1
#endif
constexpr size_t WS_O = WS_KV, WS_KE = WS_KV + 68 * MiB, WS_VT = 536 * MiB;
__device__ __forceinline__ void prep_load(const GAS bf16* rowp, int h, int tid, v4u (&r)[8]) {
#pragma unroll
    for (int j = 0; j < 2; ++j) { const int e = tid + 512 * j; const GAS bf16* p = rowp + (size_t)(e >> 4) * INC + h * 128 + (e & 15) * 8;
        r[j] = *(const GAS v4u*)(p); r[2 + j] = *(const GAS v4u*)(p + HW); r[4 + j] = *(const GAS v4u*)(p + 3 * HW); r[6 + j] = *(const GAS v4u*)(p + 2 * HW); }
}
typedef float f32x2 __attribute__((ext_vector_type(2)));
__device__ __forceinline__ f32x2 bf2x(unsigned u) { return (f32x2){__builtin_bit_cast(float, u << 16), __builtin_bit_cast(float, u & 0xffff0000u)}; }
__device__ __forceinline__ void phase_prep(Frame& F, int l) {
    LAS unsigned* Raw = (LAS unsigned*)(F.lds);
    LAS bf16* Qt = (LAS bf16*)(F.lds); LAS bf16* Kt = (LAS bf16*)(F.lds + 17408); LAS bf16* Pm = (LAS bf16*)(F.lds + 34816);
    LAS bf16* vT = (LAS bf16*)(F.lds + 65536); LAS float* tot = (LAS float*)(F.lds + 83968);
    GAS bf16* PX = (GAS bf16*)(F.ws + WS_PX); GAS bf16* KE = (GAS bf16*)(F.ws + WS_KE); GAS bf16* VT = (GAS bf16*)(F.ws + WS_VT); GAS float* DEC = (GAS float*)(F.ws + WS_DEC); GAS bf16* O = (GAS bf16*)(F.ws + WS_O);
    const int s8 = F.tid >> 6, cp = F.tid & 63, mt = F.wave >> 1, nh = F.wave & 1, lr = F.lane & 15, lq = F.lane >> 4;
    const int nit = NBATCH * 4 * NCH;
    v4u rr[8];
    auto item_row0 = [](int it) { const int tc = it >> 5, b = (it >> 2) & 7; return (tc < 4) ? b * CTXL + tc * 64 : NC + b * SEQL + (tc - 4) * 64; };
    if (F.vcu < nit) prep_load(PX + (size_t)item_row0(F.vcu) * INC, F.vcu & 3, F.tid, rr);
#pragma unroll 1
    for (int it = F.vcu; it < nit; it += F.G) {
        const int h = it & 3, b = (it >> 2) & 7, tc = it >> 5, row0 = item_row0(it);
        const bool outp = (l == 0) || (tc >= 4);
#pragma unroll
        for (int j = 0; j < 2; ++j) { const int e = F.tid + 512 * j; const int o4 = (e >> 4) * 64 + (e & 15) * 4;
#pragma unroll
            for (int x = 0; x < 4; ++x) *(LAS v4u*)(Raw + x * 4096 + o4) = rr[2 * x + j]; }
        if (it + F.G < nit) prep_load(PX + (size_t)item_row0(it + F.G) * INC, (it + F.G) & 3, F.tid, rr);
        __syncthreads();
        unsigned zf[8], zb[8], qv[8], vv[8];
#pragma unroll
        for (int t = 0; t < 8; ++t) { const int o = (s8 * 8 + t) * 64 + cp; zf[t] = Raw[o]; zb[t] = Raw[4096 + o]; qv[t] = Raw[8192 + o]; vv[t] = Raw[12288 + o]; }
        __syncthreads();
        { v4u lo, hi;
          lo.x = (vv[0] & 0xffffu) | (vv[1] << 16); lo.y = (vv[2] & 0xffffu) | (vv[3] << 16); lo.z = (vv[4] & 0xffffu) | (vv[5] << 16); lo.w = (vv[6] & 0xffffu) | (vv[7] << 16);
          hi.x = (vv[0] >> 16) | (vv[1] & 0xffff0000u); hi.y = (vv[2] >> 16) | (vv[3] & 0xffff0000u); hi.z = (vv[4] >> 16) | (vv[5] & 0xffff0000u); hi.w = (vv[6] >> 16) | (vv[7] & 0xffff0000u);
          *(LAS v4u*)(vT + (2 * cp) * 72 + s8 * 8) = lo; *(LAS v4u*)(vT + (2 * cp + 1) * 72 + s8 * 8) = hi;
          GAS bf16* vt = VT + (size_t)((b * 4 + h) * NCH + tc) * 8192;
          *(GAS v4u*)(vt + (2 * cp) * 64 + s8 * 8) = lo; *(GAS v4u*)(vt + (2 * cp + 1) * 64 + s8 * 8) = hi; }
        float qs0[8], qs1[8];
#pragma unroll
        for (int t = 0; t < 8; ++t) { const f32x2 q = bf2x(qv[t]); qs0[t] = q.x * sigmoidf_(q.x) * 0.08838834764831845f; qs1[t] = q.y * sigmoidf_(q.y) * 0.08838834764831845f; }
#pragma unroll 1
        for (int dir = 0; dir < 2; ++dir) {
            const int seq = (b * 4 + h) * 2 + dir, c = (tc < 4) ? (dir ? 3 - tc : tc) : (dir ? 71 - tc : tc);
            const float lb0 = lb_of(F, l, dir, h * 128 + 2 * cp), lb1 = lb_of(F, l, dir, h * 128 + 2 * cp + 1);
            const float lbf0 = fmaxf(lb0, 1e-30f), oml0 = 1.0f - lb0, lbf1 = fmaxf(lb1, 1e-30f), oml1 = 1.0f - lb1;
            float g0[8], g1[8], k0[8], k1[8];
#pragma unroll
            for (int t = 0; t < 8; ++t) { const f32x2 z = bf2x(dir ? zb[t] : zf[t]); const float a0 = sigmoidf_(z.x), a1 = sigmoidf_(z.y);
                g0[t] = __logf(lbf0 + oml0 * a0); k0[t] = oml0 * (1.0f - a0); g1[t] = __logf(lbf1 + oml1 * a1); k1[t] = oml1 * (1.0f - a1); }
            if (dir == 0) {
#pragma unroll
                for (int t = 1; t < 8; ++t) { g0[t] += g0[t - 1]; g1[t] += g1[t - 1]; }
                *(LAS f32x2*)(tot + s8 * 128 + 2 * cp) = (f32x2){g0[7], g1[7]};
            } else {
#pragma unroll
                for (int t = 6; t >= 0; --t) { g0[t] += g0[t + 1]; g1[t] += g1[t + 1]; }
                *(LAS f32x2*)(tot + s8 * 128 + 2 * cp) = (f32x2){g0[0], g1[0]};
            }
            __syncthreads();
            float off0 = 0.f, off1 = 0.f, m0 = 0.f, m1 = 0.f, bt0 = 0.f, bt1 = 0.f;
#pragma unroll
            for (int sg = 0; sg < 8; ++sg) { const f32x2 tv = *(const LAS f32x2*)(tot + sg * 128 + 2 * cp);
                const bool before = dir ? (sg > s8) : (sg < s8), firsthalf = dir ? (sg >= 4) : (sg < 4);
                if (before) { off0 += tv.x; off1 += tv.y; } if (firsthalf) { m0 += tv.x; m1 += tv.y; } bt0 += tv.x; bt1 += tv.y; }
            { unsigned ka[4], kb[4];
#pragma unroll
              for (int t = 0; t < 8; t += 2) { ka[t >> 1] = pg8::cvt_pk_bf16(k0[t] * __expf(bt0 - (g0[t] + off0)), k0[t + 1] * __expf(bt0 - (g0[t + 1] + off0)));
                  kb[t >> 1] = pg8::cvt_pk_bf16(k1[t] * __expf(bt1 - (g1[t] + off1)), k1[t + 1] * __expf(bt1 - (g1[t + 1] + off1))); }
              GAS bf16* ke = KE + (size_t)(seq * NCH + c) * 8192;
              *(GAS v4u*)(ke + (2 * cp) * 64 + s8 * 8) = (v4u){ka[0], ka[1], ka[2], ka[3]}; *(GAS v4u*)(ke + (2 * cp + 1) * 64 + s8 * 8) = (v4u){kb[0], kb[1], kb[2], kb[3]}; }
            if (s8 == 0) *(GAS f32x2*)(DEC + (size_t)(seq * NCH + c) * 128 + 2 * cp) = (f32x2){__expf(bt0), __expf(bt1)};
            if (outp) {
#pragma unroll
                for (int t = 0; t < 8; ++t) { const int tok = s8 * 8 + t; const float b0 = g0[t] + off0, b1 = g1[t] + off1;
                    if (PREP_INPLACE) *(GAS unsigned*)(PX + (size_t)(row0 + tok) * INC + dir * HW + h * 128 + 2 * cp) = pg8::cvt_pk_bf16(qs0[t] * __expf(fmaxf(b0, -80.f)), qs1[t] * __expf(fmaxf(b1, -80.f)));
                    *(LAS unsigned*)(Qt + tok * 136 + 2 * cp) = pg8::cvt_pk_bf16(qs0[t] * __expf(clamp80(b0 - m0)), qs1[t] * __expf(clamp80(b1 - m1)));
                    *(LAS unsigned*)(Kt + tok * 136 + 2 * cp) = pg8::cvt_pk_bf16(k0[t] * __expf(clamp80(m0 - b0)), k1[t] * __expf(clamp80(m1 - b1))); }
            }
            __syncthreads();
            if (outp) {
                const float zf0 = opaque_zero();
                f32x4 pa[2] = {(f32x4){zf0, zf0, zf0, zf0}, (f32x4){zf0, zf0, zf0, zf0}};
                mma_rows16<4, 2>(pa, Qt, 136, 16 * mt, Kt, 136, 32 * nh, F.lane);
                const int t = 16 * mt + lr;
#pragma unroll
                for (int i = 0; i < 2; ++i) { const int s0 = 32 * nh + 16 * i + 4 * lq; float p[4];
#pragma unroll
                    for (int x = 0; x < 4; ++x) { const int s = s0 + x; const bool keep = dir ? (s >= t) : (s <= t); p[x] = keep ? pa[i][x] : 0.f; }
                    *(LAS unsigned long long*)(Pm + t * 72 + s0) = (unsigned long long)pg8::cvt_pk_bf16(p[0], p[1]) | ((unsigned long long)pg8::cvt_pk_bf16(p[2], p[3]) << 32); }
            }
            __syncthreads();
            if (outp) {
                const float zf0 = opaque_zero();
                f32x4 oa[4];
#pragma unroll
                for (int i = 0; i < 4; ++i) oa[i] = (f32x4){zf0, zf0, zf0, zf0};
                mma_rows16<2, 4>(oa, Pm, 72, 16 * mt, vT, 72, 64 * nh, F.lane);
                GAS bf16* op = O + ((size_t)dir * NTOK + row0 + 16 * mt + lr) * HW + h * 128 + 64 * nh + 4 * lq;
#pragma unroll
                for (int i = 0; i < 4; ++i) *(GAS unsigned long long*)(op + 16 * i) = (unsigned long long)pg8::cvt_pk_bf16(oa[i].x, oa[i].y) | ((unsigned long long)pg8::cvt_pk_bf16(oa[i].z, oa[i].w) << 32);
            }
            __syncthreads();
        }
    }
}

__device__ __forceinline__ void scan2_load(const GAS bf16* qrow, const GAS bf16* ke, const GAS bf16* vt, int tid, v4u (&r)[6]) {
#pragma unroll
    for (int j = 0; j < 2; ++j) { const int e = tid + 512 * j; r[j] = *(const GAS v4u*)(qrow + (size_t)(e >> 4) * INC + (e & 15) * 8); r[2 + j] = ((const GAS v4u*)ke)[e]; r[4 + j] = ((const GAS v4u*)vt)[e]; }
}
__device__ __forceinline__ void scan_unit(Frame& F, int l, int u, bool dry = false) {
    constexpr int SETB = 54784;
    const GAS bf16* PX = (const GAS bf16*)(F.ws + WS_PX); const GAS bf16* KE = (const GAS bf16*)(F.ws + WS_KE); const GAS bf16* VT = (const GAS bf16*)(F.ws + WS_VT); const GAS float* DEC = (const GAS float*)(F.ws + WS_DEC);
    const int w = F.wave, lr = F.lane & 15, lq = F.lane >> 4;
    const int dir = u & 1, h = (u >> 1) & 3, b = u >> 3;
    GAS bf16* O = (GAS bf16*)(F.ws + WS_O) + (size_t)dir * NTOK * HW;
    const float zf = opaque_zero();
    f32x4 st[8];
#pragma unroll
    for (int i = 0; i < 8; ++i) st[i] = (f32x4){zf, zf, zf, zf};
    v4u ra[6], rb[6]; float da = 0.f, db = 0.f; unsigned long long oa[4] = {0ull, 0ull, 0ull, 0ull}, ob[4] = {0ull, 0ull, 0ull, 0ull};
#define SCAN_TC(c) (((c) < 4) ? (dir ? 3 - (c) : (c)) : (dir ? 71 - (c) : (c)))
#define SCAN_LOAD(R, D, OO, c) do { scan2_load(PX + (size_t)chunk_row0(b, dir, (c)) * INC + dir * HW + h * 128, KE + (size_t)(u * NCH + (c)) * 8192, VT + (size_t)((b * 4 + h) * NCH + SCAN_TC(c)) * 8192, F.tid, R); \
        if (F.tid < 128) D = DEC[(size_t)(u * NCH + (c)) * 128 + F.tid]; \
        if (l == 0 || (c) >= 4) { _Pragma("unroll") for (int m2 = 0; m2 < 4; ++m2) OO[m2] = *(const GAS unsigned long long*)(O + (size_t)(chunk_row0(b, dir, (c)) + 16 * m2 + lr) * HW + h * 128 + 16 * w + 4 * lq); } } while (0)
#define SCAN_STAGE(R, D, set) do { LAS bf16* q_ = (LAS bf16*)(F.lds + (set) * SETB); LAS bf16* k_ = (LAS bf16*)(F.lds + (set) * SETB + 17408); LAS bf16* v_ = (LAS bf16*)(F.lds + (set) * SETB + 35840); \
        _Pragma("unroll") for (int j = 0; j < 2; ++j) { const int e = F.tid + 512 * j; \
            *(LAS v4u*)(q_ + (e >> 4) * 136 + (e & 15) * 8) = R[j]; *(LAS v4u*)(k_ + (e >> 3) * 72 + (e & 7) * 8) = R[2 + j]; *(LAS v4u*)(v_ + (e >> 3) * 72 + (e & 7) * 8) = R[4 + j]; } \
        if (F.tid < 128) ((LAS float*)(F.lds + (set) * SETB + 54272))[F.tid] = D; } while (0)
#define SCAN_STEP(c, RN, DN, ON) do { \
        const int row0 = chunk_row0(b, dir, (c)), set = (c) & 1; const bool outp = (l == 0) || ((c) >= 4); \
        const LAS bf16* Qb = (const LAS bf16*)(F.lds + set * SETB); const LAS bf16* keT = (const LAS bf16*)(F.lds + set * SETB + 17408); const LAS bf16* vT = (const LAS bf16*)(F.lds + set * SETB + 35840); \
        const LAS float* decv = (const LAS float*)(F.lds + set * SETB + 54272); \
        unsigned long long oc_[4], onx_[4]; _Pragma("unroll") for (int m2 = 0; m2 < 4; ++m2) { oc_[m2] = ocur[m2]; onx_[m2] = ON[m2]; } \
        if ((c) + 1 < NCH) SCAN_STAGE(RN, DN, set ^ 1); \
        if ((c) + 3 < NCH) SCAN_LOAD(RN, DN, ON, (c) + 3); \
        if (outp) { \
            bf16x8 sf[4]; \
            _Pragma("unroll") for (int s = 0; s < 4; ++s) { const v4u x = (v4u){pk2(st[2 * s].x, st[2 * s].y), pk2(st[2 * s].z, st[2 * s].w), pk2(st[2 * s + 1].x, st[2 * s + 1].y), pk2(st[2 * s + 1].z, st[2 * s + 1].w)}; sf[s] = __builtin_bit_cast(bf16x8, x); } \
            _Pragma("unroll") for (int mp = 0; mp < 2; ++mp) {          \
                bf16x8 qa_[2][4]; f32x4 o_[2]; \
                _Pragma("unroll") for (int mm = 0; mm < 2; ++mm) { const int m2 = 2 * mp + mm; const LAS bf16* qrow = Qb + (16 * m2 + lr) * 136 + 4 * lq; \
                    _Pragma("unroll") for (int s = 0; s < 4; ++s) { const unsigned long long a0 = *(const LAS unsigned long long*)(qrow + 32 * s), a1 = *(const LAS unsigned long long*)(qrow + 32 * s + 16); \
                        const v4u ax = (v4u){(unsigned)a0, (unsigned)(a0 >> 32), (unsigned)a1, (unsigned)(a1 >> 32)}; qa_[mm][s] = __builtin_bit_cast(bf16x8, ax); } \
                    const unsigned long long ov = oc_[m2]; \
                    o_[mm] = (f32x4){bf2f((unsigned short)(ov & 0xffff)), bf2f((unsigned short)((ov >> 16) & 0xffff)), bf2f((unsigned short)((ov >> 32) & 0xffff)), bf2f((unsigned short)(ov >> 48))}; } \
                _Pragma("unroll") for (int s = 0; s < 4; ++s) \
                    _Pragma("unroll") for (int mm = 0; mm < 2; ++mm) o_[mm] = __builtin_amdgcn_mfma_f32_16x16x32_bf16(sf[s], qa_[mm][s], o_[mm], 0, 0, 0); \
                _Pragma("unroll") for (int mm = 0; mm < 2; ++mm) { const int m2 = 2 * mp + mm; \
                    GAS unsigned long long* op = (GAS unsigned long long*)(O + (size_t)(row0 + 16 * m2 + lr) * HW + h * 128 + 16 * w + 4 * lq); \
                    if (!dry) *op = (unsigned long long)pk2(o_[mm].x, o_[mm].y) | ((unsigned long long)pk2(o_[mm].z, o_[mm].w) << 32); else asm volatile("" :: "v"(o_[mm].x), "v"(o_[mm].y), "v"(o_[mm].z), "v"(o_[mm].w)); } \
            } \
        } \
        { _Pragma("unroll") for (int i = 0; i < 8; ++i) { const f32x4 d4 = *(const LAS f32x4*)(decv + 16 * i + 4 * lq); st[i] = st[i] * d4; } \
          _Pragma("unroll") for (int s2 = 0; s2 < 2; ++s2) { bf16x8 kb_[8];         \
              const bf16x8 va_ = *(const LAS bf16x8*)(vT + (16 * w + lr) * 72 + 32 * s2 + 8 * lq); \
              _Pragma("unroll") for (int i = 0; i < 8; ++i) kb_[i] = *(const LAS bf16x8*)(keT + (16 * i + lr) * 72 + 32 * s2 + 8 * lq); \
              _Pragma("unroll") for (int i = 0; i < 8; ++i) st[i] = __builtin_amdgcn_mfma_f32_16x16x32_bf16(kb_[i], va_, st[i], 0, 0, 0); } } \
        _Pragma("unroll") for (int m2 = 0; m2 < 4; ++m2) ocur[m2] = onx_[m2]; \
        __syncthreads(); } while (0)
    unsigned long long ocur[4];
    SCAN_LOAD(rb, db, ob, 0); SCAN_STAGE(rb, db, 0);
#pragma unroll
    for (int m2 = 0; m2 < 4; ++m2) ocur[m2] = ob[m2];
    SCAN_LOAD(ra, da, oa, 1); SCAN_LOAD(rb, db, ob, 2);
    __syncthreads();
    SCAN_STEP(0, ra, da, oa);
#pragma unroll 1
    for (int c = 1; c + 1 < NCH; c += 2) { SCAN_STEP(c, rb, db, ob); SCAN_STEP(c + 1, ra, da, oa); }
    SCAN_STEP(NCH - 1, rb, db, ob);
#undef SCAN_TC
#undef SCAN_LOAD
#undef SCAN_STAGE
#undef SCAN_STEP
}

#ifndef DIAG_CHECK_PREP
#define DIAG_CHECK_PREP 0
#endif
__device__ __forceinline__ void diag_check_prep(Frame& F, int l) {
    const GAS bf16* KE = (const GAS bf16*)(F.ws + WS_KE); const GAS bf16* VT = (const GAS bf16*)(F.ws + WS_VT); const GAS float* DEC = (const GAS float*)(F.ws + WS_DEC);
    bool bad = false;
    const size_t gt = (size_t)F.vcu * 512 + F.tid, gs = (size_t)F.G * 512;
    for (size_t i = gt; i < (size_t)NSEQ * NCH * 128; i += gs) { const float d = DEC[i]; if (!(d >= 0.f && d <= 1.0001f)) bad = true; }
    for (size_t i = gt; i < (size_t)NSEQ * NCH * 8192; i += gs) { const float k = bf2f(KE[i]); if (!(k >= 0.f && k <= 1.01f)) bad = true; }
    for (size_t i = gt; i < (size_t)NBATCH * 4 * NCH * 8192; i += gs) { const float v = bf2f(VT[i]); if (!(fabsf(v) < 100.f)) bad = true; }
    if (bad) ((float*)(F.ws + WS_MOD))[(size_t)9 * 6144 + 5120] = __builtin_nanf("");
}
#ifndef REP_SCAN
#define REP_SCAN 0
#endif
#ifndef REP_POOL
#define REP_POOL 0
#endif
__device__ __forceinline__ void phase_scan_pool(Frame& F, int l) {
    const bool split = F.G > NSEQ;
    if (!split || F.vcu < NSEQ) { for (int rep = 0; rep < 1 + REP_SCAN; ++rep) for (int u = F.vcu; u < NSEQ; u += F.G) scan_unit(F, l, u, rep < REP_SCAN); }
    if (!split || F.vcu >= NSEQ) {
        const int tc_lo = (l == 0) ? 0 : 4, nit = (NCH - tc_lo) * NBATCH * 4;
        const int start = split ? F.vcu - NSEQ : F.vcu, stride = split ? F.G - NSEQ : F.G;
        for (int rep = 0; rep < 1 + REP_POOL; ++rep) { v4u pr[3];
            if (start < nit) pool_load(F, (start >> 2) & 7, tc_lo + (start >> 5), start & 3, pr);
            for (int it = start; it < nit; it += stride) { const int nx = it + stride; pool_item(F, l, (it >> 2) & 7, tc_lo + (it >> 5), it & 3, pr, nx < nit, (nx >> 2) & 7, tc_lo + (nx >> 5), nx & 3); } }
    }
}
__device__ __forceinline__ void phase_hnorm(Frame& F, int l) {
    const bf16* PX = (const bf16*)(F.ws + WS_PX); const bf16* O = (const bf16*)(F.ws + WS_KV); bf16* Y = (bf16*)(F.ws + WS_HX);
    const int gw = F.vcu * NWAVES + F.wave, NGW = F.G * NWAVES, r_lo = (l == 0) ? 0 : NC;
    const f32x4 w0 = *(const GAS f32x4*)(F.in[10] + l * 128 + (F.lane & 15) * 8), w1 = *(const GAS f32x4*)(F.in[10] + l * 128 + (F.lane & 15) * 8 + 4);
    for (int row = r_lo + gw; row < NTOK; row += NGW) {
        const v4u a = *(const GAS v4u*)(O + (size_t)row * HW + F.lane * 8), bb = *(const GAS v4u*)(O + ((size_t)NTOK + row) * HW + F.lane * 8), gg = *(const GAS v4u*)(PX + (size_t)row * INC + 4 * HW + F.lane * 8);
        float o[8], gt[8];
        o[0] = bf2f((unsigned short)(a.x & 0xffff)) + bf2f((unsigned short)(bb.x & 0xffff)); o[1] = bf2f((unsigned short)(a.x >> 16)) + bf2f((unsigned short)(bb.x >> 16));
        o[2] = bf2f((unsigned short)(a.y & 0xffff)) + bf2f((unsigned short)(bb.y & 0xffff)); o[3] = bf2f((unsigned short)(a.y >> 16)) + bf2f((unsigned short)(bb.y >> 16));
        o[4] = bf2f((unsigned short)(a.z & 0xffff)) + bf2f((unsigned short)(bb.z & 0xffff)); o[5] = bf2f((unsigned short)(a.z >> 16)) + bf2f((unsigned short)(bb.z >> 16));
        o[6] = bf2f((unsigned short)(a.w & 0xffff)) + bf2f((unsigned short)(bb.w & 0xffff)); o[7] = bf2f((unsigned short)(a.w >> 16)) + bf2f((unsigned short)(bb.w >> 16));
        gt[0] = bf2f((unsigned short)(gg.x & 0xffff)); gt[1] = bf2f((unsigned short)(gg.x >> 16)); gt[2] = bf2f((unsigned short)(gg.y & 0xffff)); gt[3] = bf2f((unsigned short)(gg.y >> 16));
        gt[4] = bf2f((unsigned short)(gg.z & 0xffff)); gt[5] = bf2f((unsigned short)(gg.z >> 16)); gt[6] = bf2f((unsigned short)(gg.w & 0xffff)); gt[7] = bf2f((unsigned short)(gg.w >> 16));
        float s = 0.f;
#pragma unroll
        for (int i = 0; i < 8; ++i) s += o[i] * o[i];
        s += shx(s, 1, F.lane); s += shx(s, 2, F.lane); s += shx(s, 4, F.lane); s += shx(s, 8, F.lane);
        const float rn = 1.0f / sqrtf(s * (1.f / 128.f) + EPSN);
        const float wv[8] = {w0.x, w0.y, w0.z, w0.w, w1.x, w1.y, w1.z, w1.w}; float y[8];
#pragma unroll
        for (int i = 0; i < 8; ++i) y[i] = o[i] * rn * wv[i] * (gt[i] * sigmoidf_(gt[i]));
        *(GAS v4u*)(Y + (size_t)row * DM + F.lane * 8) = (v4u){pk2(y[0], y[1]), pk2(y[2], y[3]), pk2(y[4], y[5]), pk2(y[6], y[7])};
    }
}
__device__ __forceinline__ int moe_row_base(int l) { return l == 0 ? 0 : NC; }
__device__ __forceinline__ int moe_half_rows(int l) { return (l == 0 ? NTOK : NX) / NHALF; }


#ifndef DIAG_NAIVE_HGRN
#define DIAG_NAIVE_HGRN 0
#endif
#ifndef DIAG_ROUTER_F32
#define DIAG_ROUTER_F32 0
#endif
#ifndef DIAG_NAIVE_MOE
#define DIAG_NAIVE_MOE 0
#endif
#ifndef DIAG_NAIVE_ROUTE
#define DIAG_NAIVE_ROUTE 0
#endif
#ifndef DIAG_NAIVE_INPROJ
#define DIAG_NAIVE_INPROJ 0
#endif
#ifndef DIAG_NAIVE_OUTPROJ
#define DIAG_NAIVE_OUTPROJ 0
#endif
#ifndef DIAG_CHECK_SLOTS
#define DIAG_CHECK_SLOTS 0
#endif
#ifndef DIAG_NAIVE_MOD
#define DIAG_NAIVE_MOD 0
#endif
#ifndef DIAG_NAIVE_POOL
#define DIAG_NAIVE_POOL 0
#endif
__device__ __forceinline__ void diag_hgrn_scan(Frame& F, int l) {
    LAS float* fz = (LAS float*)(F.lds); LAS float* fk = fz + 128; LAS float* fq = fk + 128; LAS float* fv = fq + 128; LAS float* po = fv + 128;
    const bf16* PX = (const bf16*)(F.ws + WS_PX); float* OBUF = (float*)(F.ws + WS_KV);
    const int v = F.tid & 127, kq = F.tid >> 7;
    for (int it = F.vcu; it < NSEQ; it += F.G) {
        const int dir = it & 1, h = (it >> 1) & 3, b = it >> 3;
        float S[32];
#pragma unroll
        for (int i = 0; i < 32; ++i) S[i] = 0.f;
        const float lb = lb_of(F, l, dir, h * 128 + v), lbf = fmaxf(lb, 1e-30f), oml = 1.0f - lb;
        for (int step = 0; step < CTXL + SEQL; ++step) {
            int row;
            if (step < CTXL) row = b * CTXL + (dir ? CTXL - 1 - step : step);
            else { const int t = step - CTXL; row = NC + b * SEQL + (dir ? SEQL - 1 - t : t); }
            const bf16* pr = PX + (size_t)row * INC;
            if (kq == 0) { const float z = bf2f(pr[dir * HW + h * 128 + v]); const float sg = sigmoidf_(z); fz[v] = lbf + oml * sg; fk[v] = oml * (1.0f - sg); }
            if (kq == 1) { const float q = bf2f(pr[3 * HW + h * 128 + v]); fq[v] = q * sigmoidf_(q) * 0.08838834764831845f; }
            if (kq == 2) fv[v] = bf2f(pr[2 * HW + h * 128 + v]);
            __syncthreads();
            const float vv = fv[v]; float o = 0.f;
#pragma unroll
            for (int i = 0; i < 32; ++i) { const int k = kq * 32 + i; S[i] = fz[k] * S[i] + fk[k] * vv; o += S[i] * fq[k]; }
            po[kq * 128 + v] = o;
            __syncthreads();
            if (kq == 0) OBUF[((size_t)dir * NTOK + row) * HW + h * 128 + v] = (po[v] + po[128 + v]) + (po[256 + v] + po[384 + v]);
        }
        __syncthreads();
    }
}
__device__ __forceinline__ void diag_hgrn_norm(Frame& F, int l) {
    const bf16* PX = (const bf16*)(F.ws + WS_PX); const float* OBUF = (const float*)(F.ws + WS_KV); bf16* Y = (bf16*)(F.ws + WS_HX);
    const int gw = F.vcu * NWAVES + F.wave, NGW = F.G * NWAVES;
    const int r_lo = (l == 0) ? 0 : NC;
    for (int i = gw; i < (NTOK - r_lo) * 4; i += NGW) {
        const int row = r_lo + (i >> 2), h = i & 3;
        const float o0 = OBUF[(size_t)row * HW + h * 128 + F.lane] + OBUF[((size_t)NTOK + row) * HW + h * 128 + F.lane];
        const float o1 = OBUF[(size_t)row * HW + h * 128 + 64 + F.lane] + OBUF[((size_t)NTOK + row) * HW + h * 128 + 64 + F.lane];
        const float rn = 1.0f / sqrtf(wave_sum(o0 * o0 + o1 * o1, F.lane) * (1.f / 128.f) + EPSN);
        const float g0 = bf2f(PX[(size_t)row * INC + 4 * HW + h * 128 + F.lane]), g1 = bf2f(PX[(size_t)row * INC + 4 * HW + h * 128 + 64 + F.lane]);
        Y[(size_t)row * DM + h * 128 + F.lane] = (bf16)f2bf(o0 * rn * F.in[10][l * 128 + F.lane] * (g0 * sigmoidf_(g0)));
        Y[(size_t)row * DM + h * 128 + 64 + F.lane] = (bf16)f2bf(o1 * rn * F.in[10][l * 128 + 64 + F.lane] * (g1 * sigmoidf_(g1)));
    }
}
__device__ __forceinline__ void diag_pool(Frame& F, int l) {
    LAS float* pl = (LAS float*)(F.lds);
    const bf16* PX = (const bf16*)(F.ws + WS_PX); bf16* Y = (bf16*)(F.ws + WS_HX);
    const int sub = F.tid >> 7, d = F.tid & 127;
    const int r_lo = (l == 0) ? 0 : NC;
    for (int it = F.vcu; it < (NTOK - r_lo); it += F.G) {
        const int row = r_lo + it, gi = sub, wdw = 2 << gi, hw2 = wdw >> 1;
        int pos, n, srow;
        if (row < NC) { pos = row % CTXL; n = CTXL; srow = row - pos; } else { pos = (row - NC) % 64; n = 64; srow = row - pos; }
        int lo = pos - hw2, hi = pos + hw2; lo = lo < 0 ? 0 : lo; hi = hi > n ? n : hi;
        float sm = 0.f; for (int r = lo; r < hi; ++r) sm += bf2f(PX[(size_t)(srow + r) * INC + 5 * HW + gi * 128 + d]);
        pl[sub * 128 + d] = sm / (float)(hi - lo) - bf2f(PX[(size_t)row * INC + 5 * HW + gi * 128 + d]);
        __syncthreads();
        const float* wp = F.in[11] + (size_t)(l * 4 + gi) * 128 * 128;
        float o = 0.f; for (int c = 0; c < 128; ++c) o += pl[sub * 128 + c] * wp[c * 128 + d];
        Y[(size_t)row * DM + HW + gi * 128 + d] = (bf16)f2bf(o * F.in[12][l * HW + gi * 128 + d]);
        __syncthreads();
    }
}

__device__ __forceinline__ void diag_moe(Frame& F, int l, int half) {
    LAS float* xs = (LAS float*)(F.lds + F.wave * 16384);
    const bf16* HX = (const bf16*)(F.ws + WS_HX); bf16* YS = (bf16*)(F.ws + WS_YS);
    const int* blke = (const int*)(F.ws + RT_BLKE) + half * MAXBLK; const int* stok = (const int*)(F.ws + RT_STOK) + half * MAXSLOT;
    const int nblk = ((const int*)(F.ws + RT_MISC))[half];
    const int gw = F.vcu * NWAVES + F.wave, NGW = F.G * NWAVES;
    for (int it = gw; it < nblk * 64; it += NGW) {
        const int slot0 = it * 4, e = blke[slot0 >> 8];
        const float* w1 = (e < 64) ? F.in[16] + ((size_t)l * 64 + e) * DM * 256 : F.in[19] + (size_t)l * DM * 256;
        const float* w3 = (e < 64) ? F.in[17] + ((size_t)l * 64 + e) * DM * 256 : F.in[20] + (size_t)l * DM * 256;
        const float* w2 = (e < 64) ? F.in[18] + ((size_t)l * 64 + e) * 256 * DM : F.in[21] + (size_t)l * 256 * DM;
#pragma unroll
        for (int r = 0; r < 4; ++r) { const bf16* xr = HX + (size_t)stok[slot0 + r] * DM;
            for (int k = F.lane; k < DM; k += 64) xs[r * 1024 + k] = bf2f(xr[k]); }
        LDS_WAIT(); asm volatile("" ::: "memory");
        float a1[4][4], a3[4][4];
#pragma unroll
        for (int r = 0; r < 4; ++r)
#pragma unroll
            for (int i = 0; i < 4; ++i) { a1[r][i] = 0.f; a3[r][i] = 0.f; }
        for (int k = 0; k < DM; ++k) {
            float x4[4];
#pragma unroll
            for (int r = 0; r < 4; ++r) x4[r] = xs[r * 1024 + k];
#pragma unroll
            for (int i = 0; i < 4; ++i) { const float u1 = w1[(size_t)k * 256 + F.lane + 64 * i], u3 = w3[(size_t)k * 256 + F.lane + 64 * i];
#pragma unroll
                for (int r = 0; r < 4; ++r) { a1[r][i] += x4[r] * u1; a3[r][i] += x4[r] * u3; } }
        }
        LDS_WAIT(); asm volatile("" ::: "memory");
#pragma unroll
        for (int r = 0; r < 4; ++r)
#pragma unroll
            for (int i = 0; i < 4; ++i) xs[r * 256 + F.lane + 64 * i] = a1[r][i] * sigmoidf_(a1[r][i]) * a3[r][i];
        LDS_WAIT(); asm volatile("" ::: "memory");
#pragma unroll 1
        for (int dh = 0; dh < 4; ++dh) {
            float y[4][4];
#pragma unroll
            for (int r = 0; r < 4; ++r)
#pragma unroll
                for (int i = 0; i < 4; ++i) y[r][i] = 0.f;
            for (int n = 0; n < 256; ++n) {
                float h4[4];
#pragma unroll
                for (int r = 0; r < 4; ++r) h4[r] = xs[r * 256 + n];
#pragma unroll
                for (int i = 0; i < 4; ++i) { const float u = w2[(size_t)n * DM + dh * 256 + F.lane + 64 * i];
#pragma unroll
                    for (int r = 0; r < 4; ++r) y[r][i] += h4[r] * u; }
            }
#pragma unroll
            for (int r = 0; r < 4; ++r)
#pragma unroll
                for (int i = 0; i < 4; ++i) YS[(size_t)(slot0 + r) * DM + dh * 256 + F.lane + 64 * i] = (bf16)f2bf(y[r][i]);
        }
        LDS_WAIT(); asm volatile("" ::: "memory");
    }
}

__device__ __forceinline__ void diag_gemm(Frame& F, int l, int mode) {
    LAS float* As = (LAS float*)(F.lds); LAS float* Bs = As + 16 * 65;
    const int N = mode ? DM : INC, rbase = (mode && l == 1) ? NC : 0, M = NTOK - rbase;
    const bf16* A = (const bf16*)(F.ws + WS_HX) + (size_t)rbase * DM;
    const float* W = mode ? F.in[13] + (size_t)l * DM * DM : F.in[8] + (size_t)l * DM * INC;
    const int ty = F.tid >> 5, tx = F.tid & 31, ntn = N / 128;
    for (int it = F.vcu; it < (M / 64) * ntn; it += F.G) {
        const int m0 = (it / ntn) * 64, n0 = (it % ntn) * 128;
        float acc[4][4];
#pragma unroll
        for (int i = 0; i < 4; ++i)
#pragma unroll
            for (int j = 0; j < 4; ++j) acc[i][j] = 0.f;
        for (int k0 = 0; k0 < DM; k0 += 16) {
            { const int idx = F.tid * 2, r = idx >> 4, kk = idx & 15; const unsigned u = *(const unsigned*)(A + (size_t)(m0 + r) * DM + k0 + kk);
              As[kk * 65 + r] = bf2f((unsigned short)(u & 0xffff)); As[(kk + 1) * 65 + r] = bf2f((unsigned short)(u >> 16)); }
            { const int r = F.tid >> 5, c4 = (F.tid & 31) * 4; *(LAS f32x4*)(Bs + r * 128 + c4) = *(const GAS f32x4*)(W + (size_t)(k0 + r) * N + n0 + c4); }
            __syncthreads();
#pragma unroll
            for (int kk = 0; kk < 16; ++kk) { float a[4]; f32x4 b = *(const LAS f32x4*)(Bs + kk * 128 + tx * 4);
#pragma unroll
                for (int i = 0; i < 4; ++i) a[i] = As[kk * 65 + ty * 4 + i];
#pragma unroll
                for (int i = 0; i < 4; ++i) { acc[i][0] += a[i] * b.x; acc[i][1] += a[i] * b.y; acc[i][2] += a[i] * b.z; acc[i][3] += a[i] * b.w; } }
            __syncthreads();
        }
#pragma unroll
        for (int i = 0; i < 4; ++i) { const int row = rbase + m0 + ty * 4 + i, col = n0 + tx * 4;
            if (mode == 0) { bf16* px = (bf16*)(F.ws + WS_PX) + (size_t)row * INC + col;
                *(unsigned long long*)px = (unsigned long long)pk2(acc[i][0], acc[i][1]) | ((unsigned long long)pk2(acc[i][2], acc[i][3]) << 32); }
            else { const float* bp = resid_in_row(F, l, row) + col; float* op = resid_row(F, row) + col; const float* gt = (const float*)(F.ws + WS_MOD) + ((size_t)l * 9 + mod_row(row)) * 6144 + 2048 + col;
                const f32x4 b = *(const GAS f32x4*)bp, g = *(const GAS f32x4*)gt; *(GAS f32x4*)op = (f32x4){b.x + g.x * acc[i][0], b.y + g.y * acc[i][1], b.z + g.z * acc[i][2], b.w + g.w * acc[i][3]}; } }
    }
}

__device__ __forceinline__ void diag_check_slots(Frame& F, int l) {
    const int rb = moe_row_base(l), nhalf = moe_half_rows(l);
    const int* IDX = (const int*)(F.ws + RT_IDX); const int* TSLOT = (const int*)(F.ws + RT_TSLOT); const int* STOK = (const int*)(F.ws + RT_STOK); const int* BLKE = (const int*)(F.ws + RT_BLKE); const int* MISCT = (const int*)(F.ws + RT_MISC);
    bool bad = false;
    for (int a = F.vcu * 512 + F.tid; a < 2 * nhalf * 6; a += F.G * 512) {
        const int row = rb + a / 6, half = (a / 6) >= nhalf ? 1 : 0; const int slot = TSLOT[(size_t)rb * 6 + a], e = IDX[(size_t)rb * 6 + a];
        if (slot < 0 || slot >= MISCT[half] * 256) bad = true;
        else { if (STOK[half * MAXSLOT + slot] != row) bad = true; if (BLKE[half * MAXBLK + (slot >> 8)] != e) bad = true; }
    }
    for (int i = F.vcu * 512 + F.tid; i < 2 * nhalf; i += F.G * 512) { const int half = i >= nhalf ? 1 : 0, ii = i - half * nhalf; const int slot = MISCT[2 + half] + ii;
        if (STOK[half * MAXSLOT + slot] != rb + i) bad = true; if (BLKE[half * MAXBLK + (slot >> 8)] != 64) bad = true; }
    if (bad) F.out[0] = __builtin_nanf("");
    if (bad) ((float*)(F.ws + WS_MOD))[5120] = __builtin_nanf("");
}

__device__ __forceinline__ void diag_mod(Frame& F) {
    float* mod = (float*)(F.ws + WS_MOD);
    for (int i = F.vcu * 512 + F.tid; i < 2 * 6144; i += F.G * 512) {
        const int l = i / 6144, n = i % 6144; float acc[9];
        for (int r = 0; r < 9; ++r) acc[r] = 0.f;
        for (int k = 0; k < DM; ++k) { const float w = F.in[6][((size_t)l * DM + k) * 6144 + n];
            for (int r = 0; r < 9; ++r) { const float c = (r < 8) ? F.in[1][r * DM + k] : F.in[3][k]; acc[r] += (c / (1.0f + expf(-c))) * w; } }
        for (int r = 0; r < 9; ++r) mod[((size_t)l * 9 + r) * 6144 + n] = acc[r] + F.in[7][(size_t)l * 6144 + n];
    }
}

__device__ __forceinline__ void phase_route(Frame& F, int l, bool dry = false) {
    LAS bf16* Xt = (LAS bf16*)(F.lds);
    LAS float* Lg = (LAS float*)(F.lds + 32 * 2064);
    LAS unsigned* lcnt = (LAS unsigned*)(F.lds + 32 * 2064 + 8192);
    const GAS float* mod = (const GAS float*)(F.ws + WS_MOD) + (size_t)l * 9 * 6144;
    GAS bf16* HX = (GAS bf16*)(F.ws + WS_HX); const GAS bf16* WrT = (const GAS bf16*)(F.ws + WS_WR);
    GAS int* IDX = (GAS int*)(F.ws + RT_IDX); GAS float* GATE = (GAS float*)(F.ws + RT_GATE);
    const int rb = moe_row_base(l), nhalf = moe_half_rows(l), ntiles = NHALF * nhalf / 32;
    const int lr = F.lane & 15, lq = F.lane >> 4, w = F.wave;
    if (F.tid < 128) lcnt[F.tid] = 0u;
    if (F.vcu == 0) { unsigned z0 = 0u; asm volatile("" : "+v"(z0)); for (int i = F.tid; i < DM / 16; i += 512) ((GAS v4u*)((GAS unsigned char*)HX + (size_t)NTOK * DM))[i] = (v4u){z0, z0, z0, z0}; }
    const int mt = w >> 2, nt = w & 3;
    bf16x8 wf[32];
#pragma unroll
    for (int s2 = 0; s2 < 32; ++s2) wf[s2] = *(const GAS bf16x8*)(WrT + (size_t)(16 * nt + lr) * DM + 32 * s2 + 8 * lq);
    const float rbias = ((const GAS float*)F.in[15])[l * NE + F.lane];
    const GAS f32x4* nw = (const GAS f32x4*)(F.in[5] + l * DM);
    __syncthreads();
    for (int it = F.vcu; it < ntiles; it += F.G) {
        const int row0 = rb + it * 32;
        { f32x4 xv[4][4];
#pragma unroll
          for (int i = 0; i < 4; ++i) { const GAS f32x4* xr = (const GAS f32x4*)resid_row(F, row0 + w * 4 + i) + F.lane;
#pragma unroll
              for (int j = 0; j < 4; ++j) xv[i][j] = xr[64 * j]; }
#pragma unroll
          for (int i = 0; i < 4; ++i) { const int lrow = w * 4 + i, row = row0 + lrow; const GAS float* md = mod + mod_row(row) * 6144;
              float ss = 0.f;
#pragma unroll
              for (int j = 0; j < 4; ++j) ss += (xv[i][j].x * xv[i][j].x + xv[i][j].y * xv[i][j].y) + (xv[i][j].z * xv[i][j].z + xv[i][j].w * xv[i][j].w);
              const float r = 1.0f / sqrtf(wave_sum(ss, F.lane) * (1.f / DM) + EPSN);
#pragma unroll
              for (int j = 0; j < 4; ++j) { const f32x4 w4 = nw[F.lane + 64 * j], s4 = ((const GAS f32x4*)(md + 4096))[F.lane + 64 * j], h4 = ((const GAS f32x4*)(md + 3072))[F.lane + 64 * j];
                  const f32x4 o = (xv[i][j] * r) * w4 * (s4 + 1.0f) + h4;
                  const unsigned long long pk = (unsigned long long)pk2(o.x, o.y) | ((unsigned long long)pk2(o.z, o.w) << 32);
                  int w8 = 0; w8 = __builtin_amdgcn_cvt_pk_fp8_f32(o.x, o.y, w8, false); w8 = __builtin_amdgcn_cvt_pk_fp8_f32(o.z, o.w, w8, true);
                  ((GAS unsigned*)((GAS unsigned char*)HX + (size_t)row * DM))[F.lane + 64 * j] = (unsigned)w8;
                  *(LAS unsigned long long*)(Xt + lrow * 1032 + 4 * (F.lane + 64 * j)) = pk; } } }
        __syncthreads();
        { const float zf = opaque_zero(); f32x4 a4 = (f32x4){zf, zf, zf, zf};
#pragma unroll
          for (int s2 = 0; s2 < 32; ++s2) { const bf16x8 a = *(const LAS bf16x8*)(Xt + (16 * mt + lr) * 1032 + 32 * s2 + 8 * lq); a4 = __builtin_amdgcn_mfma_f32_16x16x32_bf16(wf[s2], a, a4, 0, 0, 0); }
          *(LAS f32x4*)(Lg + (16 * mt + lr) * 64 + 16 * nt + 4 * lq) = a4; }
        __syncthreads();
        { float sc[4], bs[4], gs[4], msk[4], ssum[4], myg2[4]; int myi[4], sel[4];
#pragma unroll
          for (int i = 0; i < 4; ++i) { sc[i] = sigmoidf_(Lg[(w * 4 + i) * 64 + F.lane]); bs[i] = sc[i] + rbias; ssum[i] = 0.f; sel[i] = 0; myi[i] = 0; myg2[i] = 0.f; }
          { float m1[4], m2[4];
#pragma unroll
            for (int i = 0; i < 4; ++i) m1[i] = bs[i];
#pragma unroll
            for (int o = 1; o < 8; o <<= 1)
#pragma unroll
                for (int i = 0; i < 4; ++i) m1[i] = fmaxf(m1[i], shx(m1[i], o, F.lane));
            const int gb = F.lane & ~7;
#pragma unroll
            for (int i = 0; i < 4; ++i) { const unsigned long long bal = __ballot(bs[i] == m1[i]); const unsigned gm = (unsigned)((bal >> gb) & 0xffull); const int first = gb + __ffs((int)gm) - 1; m2[i] = (F.lane == first) ? -3.0e38f : bs[i]; }
#pragma unroll
            for (int o = 1; o < 8; o <<= 1)
#pragma unroll
                for (int i = 0; i < 4; ++i) m2[i] = fmaxf(m2[i], shx(m2[i], o, F.lane));
#pragma unroll
            for (int i = 0; i < 4; ++i) gs[i] = m1[i] + m2[i]; }
          { const int myg = F.lane >> 3; int rank[4] = {0, 0, 0, 0};
#pragma unroll
            for (int g2 = 0; g2 < 8; ++g2)
#pragma unroll
                for (int i = 0; i < 4; ++i) { const float og = shl(gs[i], g2 * 8); rank[i] += ((og > gs[i]) || (og == gs[i] && g2 < myg)) ? 1 : 0; }
#pragma unroll
            for (int i = 0; i < 4; ++i) msk[i] = (rank[i] < 4) ? bs[i] : -1.0e4f; }
#pragma unroll
          for (int jj = 0; jj < 6; ++jj) { float mx[4];
#pragma unroll
              for (int i = 0; i < 4; ++i) mx[i] = msk[i];
#pragma unroll
              for (int o = 1; o < 64; o <<= 1)
#pragma unroll
                  for (int i = 0; i < 4; ++i) mx[i] = fmaxf(mx[i], shx(mx[i], o, F.lane));
#pragma unroll
              for (int i = 0; i < 4; ++i) { const unsigned long long b2 = __ballot(msk[i] == mx[i]); const int win = __ffsll((long long)b2) - 1;
                  const float wv = shl(sc[i], win); ssum[i] += wv; if (F.lane == jj) { myi[i] = win; myg2[i] = wv; } if (F.lane == win) { msk[i] = -3.0e38f; sel[i] = 1; } } }
#pragma unroll
          for (int i = 0; i < 4; ++i) { const int row = row0 + w * 4 + i; const float inv = 2.5f / ssum[i];
              if (F.lane < 6) { IDX[(size_t)row * 6 + F.lane] = myi[i]; GATE[(size_t)row * 6 + F.lane] = myg2[i] * inv; }
              const int half = (row - rb) >= nhalf ? 1 : 0;
              if (sel[i] && !dry) __hip_atomic_fetch_add(&lcnt[half * 64 + F.lane], 1u, __ATOMIC_RELAXED, __HIP_MEMORY_SCOPE_WORKGROUP); } }
        __syncthreads();
    }
    __syncthreads();
    if (F.tid < 128) { const unsigned v = lcnt[F.tid]; if (v) atomicAdd(F.ctl + CW_CNT + l * 128 + F.tid, v); }
}

__device__ __forceinline__ void phase_slots(Frame& F, int l) {
    LAS int* pstart = (LAS int*)(F.lds);
    LAS int* cntl = (LAS int*)(F.lds + 1024);
    LAS unsigned* lc = (LAS unsigned*)(F.lds + 2048);
    LAS unsigned* lbase = (LAS unsigned*)(F.lds + 2560);
    const int rb = moe_row_base(l), nhalf = moe_half_rows(l);
    const int* IDX = (const int*)(F.ws + RT_IDX); int* TSLOT = (int*)(F.ws + RT_TSLOT); int* STOK = (int*)(F.ws + RT_STOK); int* BLKE = (int*)(F.ws + RT_BLKE); int* MISC = (int*)(F.ws + RT_MISC);
    if (F.tid < 128) cntl[F.tid] = (int)__hip_atomic_load(F.ctl + CW_CNT + l * 128 + F.tid, __ATOMIC_RELAXED, __HIP_MEMORY_SCOPE_AGENT);
    __syncthreads();
    if (F.tid < NHALF) { int s = 0; for (int e = 0; e < 64; ++e) { pstart[F.tid * 66 + e] = s; s += (cntl[F.tid * 64 + e] + 255) & ~255; } pstart[F.tid * 66 + 64] = s; pstart[F.tid * 66 + 65] = s + nhalf; }
    __syncthreads();
    for (int w = F.vcu; w < NHALF * 65; w += F.G) {
        const int half = w / 65, e = w % 65; int* stok = STOK + half * MAXSLOT; int* blke = BLKE + half * MAXBLK;
        const int ps = pstart[half * 66 + e], pe = pstart[half * 66 + e + 1];
        for (int b = ps / 256 + F.tid; b < pe / 256; b += 512) blke[b] = e;
        if (e < 64) { for (int s = ps + cntl[half * 64 + e] + F.tid; s < pe; s += 512) stok[s] = NTOK; }
        else { for (int i = F.tid; i < nhalf; i += 512) stok[ps + i] = rb + half * nhalf + i;
               if (F.tid == 0) { MISC[half] = pe / 256; MISC[2 + half] = ps; } }
    }
    const int tpc = NHALF * nhalf / 256;
    for (int ck = F.vcu; ck < 256; ck += F.G) {
        const int half = (ck * tpc) / nhalf, tok0 = rb + ck * tpc; int* stok = STOK + half * MAXSLOT;
        if (F.tid < 64) lc[F.tid] = 0u;
        __syncthreads();
        int e0 = -1, e1 = -1; unsigned p0 = 0, p1 = 0; const int a0 = F.tid, a1 = F.tid + 512;
        if (a0 < tpc * 6) { e0 = IDX[(size_t)tok0 * 6 + a0]; p0 = __hip_atomic_fetch_add(&lc[e0], 1u, __ATOMIC_RELAXED, __HIP_MEMORY_SCOPE_WORKGROUP); }
        if (a1 < tpc * 6) { e1 = IDX[(size_t)tok0 * 6 + a1]; p1 = __hip_atomic_fetch_add(&lc[e1], 1u, __ATOMIC_RELAXED, __HIP_MEMORY_SCOPE_WORKGROUP); }
        __syncthreads();
        if (F.tid < 64) { const unsigned n = lc[F.tid]; lbase[F.tid] = n ? atomicAdd(F.ctl + CW_CUR + l * 128 + half * 64 + F.tid, n) : 0u; }
        __syncthreads();
        if (e0 >= 0) { const int slot = pstart[half * 66 + e0] + (int)(lbase[e0] + p0); stok[slot] = tok0 + a0 / 6; TSLOT[(size_t)tok0 * 6 + a0] = slot; }
        if (e1 >= 0) { const int slot = pstart[half * 66 + e1] + (int)(lbase[e1] + p1); stok[slot] = tok0 + a1 / 6; TSLOT[(size_t)tok0 * 6 + a1] = slot; }
        __syncthreads();
    }
}

__device__ __forceinline__ void phase_combine(Frame& F, int l, int half) {
    const int gw = F.vcu * NWAVES + F.wave, NGW = F.G * NWAVES;
    const int rb = moe_row_base(l), nhalf = moe_half_rows(l);
    const GAS float* mod = (const GAS float*)(F.ws + WS_MOD) + (size_t)l * 9 * 6144;
    const GAS int* TSLOT = (const GAS int*)(F.ws + RT_TSLOT); const GAS float* GATE = (const GAS float*)(F.ws + RT_GATE); const int* MISC = (const int*)(F.ws + RT_MISC);
    const GAS unsigned char* YS = (const GAS unsigned char*)(F.ws + WS_YS); GAS bf16* HX = (GAS bf16*)(F.ws + WS_HX);
    const int shs = MISC[2 + half], c0 = 8 * F.lane;
    int sl[6]; float gj[6];
    if (gw < nhalf) { const size_t a = (size_t)(rb + half * nhalf + gw) * 6;
#pragma unroll
        for (int j = 0; j < 6; ++j) { sl[j] = TSLOT[a + j]; gj[j] = GATE[a + j]; } }
    for (int i = gw; i < nhalf; i += NGW) {
        const int row = rb + half * nhalf + i;
        GAS float* xr = (GAS float*)resid_row(F, row); const GAS float* gt = mod + mod_row(row) * 6144 + 5120;
        unsigned long long ya[7][2];
#pragma unroll
        for (int j = 0; j < 6; ++j) { const GAS unsigned char* yp = YS + (size_t)sl[j] * DM + c0; ya[j][0] = *(const GAS unsigned long long*)yp; ya[j][1] = *(const GAS unsigned long long*)(yp + 512); }
        { const GAS unsigned char* yp = YS + (size_t)(shs + i) * DM + c0; ya[6][0] = *(const GAS unsigned long long*)yp; ya[6][1] = *(const GAS unsigned long long*)(yp + 512); }
        f32x4 xv[4], g4[4];
#pragma unroll
        for (int q = 0; q < 4; ++q) { const int co = c0 + (q >> 1) * 512 + (q & 1) * 4; xv[q] = *(const GAS f32x4*)(xr + co); g4[q] = *(const GAS f32x4*)(gt + co); }
        float gc[7];
#pragma unroll
        for (int j = 0; j < 6; ++j) gc[j] = gj[j] * (1.0f / pg8::YS_SCALE);
        gc[6] = 1.0f / pg8::YS_SCALE;
        if (i + NGW < nhalf) { const size_t a = (size_t)(row + NGW) * 6;
#pragma unroll
            for (int j = 0; j < 6; ++j) { sl[j] = TSLOT[a + j]; gj[j] = GATE[a + j]; } }
        float y[16]; const float zf = opaque_zero();
#pragma unroll
        for (int k = 0; k < 16; ++k) y[k] = zf;
#pragma unroll
        for (int j = 0; j < 7; ++j)
#pragma unroll
            for (int hh = 0; hh < 2; ++hh) { const int lo = (int)(unsigned)ya[j][hh], hi = (int)(unsigned)(ya[j][hh] >> 32);
                const pg8::f32v2_t a0 = __builtin_amdgcn_cvt_pk_f32_fp8(lo, false), a1 = __builtin_amdgcn_cvt_pk_f32_fp8(lo, true), a2 = __builtin_amdgcn_cvt_pk_f32_fp8(hi, false), a3 = __builtin_amdgcn_cvt_pk_f32_fp8(hi, true);
                y[8 * hh + 0] += gc[j] * a0.x; y[8 * hh + 1] += gc[j] * a0.y; y[8 * hh + 2] += gc[j] * a1.x; y[8 * hh + 3] += gc[j] * a1.y;
                y[8 * hh + 4] += gc[j] * a2.x; y[8 * hh + 5] += gc[j] * a2.y; y[8 * hh + 6] += gc[j] * a3.x; y[8 * hh + 7] += gc[j] * a3.y; }
        float ss = 0.f;
#pragma unroll
        for (int q = 0; q < 4; ++q) { xv[q] = xv[q] + g4[q] * (f32x4){y[4 * q], y[4 * q + 1], y[4 * q + 2], y[4 * q + 3]};
            ss += (xv[q].x * xv[q].x + xv[q].y * xv[q].y) + (xv[q].z * xv[q].z + xv[q].w * xv[q].w); }
        const float r = 1.0f / sqrtf(wave_sum(ss, F.lane) * (1.f / DM) + EPSN);
        if (l == 1) {
#pragma unroll
            for (int q = 0; q < 4; ++q) { const int co = c0 + (q >> 1) * 512 + (q & 1) * 4; const f32x4 w4 = *(const GAS f32x4*)((const GAS float*)F.in[22] + co); *(GAS f32x4*)(xr + co) = xv[q] * r * w4; }
        } else {
            const GAS float* md1 = mod + (size_t)(9 + mod_row(row)) * 6144; const GAS float* nw = (const GAS float*)F.in[4] + DM;
            unsigned pk[8];
#pragma unroll
            for (int q = 0; q < 4; ++q) { const int co = c0 + (q >> 1) * 512 + (q & 1) * 4; *(GAS f32x4*)(xr + co) = xv[q];
                const f32x4 w4 = *(const GAS f32x4*)(nw + co), s4 = *(const GAS f32x4*)(md1 + 1024 + co), h4 = *(const GAS f32x4*)(md1 + co);
                const f32x4 o = (xv[q] * r) * w4 * (s4 + 1.0f) + h4; pk[2 * q] = pk2(o.x, o.y); pk[2 * q + 1] = pk2(o.z, o.w); }
            *(GAS v4u*)(HX + (size_t)row * DM + c0) = (v4u){pk[0], pk[1], pk[2], pk[3]}; *(GAS v4u*)(HX + (size_t)row * DM + 512 + c0) = (v4u){pk[4], pk[5], pk[6], pk[7]};
        }
    }
}

constexpr int PH_PER_LAYER = 14, N_PHASES = 1 + 2 * PH_PER_LAYER;
#ifndef MK_PER_PHASE
#define MK_PER_PHASE 0
#endif
struct Args { const float* in[23]; float* out; unsigned char* ws; int ph_lo, ph_hi; };
__global__ void __launch_bounds__(NWAVES * 64, 2) mk_fwd(Args args) {
    {
        LAS unsigned char* lds = (LAS unsigned char*)g_lds;
        for (int u = threadIdx.x; u < (LDS_BYTES - LDSCTL_OFF) / 4; u += NWAVES * 64) ((LAS unsigned*)(lds + LDSCTL_OFF))[u] = 0u;
        __syncthreads();
        LAS unsigned long long* tab = (LAS unsigned long long*)(lds + TAB_OFF);
        if (threadIdx.x < 23) tab[threadIdx.x] = (unsigned long long)args.in[threadIdx.x];
        if (threadIdx.x == 23) tab[23] = (unsigned long long)args.out;
        if (threadIdx.x == 24) tab[24] = (unsigned long long)args.ws;
        __syncthreads();
#if !MK_PER_PHASE
        if (threadIdx.x == 0) (void)xb_add((unsigned*)(args.ws + WS_CTL) + CW_BAR + XB_XCNT(xb_xcc_id()), 1u);
#endif
    }
#if MK_PER_PHASE
    const int lo = args.ph_lo, hi = args.ph_hi;
#define IN(k) (lo <= (k) && (k) < hi)
#define SEAM(k) do { } while (0)
#else
#define IN(k) true
#define SEAM(k) do { grid_barrier(); if (REP_MASK & 0x10000u) { grid_barrier(); grid_barrier(); } if (TIMING_MASK) { if (blockIdx.x == 0 && threadIdx.x == 0) ((unsigned long long*)(args.ws + WS_CTL + 65536))[1 + seam_id] = __builtin_amdgcn_s_memrealtime(); ++seam_id; } } while (0)
#endif
#ifndef GEMM2_STAGGER
#define GEMM2_STAGGER 0
#endif
#ifndef REP_MASK
#define REP_MASK 0u
#endif
#ifndef TIMING_MASK
#define TIMING_MASK 0u
#endif
#define REP(c) (1 + ((REP_MASK >> (c)) & 1u))
#ifndef PH_MASK
#define PH_MASK 0xffffffffu
#endif
#define INM(k, c) (IN(k) && ((PH_MASK >> (c)) & 1u))
    int seam_id = 0; (void)seam_id;
    if (TIMING_MASK) { if (blockIdx.x == 0 && threadIdx.x == 0) ((unsigned long long*)(args.ws + WS_CTL + 65536))[0] = __builtin_amdgcn_s_memrealtime(); }
    if (INM(0, 0)) { Frame F = make_frame(); phase_mod(F); __syncthreads(); for (int rep = 0; rep < REP(12); ++rep) phase_wconv(F, 0); }
    SEAM(0);
#if DIAG_NAIVE_MOD
    { Frame F = make_frame(); diag_mod(F); } SEAM(0);
#endif
#pragma unroll 1
    for (int l = 0; l < 2; ++l) {
        const int P = 1 + l * PH_PER_LAYER; (void)P;
        if (l == 0) {
            if (INM(P + 0, 1)) for (int rep = 0; rep < REP(1); ++rep) { Frame F = make_frame(); phase_hx(F, l); }
            SEAM(P + 0);
        }
#if DIAG_NAIVE_INPROJ
        { Frame F = make_frame(); diag_gemm(F, l, 0); }
#else
        if (INM(P + 1, 2)) for (int rep = 0; rep < REP(2); ++rep) {
            Frame F = make_frame(); unsigned char* ws = F.ws;
            pg8::Gemm g{(const bf16*)(ws + WS_HX), (const bf16*)(ws + WS_WIN), DM, nullptr}; pg8::StaticOrder S; S.init(NTOK, INC, F.G, (int)blockIdx.x);
            pg8::EpiB16 E{(bf16*)(ws + WS_PX), INC, 0xffff};
            pg8::gemm_phase<pg8::EpiB16, pg8::StaticOrder, true, false>(F.lds, g, S, E);
        }
#endif
        SEAM(P + 1);
        if (INM(P + 2, 3)) for (int rep = 0; rep < REP(13); ++rep) { Frame F = make_frame(); phase_prep(F, l); }
        SEAM(P + 2);
#if DIAG_CHECK_PREP
        { Frame F = make_frame(); diag_check_prep(F, l); } SEAM(P + 2);
#endif
        if (INM(P + 2, 3)) { Frame F = make_frame(); phase_scan_pool(F, l); }
        SEAM(P + 2);
        if (INM(P + 3, 4)) for (int rep = 0; rep < REP(4); ++rep) { Frame F = make_frame(); phase_hnorm(F, l); }
        SEAM(P + 3);
#if DIAG_NAIVE_HGRN
        { Frame F = make_frame(); diag_hgrn_scan(F, l); } SEAM(P + 4);
        { Frame F = make_frame(); diag_hgrn_norm(F, l); } SEAM(P + 4);
#endif
#if DIAG_NAIVE_POOL
        { Frame F = make_frame(); diag_pool(F, l); } SEAM(P + 4);
#endif
#if DIAG_NAIVE_OUTPROJ
        { Frame F = make_frame(); diag_gemm(F, l, 1); }
#else
        if (INM(P + 5, 6)) for (int rep = 0; rep < (l == 0 ? REP(6) : 1); ++rep) {
            Frame F = make_frame(); unsigned char* ws = F.ws;
            const int rbase = l == 0 ? 0 : NC;
            pg8::Gemm g{(const bf16*)(ws + WS_HX) + (size_t)rbase * DM, (const bf16*)(ws + WS_WOUT), DM, nullptr}; pg8::StaticOrder S; S.init(NTOK - rbase, DM, F.G, (int)blockIdx.x);
            pg8::EpiRes E{l == 0 ? F.in[2] : (const float*)(ws + WS_CTXRES), l == 0 ? F.in[0] : (const float*)F.out, (float*)(ws + WS_CTXRES), F.out, (const float*)(ws + WS_MOD) + (size_t)l * 9 * 6144, 2048, rbase};
            pg8::gemm_phase<pg8::EpiRes, pg8::StaticOrder, true, false>(F.lds, g, S, E);
        }
#endif
        SEAM(P + 5);
        if (INM(P + 6, 7)) for (int rep = 0; rep < REP(7); ++rep) { Frame F = make_frame(); phase_route(F, l, rep + 1 < REP(7)); }
        SEAM(P + 6);
        if (INM(P + 7, 8)) { Frame F = make_frame(); phase_slots(F, l); }
        SEAM(P + 7);
#if DIAG_CHECK_SLOTS
        { Frame F = make_frame(); diag_check_slots(F, l); } SEAM(P + 7);
#endif
#pragma unroll 1
        for (int half = 0; half < NHALF; ++half) {
            const int Q = P + 8 + 3 * half; (void)Q;
            if (INM(Q + 0, 9)) for (int rep = 0; rep < REP(9); ++rep) {
                Frame F = make_frame(); unsigned char* ws = F.ws;
                const int* blke = (const int*)(ws + RT_BLKE) + half * MAXBLK; const int* stok = (const int*)(ws + RT_STOK) + half * MAXSLOT;
                const int nblk = __builtin_amdgcn_readfirstlane(((const int*)(ws + RT_MISC))[half]);
                int k1 = DM / 2; asm volatile("" : "+s"(k1));
                pg8::Gemm g{(const bf16*)(ws + WS_HX), (const bf16*)(ws + WS_W13), k1, stok}; pg8::MoeOrder S{blke, nblk, 2, F.G, F.vcu};
                pg8::EpiSwiglu E{(bf16*)(ws + WS_HS)};
                pg8::gemm_phase<pg8::EpiSwiglu, pg8::MoeOrder, true, true, true>(F.lds, g, S, E);
            }
            SEAM(Q + 0);
            if (INM(Q + 1, 10)) for (int rep = 0; rep < REP(10); ++rep) {
                Frame F = make_frame(); unsigned char* ws = F.ws;
                const int* blke = (const int*)(ws + RT_BLKE) + half * MAXBLK;
                const int nblk = __builtin_amdgcn_readfirstlane(((const int*)(ws + RT_MISC))[half]);
                if (GEMM2_STAGGER && (F.vcu & 1)) { const unsigned long long t0 = __builtin_amdgcn_s_memrealtime(); while (__builtin_amdgcn_s_memrealtime() - t0 < (unsigned long long)GEMM2_STAGGER) __builtin_amdgcn_s_sleep(8); }
                int k2 = 256; asm volatile("" : "+s"(k2));
                pg8::Gemm g{(const bf16*)(ws + WS_HS), (const bf16*)(ws + WS_W2), k2, nullptr}; pg8::MoeOrder S{blke, nblk, 4, F.G, F.vcu};
                pg8::EpiF8 E{(unsigned char*)(ws + WS_YS), 3, (rep + 1 < (int)REP(10)) ? 1 : 0};
                pg8::gemm_phase<pg8::EpiF8, pg8::MoeOrder, true, false>(F.lds, g, S, E);
            }
            SEAM(Q + 1);
#if DIAG_NAIVE_MOE
            { Frame F = make_frame(); diag_moe(F, l, half); } SEAM(Q + 1);
#endif
            if (INM(Q + 2, 11)) { Frame F = make_frame(); phase_combine(F, l, half); if (l == 0 && half == NHALF - 1) for (int rep = 0; rep < REP(12); ++rep) phase_wconv(F, 1); }
            if (!(l == 1 && half == NHALF - 1)) SEAM(Q + 2);
        }
    }
    if (TIMING_MASK) {
        SEAM(99);
        const unsigned long long* ts = (const unsigned long long*)(args.ws + WS_CTL + 65536);
        unsigned long long tk = 0ull;
        for (int k = 0; k < seam_id && k < 32; ++k) if ((TIMING_MASK >> k) & 1u) tk += ts[1 + k] - ts[k];
        const float a = sqrtf((float)((tk / 2500ull) * 2500ull) * 0.0001f);
        for (size_t i = (size_t)blockIdx.x * 512 + threadIdx.x; i < (size_t)NX * DM; i += (size_t)gridDim.x * 512) args.out[i] = a;
    }
#undef IN
#undef INM
#undef SEAM
}

extern "C" void kernel_launch(void* const* d_in, const int* in_sizes, int n_in, void* d_out, int out_size, void* d_ws, size_t ws_size, hipStream_t stream) {
    static int grid = 0;
    if (grid == 0) {
        if (n_in != 23 || out_size != NX * DM || ws_size < WS_END) { fprintf(stderr, "kernel_launch: unexpected shapes (n_in %d, out %d, ws %zu); nothing launched\n", n_in, out_size, ws_size); grid = -1; return; }
        int dev = 0, cus = 0;
        if (hipGetDevice(&dev) != hipSuccess || hipDeviceGetAttribute(&cus, hipDeviceAttributeMultiprocessorCount, dev) != hipSuccess) { grid = -1; return; }
        if (hipFuncSetAttribute((const void*)mk_fwd, hipFuncAttributeMaxDynamicSharedMemorySize, LDS_BYTES) != hipSuccess) { fprintf(stderr, "kernel_launch: hipFuncSetAttribute failed\n"); grid = -1; return; }
        (void)hipGetLastError();
        grid = cus;
    }
    if (grid < 0) return;
    if (hipMemsetAsync((char*)d_ws + WS_CTL, 0, CTL_ZERO_BYTES, stream) != hipSuccess) { fprintf(stderr, "kernel_launch: memset failed\n"); return; }
    Args a{};
    for (int i = 0; i < 23; ++i) a.in[i] = (const float*)d_in[i];
    a.out = (float*)d_out; a.ws = (unsigned char*)d_ws;
#if MK_PER_PHASE
    for (int p = 0; p < N_PHASES; ++p) { a.ph_lo = p; a.ph_hi = p + 1; hipLaunchKernelGGL(mk_fwd, dim3(grid), dim3(NWAVES * 64), LDS_BYTES, stream, a); }
#else
    a.ph_lo = 0; a.ph_hi = N_PHASES;
    hipLaunchKernelGGL(mk_fwd, dim3(grid), dim3(NWAVES * 64), LDS_BYTES, stream, a);
#endif
    const hipError_t le = hipPeekAtLastError();
    if (le != hipSuccess) fprintf(stderr, "kernel_launch: launch failed: %s\n", hipGetErrorName(le));
}
```

```cpp
#include <hip/hip_runtime.h>
#include <cstdio>
#include <cstdint>
namespace pg8 {
#define PG8_LAS __attribute__((address_space(3)))
typedef unsigned short bf16_t;
typedef short bf16x8 __attribute__((ext_vector_type(8)));
typedef float f32x4 __attribute__((ext_vector_type(4)));
typedef unsigned u32x4 __attribute__((ext_vector_type(4)));
typedef int v4i_t __attribute__((ext_vector_type(4)));
typedef int v8i_t __attribute__((ext_vector_type(8)));
__device__ __forceinline__ int opaque_tid() { int t = threadIdx.x; asm volatile("" : "+v"(t)); return t; }
constexpr int BM = 256, BK = 64, HALF = 128, HTB = HALF * BK * 2  , STAGE_BYTES = 8 * HTB, NXCD = 8, WGM = 8;

__host__ __device__ __forceinline__ int lds_byte(int r, int c) { const int st = (r >> 4) * 2 + (c >> 5), rr = r & 15, cc = c & 31, ob = rr * 64 + cc * 2; return st * 1024 + (ob ^ (((ob >> 9) & 1) << 5)); }
__host__ __device__ __forceinline__ void stage_rc(int b, int& R, int& C) { const int st = b / 1024, sb = b % 1024, swz = sb ^ (((sb >> 9) & 1) << 5); R = (st >> 1) * 16 + swz / 64; C = (st & 1) * 32 + (swz % 64) / 2; }
__host__ __device__ __forceinline__ int perm32(int rho) { const int n = rho >> 4, i = rho & 15; return 8 * (i >> 2) + 4 * n + (i & 3); }

struct Unit { int pm, pn; };
struct Gemm { const bf16_t* A; const bf16_t* Bt; int K; const int* rowidx; int wsc = 0x7f7f7f7f; };

struct StaticOrder {
    int nM, nN, nwg, G, c;
    __host__ __device__ void init(int M, int N, int G_, int c_) { nM = M / BM; nN = N / BM; nwg = nM * nN; G = G_; c = c_; }
    __host__ __device__ bool next(int i, Unit& u) const {
        const long L = (long)i * G + c; if (L >= nwg) return false;
        int wgid = (int)L; { const int q = nwg / NXCD, r = nwg % NXCD, xcd = wgid % NXCD, off = wgid / NXCD; wgid = (xcd < r ? xcd * (q + 1) : r * (q + 1) + (xcd - r) * q) + off; }
        const int nig = WGM * nN, gid = wgid / nig, fm = gid * WGM, gsz = (nM - fm) < WGM ? (nM - fm) : WGM;
        u.pm = fm + ((wgid % nig) % gsz); u.pn = (wgid % nig) / gsz; return true;
    }
};
struct MoeOrder {
    const int* blk_e; int nblk, NT, G, c;
    __device__ __forceinline__ bool next(int i, Unit& u) const {
        const long L = (long)i * G + c; if (L >= (long)nblk * NT) return false;
        const int blk = (int)(L / NT), pnl = (int)(L % NT); const int e = __builtin_amdgcn_readfirstlane(blk_e[blk]);
        u.pm = blk; u.pn = e * NT + pnl; return true;
    }
};

typedef __bf16 bf16v2_t __attribute__((ext_vector_type(2)));
typedef float f32v2_t __attribute__((ext_vector_type(2)));
__device__ __forceinline__ unsigned cvt_pk_bf16(float lo, float hi) { const f32v2_t v = {lo, hi}; return __builtin_bit_cast(unsigned, __builtin_convertvector(v, bf16v2_t)); }

#ifndef DEG_PX
#define DEG_PX 0
#endif
struct EpiB16 {
    static constexpr bool PERM = true;
    bf16_t* O; int ldc; int pn_mask; int dry = 0;
    __device__ __forceinline__ void operator()(const f32x4 (&acc)[2][2][4][2], const Unit& u, int wr, int wc, int fr, int fq) const {
        const int row0 = u.pm * BM + wr * 64 + fr; const int col0 = (u.pn & pn_mask) * BM + wc * 32 + 8 * fq;
#pragma unroll
        for (int ai = 0; ai < 2; ++ai)
#pragma unroll
            for (int m = 0; m < 4; ++m) { bf16_t* rowp = O + (size_t)(row0 + ai * HALF + m * 16) * ldc + col0;
#pragma unroll
                for (int bj = 0; bj < 2; ++bj) { const f32x4 v0 = acc[ai][bj][m][0], v1 = acc[ai][bj][m][1];
                    u32x4 w; w.x = cvt_pk_bf16(v0[0], v0[1]); w.y = cvt_pk_bf16(v0[2], v0[3]); w.z = cvt_pk_bf16(v1[0], v1[1]); w.w = cvt_pk_bf16(v1[2], v1[3]);
                    if (DEG_PX && pn_mask == 0xffff) { w.x &= 0xfffcfffcu; w.y &= 0xfffcfffcu; w.z &= 0xfffcfffcu; w.w &= 0xfffcfffcu; }
                    if (dry) asm volatile("" :: "v"(w.x), "v"(w.y), "v"(w.z), "v"(w.w)); else *(u32x4*)(rowp + bj * HALF) = w; } }
    }
};
constexpr float YS_SCALE = 8.0f;
struct EpiF8 {
    static constexpr bool PERM = true;
    unsigned char* O; int pn_mask; int dry = 0;
    __device__ __forceinline__ void operator()(const f32x4 (&acc)[2][2][4][2], const Unit& u, int wr, int wc, int fr, int fq) const {
        const int row0 = u.pm * BM + wr * 64 + fr; const int col0 = (u.pn & pn_mask) * BM + wc * 32 + 8 * fq;
#pragma unroll
        for (int ai = 0; ai < 2; ++ai)
#pragma unroll
            for (int m = 0; m < 4; ++m) { unsigned char* rowp = O + (size_t)(row0 + ai * HALF + m * 16) * 1024 + col0;
#pragma unroll
                for (int bj = 0; bj < 2; ++bj) { const f32x4 v0 = acc[ai][bj][m][0], v1 = acc[ai][bj][m][1];
                    int w0 = 0, w1 = 0;
                    w0 = __builtin_amdgcn_cvt_pk_fp8_f32(v0[0], v0[1], w0, false); w0 = __builtin_amdgcn_cvt_pk_fp8_f32(v0[2], v0[3], w0, true);
                    w1 = __builtin_amdgcn_cvt_pk_fp8_f32(v1[0], v1[1], w1, false); w1 = __builtin_amdgcn_cvt_pk_fp8_f32(v1[2], v1[3], w1, true);
                    const unsigned long long pk = (unsigned long long)(unsigned)w0 | ((unsigned long long)(unsigned)w1 << 32);
                    if (dry) asm volatile("" :: "v"(w0), "v"(w1)); else *(unsigned long long*)(rowp + bj * HALF) = pk; }
                asm volatile("" ::: "memory"); }
    }
};
struct EpiRes {
    static constexpr bool PERM = false;
    const float* base_c; const float* base_x; float* out_c; float* out_x; const float* mod; int gt_off; int row_base;
    __device__ __forceinline__ void operator()(const f32x4 (&acc)[2][2][4][2], const Unit& u, int wr, int wc, int fr, int fq) const {
        const int trow = row_base + u.pm * BM;
        const float* bp; float* op; int mr;
        if (trow < 2048) { mr = 8; bp = base_c + (size_t)trow * 1024; op = out_c + (size_t)trow * 1024; }
        else { mr = (trow - 2048) >> 12; bp = base_x + (size_t)(trow - 2048) * 1024; op = out_x + (size_t)(trow - 2048) * 1024; }
        const float* gate = mod + mr * 6144 + gt_off;
        const int r0 = wr * 64 + fr, col0 = u.pn * BM + wc * 32 + 4 * fq;
        f32x4 gv[2][2];
#pragma unroll
        for (int bj = 0; bj < 2; ++bj)
#pragma unroll
            for (int n = 0; n < 2; ++n) gv[bj][n] = *(const f32x4*)(gate + col0 + bj * HALF + n * 16);
#pragma unroll
        for (int ai = 0; ai < 2; ++ai)
#pragma unroll
            for (int m = 0; m < 4; ++m) { const size_t off = (size_t)(r0 + ai * HALF + m * 16) * 1024 + col0;
#pragma unroll
                for (int bj = 0; bj < 2; ++bj)
#pragma unroll
                    for (int n = 0; n < 2; ++n) { const f32x4 b = *(const f32x4*)(bp + off + bj * HALF + n * 16); *(f32x4*)(op + off + bj * HALF + n * 16) = b + gv[bj][n] * acc[ai][bj][m][n]; }
                asm volatile("" ::: "memory"); }
    }
};
struct EpiSwiglu {
    static constexpr bool PERM = false;
    unsigned char* HS;
    __device__ __forceinline__ void operator()(const f32x4 (&acc)[2][2][4][2], const Unit& u, int wr, int wc, int fr, int fq) const {
        const int row0 = u.pm * BM + wr * 64 + fr, hid0 = (u.pn & 1) * 128 + wc * 32 + fq * 8;
#pragma unroll
        for (int ai = 0; ai < 2; ++ai)
#pragma unroll
            for (int m = 0; m < 4; ++m) {
                float h[8];
#pragma unroll
                for (int bj = 0; bj < 2; ++bj)
#pragma unroll
                    for (int i = 0; i < 4; ++i) { const float a = acc[ai][bj][m][0][i], b = acc[ai][bj][m][1][i]; h[bj * 4 + i] = a * __builtin_amdgcn_rcpf(1.0f + __expf(-a)) * b; }
                int w0 = 0, w1 = 0;
                w0 = __builtin_amdgcn_cvt_pk_fp8_f32(h[0], h[1], w0, false); w0 = __builtin_amdgcn_cvt_pk_fp8_f32(h[2], h[3], w0, true);
                w1 = __builtin_amdgcn_cvt_pk_fp8_f32(h[4], h[5], w1, false); w1 = __builtin_amdgcn_cvt_pk_fp8_f32(h[6], h[7], w1, true);
                *(unsigned long long*)(HS + (size_t)(row0 + ai * HALF + m * 16) * 256 + hid0) = (unsigned long long)(unsigned)w0 | ((unsigned long long)(unsigned)w1 << 32); }
    }
};

template <class Epi, class Sched, bool ALIGN_EPI, bool GATHER, bool F8 = false>
__device__ __forceinline__ void gemm_phase(PG8_LAS unsigned char* lds, const Gemm g, const Sched& S, const Epi& E) {
    const int tid = opaque_tid(), wid = __builtin_amdgcn_readfirstlane(tid >> 6), lane = tid & 63, wr = wid >> 2, wc = wid & 3, fr = lane & 15, fq = lane >> 4;
    const int K = g.K, nt = K / BK;
    unsigned voffA[2], voffB[2];
#pragma unroll
    for (int i = 0; i < 2; ++i) { int R, C; stage_rc(tid * 16 + i * 8192, R, C); const int Rb = Epi::PERM ? ((R & ~31) + perm32(R & 31)) : R;
        voffA[i] = (unsigned)(R * K + C) * 2u; voffB[i] = (unsigned)(Rb * K + C) * 2u; }
    const size_t kstep = (size_t)(BK * 2);
    const size_t hstep = (size_t)HALF * K * 2;
    const size_t tstep = 2 * hstep;
    const unsigned ldsw = (unsigned)wid * 1024u;
    const int aoff = lds_byte(wr * 64 + fr, fq * 8), boff = lds_byte(wc * 32 + fr, fq * 8);
#define PG8_SA(b, h) (((b) * 2 + (h)) * HTB)
#define PG8_SB(b, h) ((4 + (b) * 2 + (h)) * HTB)
#define PG8_STAGE(bufoff, gbase, voff) do { _Pragma("unroll") for (int _i = 0; _i < 2; ++_i) \
        __builtin_amdgcn_global_load_lds((const unsigned*)((const char*)(gbase) + (voff)[_i]), (PG8_LAS unsigned*)(lds + (bufoff) + ldsw + _i * 8192), 16, 0, 0); } while (0)
#define PG8_STAGE2(bufoff, gbase, o0, o1) do { \
        __builtin_amdgcn_global_load_lds((const unsigned*)((const char*)(gbase) + (o0)), (PG8_LAS unsigned*)(lds + (bufoff) + ldsw), 16, 0, 0); \
        __builtin_amdgcn_global_load_lds((const unsigned*)((const char*)(gbase) + (o1)), (PG8_LAS unsigned*)(lds + (bufoff) + ldsw + 8192), 16, 0, 0); } while (0)
#define PG8_LD2(p) __builtin_shufflevector(*(const PG8_LAS v4i_t*)(p), *(const PG8_LAS v4i_t*)((p) + 1024), 0, 1, 2, 3, 4, 5, 6, 7)
#define PG8_LDA(dst, b, h) do { _Pragma("unroll") for (int m = 0; m < 4; ++m) dst[m] = PG8_LD2(lds + PG8_SA(b, h) + aoff + m * 2048); } while (0)
#define PG8_LDB(dst, b, h) do { _Pragma("unroll") for (int n = 0; n < 2; ++n) dst[n] = PG8_LD2(lds + PG8_SB(b, h) + boff + n * 2048); } while (0)
#define PG8_HALF(v, k) __builtin_bit_cast(bf16x8, __builtin_shufflevector(v, v, 4 * (k), 4 * (k) + 1, 4 * (k) + 2, 4 * (k) + 3))
#define PG8_MMA(ai, bj, At, Bt) do { __builtin_amdgcn_s_setprio(1); _Pragma("unroll") for (int m = 0; m < 4; ++m) _Pragma("unroll") for (int n = 0; n < 2; ++n) { \
        acc[ai][bj][m][n] = __builtin_amdgcn_mfma_f32_16x16x32_bf16(PG8_HALF(Bt[n], 0), PG8_HALF(At[m], 0), acc[ai][bj][m][n], 0, 0, 0); \
        acc[ai][bj][m][n] = __builtin_amdgcn_mfma_f32_16x16x32_bf16(PG8_HALF(Bt[n], 1), PG8_HALF(At[m], 1), acc[ai][bj][m][n], 0, 0, 0); } __builtin_amdgcn_s_setprio(0); } while (0)
#define PG8_MMA8(ai, bj, At, Bt) do { __builtin_amdgcn_s_setprio(1); _Pragma("unroll") for (int m = 0; m < 4; ++m) _Pragma("unroll") for (int n = 0; n < 2; ++n) { \
        asm volatile("v_mfma_scale_f32_16x16x128_f8f6f4 %0, %1, %2, %0, %3, %4 op_sel_hi:[0,0,0]" : "+v"(acc[ai][bj][m][n]) : "v"(Bt[n]), "v"(At[m]), "v"(scw), "v"(scx)); }     __builtin_amdgcn_s_setprio(0); } while (0)
#define PG8_MM(ai, bj, At, Bt) do { if constexpr (F8) PG8_MMA8(ai, bj, At, Bt); else PG8_MMA(ai, bj, At, Bt); } while (0)
#define PG8_F8PAD do { if constexpr (F8) asm volatile("s_nop 15\n\ts_nop 15\n\ts_nop 15\n\ts_nop 15" ::: "memory"); } while (0)
#define PG8_WAIT_V(n) asm volatile("s_waitcnt vmcnt(" #n ")" ::: "memory")
#define PG8_WAIT_L(n) asm volatile("s_waitcnt lgkmcnt(" #n ")" ::: "memory")
#define PG8_BAR __builtin_amdgcn_s_barrier()
#define PG8_SCHED __builtin_amdgcn_sched_barrier(0)
    Unit cur, nxt; int ui = 0;
    if (!S.next(0, cur)) return;
    float zf = 0.f; asm volatile("" : "+v"(zf));
    f32x4 acc[2][2][4][2];
#pragma unroll
    for (int a = 0; a < 2; ++a)
#pragma unroll
        for (int b = 0; b < 2; ++b)
#pragma unroll
            for (int m = 0; m < 4; ++m)
#pragma unroll
                for (int n = 0; n < 2; ++n) acc[a][b][m][n] = (f32x4){zf, zf, zf, zf};
    v8i_t At[4], B0[2], B1[2];
    int scw = g.wsc, scx = 0x7f7f7f7f;
    if constexpr (F8) { asm volatile("" : "+v"(scw), "+v"(scx)); }
    unsigned oc00 = 0, oc01 = 0, oc10 = 0, oc11 = 0, on00 = 0, on01 = 0, on10 = 0, on11 = 0;
    const char* cA = GATHER ? (const char*)g.A : (const char*)g.A + (size_t)cur.pm * tstep; const char* cB = (const char*)g.Bt + (size_t)cur.pn * tstep;
#define PG8_ROWCOL() int rowA[2]; unsigned colA[2]; { int t_ = tid; asm volatile("" : "+v"(t_)); _Pragma("unroll") for (int i = 0; i < 2; ++i) { int R, C; stage_rc(t_ * 16 + i * 8192, R, C); rowA[i] = R; colA[i] = (unsigned)C * 2u; } }
    if constexpr (GATHER) { PG8_ROWCOL(); const int* ri = g.rowidx + cur.pm * BM; const unsigned rb = (unsigned)K * 2u;
        oc00 = (unsigned)ri[rowA[0]] * rb + colA[0]; oc01 = (unsigned)ri[rowA[1]] * rb + colA[1]; oc10 = (unsigned)ri[HALF + rowA[0]] * rb + colA[0]; oc11 = (unsigned)ri[HALF + rowA[1]] * rb + colA[1]; }
    PG8_STAGE(PG8_SB(0, 0), cB, voffB); PG8_STAGE(PG8_SB(0, 1), cB + hstep, voffB);
    if constexpr (GATHER) { PG8_STAGE2(PG8_SA(0, 0), cA, oc00, oc01); PG8_STAGE2(PG8_SA(0, 1), cA, oc10, oc11); }
    else { PG8_STAGE(PG8_SA(0, 0), cA, voffA); PG8_STAGE(PG8_SA(0, 1), cA + hstep, voffA); }
    if (wr == 1) PG8_BAR;
    PG8_WAIT_V(2); PG8_BAR;
    PG8_STAGE(PG8_SB(1, 0), cB + kstep, voffB);
    if constexpr (GATHER) { PG8_STAGE2(PG8_SA(1, 0), cA + kstep, oc00, oc01); } else { PG8_STAGE(PG8_SA(1, 0), cA + kstep, voffA); }
    PG8_STAGE(PG8_SB(1, 1), cB + hstep + kstep, voffB);
    PG8_WAIT_V(6); PG8_BAR;
    for (;;) {
        const bool has_next = S.next(ui + 1, nxt);
        const char* nA = GATHER ? cA : (has_next ? (const char*)g.A + (size_t)nxt.pm * tstep : cA); const char* nB = has_next ? (const char*)g.Bt + (size_t)nxt.pn * tstep : cB;
        if constexpr (GATHER) {
            if (has_next) { PG8_ROWCOL(); const int* ri = g.rowidx + nxt.pm * BM; const unsigned rb = (unsigned)K * 2u;
                on00 = (unsigned)ri[rowA[0]] * rb + colA[0]; on01 = (unsigned)ri[rowA[1]] * rb + colA[1]; on10 = (unsigned)ri[HALF + rowA[0]] * rb + colA[0]; on11 = (unsigned)ri[HALF + rowA[1]] * rb + colA[1]; }
            else { on00 = oc00; on01 = oc01; on10 = oc10; on11 = oc11; }
        }
        for (int t = 0; t < nt; t += 2) {
            const bool last = (t == nt - 2);
            const char* a1 = cA + (size_t)(t + 1) * kstep;
            const char* a2 = last ? nA : cA + (size_t)(t + 2) * kstep; const char* b2 = last ? nB : cB + (size_t)(t + 2) * kstep;
            const char* a3 = a2 + kstep; const char* b3 = b2 + kstep;
            const unsigned s00 = last ? on00 : oc00, s01 = last ? on01 : oc01, s10 = last ? on10 : oc10, s11 = last ? on11 : oc11;
            PG8_LDB(B0, 0, 0); PG8_LDB(B1, 0, 1); PG8_SCHED; PG8_LDA(At, 0, 0);
            if constexpr (GATHER) { PG8_STAGE2(PG8_SA(1, 1), a1, oc10, oc11); } else { PG8_STAGE(PG8_SA(1, 1), a1 + hstep, voffA); }
            PG8_WAIT_V(8); PG8_WAIT_L(0); PG8_BAR; PG8_MM(0, 0, At, B0); PG8_MM(0, 1, At, B1); PG8_F8PAD; PG8_BAR; PG8_SCHED;
            PG8_LDA(At, 0, 1); PG8_STAGE(PG8_SB(0, 0), b2, voffB); PG8_STAGE(PG8_SB(0, 1), b2 + hstep, voffB);
            if constexpr (GATHER) { PG8_STAGE2(PG8_SA(0, 0), a2, s00, s01); } else { PG8_STAGE(PG8_SA(0, 0), a2, voffA); }
            PG8_WAIT_V(8); PG8_WAIT_L(0); PG8_BAR; PG8_MM(1, 0, At, B0); PG8_MM(1, 1, At, B1); PG8_F8PAD; PG8_BAR; PG8_SCHED;
            PG8_LDB(B0, 1, 0); PG8_LDB(B1, 1, 1); PG8_SCHED; PG8_LDA(At, 1, 0);
            if constexpr (GATHER) { PG8_STAGE2(PG8_SA(0, 1), a2, s10, s11); } else { PG8_STAGE(PG8_SA(0, 1), a2 + hstep, voffA); }
            PG8_WAIT_V(8); PG8_WAIT_L(0); PG8_BAR; PG8_MM(0, 0, At, B0); PG8_MM(0, 1, At, B1); PG8_F8PAD; PG8_BAR; PG8_SCHED;
            PG8_LDA(At, 1, 1); PG8_STAGE(PG8_SB(1, 0), b3, voffB); PG8_STAGE(PG8_SB(1, 1), b3 + hstep, voffB);
            if constexpr (GATHER) { PG8_STAGE2(PG8_SA(1, 0), a3, s00, s01); } else { PG8_STAGE(PG8_SA(1, 0), a3, voffA); }
            PG8_WAIT_V(8); PG8_WAIT_L(0); PG8_BAR; PG8_MM(1, 0, At, B0); PG8_MM(1, 1, At, B1); PG8_F8PAD; PG8_BAR; PG8_SCHED;
        }
        if constexpr (ALIGN_EPI) { if (wr == 0) PG8_BAR; }
        if constexpr (F8) { asm volatile("s_nop 15\n\ts_nop 15\n\ts_nop 15\n\ts_nop 15\n\ts_nop 15\n\ts_nop 15\n\ts_nop 15\n\ts_nop 15\n\ts_nop 15\n\ts_nop 15\n\ts_nop 15\n\ts_nop 15" ::: "memory"); }
        E(acc, cur, wr, wc, fr, fq);
        if (!has_next) break;
#pragma unroll
        for (int a = 0; a < 2; ++a)
#pragma unroll
            for (int b = 0; b < 2; ++b)
#pragma unroll
                for (int m = 0; m < 4; ++m)
#pragma unroll
                    for (int n = 0; n < 2; ++n) acc[a][b][m][n] = (f32x4){zf, zf, zf, zf};
        cur = nxt; cA = nA; cB = nB; ++ui; oc00 = on00; oc01 = on01; oc10 = on10; oc11 = on11;
        if constexpr (ALIGN_EPI) { if (wr == 1) PG8_BAR; }
    }
    PG8_WAIT_V(0);
    if constexpr (!ALIGN_EPI) { if (wr == 0) PG8_BAR; }
    PG8_BAR;
#undef PG8_SA
#undef PG8_SB
#undef PG8_STAGE
#undef PG8_STAGE2
#undef PG8_LDA
#undef PG8_ROWCOL
#undef PG8_LD2
#undef PG8_HALF
#undef PG8_LDB
#undef PG8_MMA
#undef PG8_MMA8
#undef PG8_MM
#undef PG8_F8PAD
#undef PG8_WAIT_V
#undef PG8_WAIT_L
#undef PG8_BAR
#undef PG8_SCHED
}
}
#define GAS __attribute__((address_space(1)))
#define LAS __attribute__((address_space(3)))
typedef unsigned short bf16;
typedef unsigned v4u __attribute__((ext_vector_type(4)));
typedef float f32x4 __attribute__((ext_vector_type(4)));
typedef short bf16x8 __attribute__((ext_vector_type(8)));
typedef GAS unsigned gu32;
typedef GAS unsigned long long gu64;
#define RLX_AGENT __ATOMIC_RELAXED, __HIP_MEMORY_SCOPE_AGENT
#define LDS_WAIT() asm volatile("s_waitcnt lgkmcnt(0)" ::: "memory")
#define VM_WAIT() asm volatile("s_waitcnt vmcnt(0)" ::: "memory")
__device__ __forceinline__ unsigned long long rt() { return __builtin_amdgcn_s_memrealtime(); }
__device__ __forceinline__ unsigned f2bf(float f) { return (unsigned)__builtin_bit_cast(unsigned short, (__bf16)f); }
__device__ __forceinline__ unsigned pk2(float lo, float hi) { return pg8::cvt_pk_bf16(lo, hi); }

#define XB_TMO      128
#define XB_XCNT(j)  (256  + 64 * (j))
#define XB_XSUB(j)  (1280 + 64 * (j))
#define XB_XGEN(j)  (2304 + 64 * (j))
#define XB_TOP      3328
#define XB_TOPGEN   3392
#define XCD_BAR_WORDS 3456
#define XB_SPIN_CAP (1u << 18)

__device__ __forceinline__ unsigned xb_ld(unsigned* p)              { return __hip_atomic_load(p, __ATOMIC_RELAXED, __HIP_MEMORY_SCOPE_AGENT); }
__device__ __forceinline__ unsigned xb_add(unsigned* p, unsigned v) { return __hip_atomic_fetch_add(p, v, __ATOMIC_RELAXED, __HIP_MEMORY_SCOPE_AGENT); }
__device__ __forceinline__ unsigned xb_xcc_id() { return (unsigned)__builtin_amdgcn_s_getreg((3 << 11) | 20) & 0xFu; }
#define XB_SPIN(cond, bar) do { unsigned _sp = 0; while (cond) { __builtin_amdgcn_s_sleep(1); \
    if ((++_sp & 255u) == 0u) { if (xb_ld(&(bar)[XB_TMO])) break; if (_sp > XB_SPIN_CAP) { atomicAdd(&(bar)[XB_TMO], 1u); break; } } } } while (0)

struct XcdBarrier {
    unsigned* bar; unsigned x;
    volatile LAS unsigned* st;
};

__device__ __forceinline__ XcdBarrier xcd_barrier_post(unsigned* bar, volatile LAS unsigned* st) {
    XcdBarrier b; b.bar = bar; b.x = xb_xcc_id(); b.st = st;
    if (threadIdx.x == 0) (void)xb_add(&bar[XB_XCNT(b.x)], 1u);
    return b;
}
__device__ __forceinline__ void xcd_barrier_complete(unsigned* bar, unsigned x, unsigned& nloc, unsigned& nx) {
    const unsigned G = gridDim.x * gridDim.y * gridDim.z;
    unsigned sum, cnt, mine, sp = 0u;
    for (;;) {
        sum = 0u; cnt = 0u; mine = 0u;
#pragma unroll
        for (unsigned j = 0; j < 16; ++j) { const unsigned c = xb_ld(&bar[XB_XCNT(j)]); sum += c; cnt += (c > 0u) ? 1u : 0u; mine = (j == x) ? c : mine; }
        if (sum == G) break;
        __builtin_amdgcn_s_sleep(1);
        if ((++sp & 255u) == 0u) { if (xb_ld(&bar[XB_TMO])) break; if (sp > XB_SPIN_CAP) { atomicAdd(&bar[XB_TMO], 1u); break; } }
    }
    nloc = mine > 0u ? mine : 1u; nx = cnt > 0u ? cnt : 1u;
}

__device__ __forceinline__ void xcd_barrier(const XcdBarrier& b) {
    asm volatile("s_waitcnt vmcnt(0)" ::: "memory");
    __syncthreads();
    if (threadIdx.x == 0) {
        unsigned* bar = b.bar;
        __builtin_amdgcn_s_waitcnt(0);
        unsigned nloc = b.st[0], nx = b.st[1];
        if (nloc == 0u) { xcd_barrier_complete(bar, b.x, nloc, nx); b.st[0] = nloc; b.st[1] = nx; }
        const unsigned old = xb_add(&bar[XB_XSUB(b.x)], 1u);
        const unsigned gen = old / nloc;
        if (old + 1u == (gen + 1u) * nloc) {
            __builtin_amdgcn_fence(__ATOMIC_RELEASE, "agent");
            asm volatile("s_waitcnt vmcnt(0)" ::: "memory");
            const unsigned og = xb_add(&bar[XB_TOP], 1u);
            const unsigned tg = og / nx;
            if (og + 1u == (tg + 1u) * nx) xb_add(&bar[XB_TOPGEN], 1u);
            else XB_SPIN(xb_ld(&bar[XB_TOPGEN]) == tg, bar);
            __builtin_amdgcn_fence(__ATOMIC_ACQUIRE, "agent");
            xb_add(&bar[XB_XGEN(b.x)], 1u);
            asm volatile("s_waitcnt vmcnt(0)" ::: "memory");
        } else {
            XB_SPIN(xb_ld(&bar[XB_XGEN(b.x)]) == gen, bar);
            __builtin_amdgcn_fence(__ATOMIC_ACQUIRE, "agent");
            asm volatile("s_waitcnt vmcnt(0)" ::: "memory");
        }
    }
    __syncthreads();
}

constexpr int NWAVES = 8;
constexpr int DM = 1024, NBATCH = 8, SEQL = 4096, CTXL = 256;
constexpr int NC = NBATCH * CTXL, NX = NBATCH * SEQL, NTOK = NC + NX;
constexpr int HW = 512, INC = 3072, NE = 64, TOPK = 6;
constexpr int NCH = 68;
constexpr int NSEQ = NBATCH * 4 * 2;
constexpr float EPSN = 1e-6f;
constexpr int NHALF = 1;
constexpr int MAXBLK = 1024;
constexpr int MAXSLOT = 1016 * 256;

constexpr size_t MiB = 1u << 20;
constexpr size_t WS_CTL = 0, CTL_ZERO_BYTES = 1 * MiB;
constexpr size_t WS_MOD = 1 * MiB;
constexpr size_t WS_RT = 2 * MiB;
constexpr size_t RT_IDX = WS_RT, RT_GATE = WS_RT + 1 * MiB, RT_TSLOT = WS_RT + 2 * MiB, RT_STOK = WS_RT + 3 * MiB, RT_BLKE = WS_RT + 4 * MiB + 512 * 1024, RT_MISC = RT_BLKE + 8192;
constexpr size_t WS_CTXRES = 8 * MiB;
constexpr size_t WS_WIN = 16 * MiB, WS_WOUT = 22 * MiB, WS_WPOOL = 24 * MiB, WS_WR = 25 * MiB, WS_W13 = 26 * MiB, WS_W2 = 91 * MiB;
constexpr size_t WS_HX = 124 * MiB;
constexpr size_t WS_PX = 193 * MiB;
constexpr size_t WS_KV = 397 * MiB;
constexpr size_t WS_DEC = 533 * MiB;
constexpr size_t WS_HS = 193 * MiB, WS_YS = 320 * MiB;
constexpr size_t WS_END = 574 * MiB;
static_assert(WS_HS + (size_t)MAXSLOT * 512 <= WS_YS && WS_YS + (size_t)MAXSLOT * 1024 <= WS_END && WS_HX + (size_t)(NTOK + 1) * 2048 <= WS_PX && WS_PX + (size_t)NTOK * INC * 2 <= WS_KV, "ws map");
constexpr int CW_BAR = 4096, CW_CNT = 8192, CW_CUR = 8448;

constexpr int RING_BYTES = 131072, LDSCTL_OFF = RING_BYTES, MISC_OFF = LDSCTL_OFF + 320, LDS_BYTES = 147456;

__device__ __forceinline__ float bf2f(unsigned short u) { return __builtin_bit_cast(float, ((unsigned)u) << 16); }
__device__ __forceinline__ float shx(float v, int o, int lane) { return __builtin_bit_cast(float, __builtin_amdgcn_ds_bpermute((lane ^ o) << 2, __builtin_bit_cast(int, v))); }
__device__ __forceinline__ float shl(float v, int src) { return __builtin_bit_cast(float, __builtin_amdgcn_ds_bpermute(src << 2, __builtin_bit_cast(int, v))); }
__device__ __forceinline__ float wave_sum(float v, int lane) {
#pragma unroll
    for (int o = 1; o < 64; o <<= 1) v += shx(v, o, lane);
    return v;
}
__device__ __forceinline__ float wave_max(float v, int lane) {
#pragma unroll
    for (int o = 1; o < 64; o <<= 1) v = fmaxf(v, shx(v, o, lane));
    return v;
}
__device__ __forceinline__ float opaque_zero() { float z = 0.f; asm volatile("" : "+v"(z)); return z; }
__device__ __forceinline__ float sigmoidf_(float x) { return __builtin_amdgcn_rcpf(1.0f + __expf(-x)); }
__device__ __forceinline__ float clamp80(float x) { return fminf(fmaxf(x, -80.f), 80.f); }

struct Frame {
    LAS unsigned char* lds;
    unsigned* ctl;
    int tid, lane, wave, vcu, G;
    const float* in[23];
    float* out; unsigned char* ws;
};
extern __shared__ __attribute__((aligned(16))) unsigned char g_lds[];
constexpr int TAB_OFF = MISC_OFF + 128;
__device__ __forceinline__ unsigned long long tab_ld(int i) {
    const unsigned long long v = ((const LAS unsigned long long*)((LAS unsigned char*)g_lds + TAB_OFF))[i];
    const unsigned lo = (unsigned)__builtin_amdgcn_readfirstlane((int)(unsigned)v), hi = (unsigned)__builtin_amdgcn_readfirstlane((int)(unsigned)(v >> 32));
    return ((unsigned long long)hi << 32) | lo;
}
__device__ __forceinline__ Frame make_frame() {
    asm volatile("" ::: "memory");
    Frame F;
    F.lds = (LAS unsigned char*)g_lds;
    F.tid = pg8::opaque_tid(); F.lane = F.tid & 63; F.wave = __builtin_amdgcn_readfirstlane(F.tid >> 6);
    F.G = gridDim.x; { int bx = blockIdx.x; asm volatile("" : "+s"(bx)); F.vcu = (F.G % 8 == 0) ? (bx % 8) * (F.G / 8) + bx / 8 : bx; }
#pragma unroll
    for (int i = 0; i < 23; ++i) F.in[i] = (const float*)tab_ld(i);
    F.out = (float*)tab_ld(23); F.ws = (unsigned char*)tab_ld(24); F.ctl = (unsigned*)(F.ws + WS_CTL);
    return F;
}
__device__ __forceinline__ void grid_barrier() {
    const Frame F = make_frame();
    XcdBarrier b; b.bar = F.ctl + CW_BAR; b.x = xb_xcc_id(); b.st = (volatile LAS unsigned*)((LAS unsigned char*)g_lds + MISC_OFF) + 8;
    xcd_barrier(b);
}

__device__ __forceinline__ void transpose_item(const float* W, int K, int N, bf16* WT, int mode, LAS float* scr, int item, int lane, float wscale = 1.0f, bool f8 = false) {
    (void)scr;
    const int nblk = N / 32, kb = item / nblk, nb = item % nblk, k0 = 64 * kb, n0 = 32 * nb, c = lane >> 3, n4 = lane & 7;
    const GAS f32x4* src = (const GAS f32x4*)(W + (size_t)(k0 + 8 * c) * N + n0 + 4 * n4);
    f32x4 v[8];
#pragma unroll
    for (int j = 0; j < 8; ++j) v[j] = src[(size_t)j * (N / 4)] * wscale;
#pragma unroll
    for (int i = 0; i < 4; ++i) {
        const v4u o = (v4u){pk2(v[0][i], v[1][i]), pk2(v[2][i], v[3][i]), pk2(v[4][i], v[5][i]), pk2(v[6][i], v[7][i])};
        const int nn = n0 + 4 * n4 + i; int dr = nn;
        if (mode) dr = 256 * (nn >> 7) + 128 * ((nn >> 2) & 1) + 32 * ((nn >> 5) & 3) + 16 * (mode - 1) + 4 * ((nn >> 3) & 3) + (nn & 3);
        if (!f8) *(GAS v4u*)(WT + (size_t)dr * K + k0 + 8 * c) = o;
        else { int lo8 = 0, hi8 = 0;
            lo8 = __builtin_amdgcn_cvt_pk_fp8_f32(v[0][i], v[1][i], lo8, false); lo8 = __builtin_amdgcn_cvt_pk_fp8_f32(v[2][i], v[3][i], lo8, true);
            hi8 = __builtin_amdgcn_cvt_pk_fp8_f32(v[4][i], v[5][i], hi8, false); hi8 = __builtin_amdgcn_cvt_pk_fp8_f32(v[6][i], v[7][i], hi8, true);
            *(GAS unsigned long long*)((GAS unsigned char*)WT + (size_t)dr * K + k0 + 8 * c) = (unsigned long long)(unsigned)lo8 | ((unsigned long long)(unsigned)hi8 << 32); } }
}

__device__ __forceinline__ void phase_wconv(Frame& F, int l) {
    LAS float* scr = (LAS float*)(F.lds + F.wave * 16384);
    const int gw = F.vcu * NWAVES + F.wave, NGW = F.G * NWAVES;
    constexpr int I_IN = 16 * 96, I_OUT = 16 * 32, I_POOL = 4 * 8, I_R = 16 * 2, I_1 = 65 * 128, I_2 = 65 * 128;
    constexpr int NITEMS = I_IN + I_OUT + I_POOL + I_R + 2 * I_1 + I_2;
    unsigned char* ws = F.ws;
    for (int it = gw; it < NITEMS; it += NGW) {
        int r = it;
        if (r < I_IN) { transpose_item(F.in[8] + (size_t)l * DM * INC, DM, INC, (bf16*)(ws + WS_WIN), 0, scr, r, F.lane); continue; } r -= I_IN;
        if (r < I_OUT) { transpose_item(F.in[13] + (size_t)l * DM * DM, DM, DM, (bf16*)(ws + WS_WOUT), 0, scr, r, F.lane); continue; } r -= I_OUT;
        if (r < I_POOL) { const int g = r / 8; transpose_item(F.in[11] + (size_t)(l * 4 + g) * 128 * 128, 128, 128, (bf16*)(ws + WS_WPOOL) + g * 128 * 128, 0, scr, r % 8, F.lane); continue; } r -= I_POOL;
        if (r < I_R) { transpose_item(F.in[14] + (size_t)l * DM * NE, DM, NE, (bf16*)(ws + WS_WR), 0, scr, r, F.lane); continue; } r -= I_R;
        if (r < 2 * I_1) { const int mat = r / I_1; r -= mat * I_1; const int e = r / 128, ii = r % 128;
            const float* src = (e < 64) ? F.in[mat ? 17 : 16] + ((size_t)l * 64 + e) * DM * 256 : F.in[mat ? 20 : 19] + (size_t)l * DM * 256;
            transpose_item(src, DM, 256, (bf16*)((unsigned char*)(ws + WS_W13) + (size_t)e * 512 * DM), 1 + mat, scr, ii, F.lane, 32.0f, true); continue; } r -= 2 * I_1;
        { const int e = r / 128, ii = r % 128;
            const float* src = (e < 64) ? F.in[18] + ((size_t)l * 64 + e) * 256 * DM : F.in[21] + (size_t)l * 256 * DM;
            transpose_item(src, 256, DM, (bf16*)((unsigned char*)(ws + WS_W2) + (size_t)e * DM * 256), 0, scr, ii, F.lane, 16.0f, true); }
    }
}

__device__ __forceinline__ void phase_mod(Frame& F) {
    LAS float* sil = (LAS float*)(F.lds + 65536);
    LAS float* part = (LAS float*)(F.lds + 65536 + 36864);
    for (int i = F.tid; i < 9 * 1024; i += 512) { const int r = i >> 10, k = i & 1023; const float v = (r < 8) ? F.in[1][r * 1024 + k] : F.in[3][k]; sil[i] = v * sigmoidf_(v); }
    __syncthreads();
    float* mod = (float*)(F.ws + WS_MOD);
    for (int it = F.vcu; it < 2 * 96; it += F.G) {
        const int l = it / 96, n0 = (it % 96) * 64;
        const float* wa = F.in[6] + (size_t)l * DM * 6144 + n0 + F.lane;
        float acc[9];
#pragma unroll
        for (int r = 0; r < 9; ++r) acc[r] = 0.f;
        const int kb = F.wave * 128;
#pragma unroll 4
        for (int k = 0; k < 128; ++k) { const float w = wa[(size_t)(kb + k) * 6144];
#pragma unroll
            for (int r = 0; r < 9; ++r) acc[r] += sil[r * 1024 + kb + k] * w; }
#pragma unroll
        for (int r = 0; r < 9; ++r) part[(F.wave * 9 + r) * 64 + F.lane] = acc[r];
        __syncthreads();
        for (int i = F.tid; i < 9 * 64; i += 512) { const int r = i >> 6, c = i & 63; float s = 0.f;
#pragma unroll
            for (int w = 0; w < 8; ++w) s += part[(w * 9 + r) * 64 + c];
            mod[((size_t)l * 9 + r) * 6144 + n0 + c] = s + F.in[7][(size_t)l * 6144 + n0 + c]; }
        __syncthreads();
    }
}

__device__ __forceinline__ const float* resid_in_row(Frame& F, int l, int row) {
    if (l == 0) return row < NC ? F.in[2] + (size_t)row * DM : F.in[0] + (size_t)(row - NC) * DM;
    return row < NC ? (const float*)(F.ws + WS_CTXRES) + (size_t)row * DM : F.out + (size_t)(row - NC) * DM;
}
__device__ __forceinline__ float* resid_row(Frame& F, int row) { return row < NC ? (float*)(F.ws + WS_CTXRES) + (size_t)row * DM : F.out + (size_t)(row - NC) * DM; }
__device__ __forceinline__ int mod_row(int row) { return row < NC ? 8 : ((row - NC) >> 12); }

#ifndef DIAG_ZERO_CTXSTATE
#define DIAG_ZERO_CTXSTATE 0
#endif
#ifndef DEG_HX
#define DEG_HX 0
#endif
#ifndef DEG_Y
#define DEG_Y 0
#endif
__device__ __forceinline__ void norm_mod_row(Frame& F, const float* xrow, const float* nw, const float* sh, const float* sc, bf16* orow, LAS bf16* lrow, LAS float* frow = nullptr) {
    const GAS f32x4* xr = (const GAS f32x4*)xrow + F.lane;
    f32x4 v[4]; float s = 0.f;
#pragma unroll
    for (int j = 0; j < 4; ++j) { v[j] = xr[64 * j]; s += (v[j].x * v[j].x + v[j].y * v[j].y) + (v[j].z * v[j].z + v[j].w * v[j].w); }
    const float r = 1.0f / sqrtf(wave_sum(s, F.lane) * (1.f / DM) + EPSN);
#pragma unroll
    for (int j = 0; j < 4; ++j) {
        const f32x4 w4 = ((const GAS f32x4*)nw)[F.lane + 64 * j], s4 = ((const GAS f32x4*)sc)[F.lane + 64 * j], h4 = ((const GAS f32x4*)sh)[F.lane + 64 * j];
        const f32x4 o = (v[j] * r) * w4 * (s4 + 1.0f) + h4;
        unsigned long long pk = (unsigned long long)pk2(o.x, o.y) | ((unsigned long long)pk2(o.z, o.w) << 32);
        if (DEG_HX) pk &= 0xfffcfffcfffcfffcull;
        ((GAS unsigned long long*)orow)[F.lane + 64 * j] = pk;
        if (lrow) *(LAS unsigned long long*)(lrow + 4 * (F.lane + 64 * j)) = pk;
        if (frow) *(LAS f32x4*)(frow + 4 * (F.lane + 64 * j)) = o;
    }
}

__device__ __forceinline__ void phase_hx(Frame& F, int l) {
    const int gw = F.vcu * NWAVES + F.wave, NGW = F.G * NWAVES;
    const float* mod = (const float*)(F.ws + WS_MOD) + (size_t)l * 9 * 6144;
    bf16* HX = (bf16*)(F.ws + WS_HX);
    for (int row = gw; row < NTOK; row += NGW) { const float* md = mod + mod_row(row) * 6144;
        norm_mod_row(F, resid_in_row(F, l, row), F.in[4] + l * DM, md, md + 1024, HX + (size_t)row * DM, nullptr); }
}

__device__ __forceinline__ void gates16(const bf16* zp, float lb, float (&g)[16], float (&kk)[16]) {
    const float lbf = fmaxf(lb, 1e-30f), oml = 1.0f - lb;
#pragma unroll
    for (int j = 0; j < 16; ++j) { const float z = bf2f(zp[(size_t)j * INC]); const float sg = sigmoidf_(z); g[j] = __logf(lbf + oml * sg); kk[j] = oml * (1.0f - sg); }
}
__device__ __forceinline__ float lb_of(Frame& F, int l, int dir, int hch) {
    if (l == 0) return 0.f;
    const float a0 = F.in[9][dir * HW + hch], a1 = F.in[9][2 * HW + dir * HW + hch];
    return 1.0f / (1.0f + __expf(a0 - a1));
}
__device__ __forceinline__ int chunk_row0(int b, int dir, int c) {
    if (c < 4) { const int tc = dir ? 3 - c : c; return b * CTXL + tc * 64; }
    const int tc = dir ? 63 - (c - 4) : (c - 4); return NC + b * SEQL + tc * 64;
}

template <int KS, int NTILE>
__device__ __forceinline__ void mma_rows16(f32x4 (&acc)[NTILE], const LAS bf16* A, int lda, int arow0, const LAS bf16* Bt, int ldb, int brow0, int lane) {
    const int r = lane & 15, q = lane >> 4;
    bf16x8 af[KS], bfr[KS][NTILE];
#pragma unroll
    for (int s = 0; s < KS; ++s) { af[s] = *(const LAS bf16x8*)(A + (arow0 + r) * lda + 32 * s + 8 * q);
#pragma unroll
        for (int i = 0; i < NTILE; ++i) bfr[s][i] = *(const LAS bf16x8*)(Bt + (brow0 + 16 * i + r) * ldb + 32 * s + 8 * q); }
#pragma unroll
    for (int s = 0; s < KS; ++s)
#pragma unroll
        for (int i = 0; i < NTILE; ++i) acc[i] = __builtin_amdgcn_mfma_f32_16x16x32_bf16(bfr[s][i], af[s], acc[i], 0, 0, 0);
}

__device__ __forceinline__ void pool_load(Frame& F, int b, int tc, int gi, v4u (&r)[3]) {
    const GAS bf16* PX = (const GAS bf16*)(F.ws + WS_PX);
    const int row0 = (tc < 4) ? b * CTXL + tc * 64 : NC + b * SEQL + (tc - 4) * 64;
    const int lo_b = (tc < 4) ? -tc * 64 : 0, hi_b = (tc < 4) ? (4 - tc) * 64 : 64;
#pragma unroll
    for (int j = 0; j < 3; ++j) { const int e = F.tid + 512 * j; const int rr = (e >> 4) - 8; r[j] = (v4u){0u, 0u, 0u, 0u};
        if (e < 1280 && rr >= lo_b && rr < hi_b) r[j] = *(const GAS v4u*)(PX + (size_t)(row0 + rr) * INC + 5 * HW + gi * 128 + (e & 15) * 8); }
}
__device__ __forceinline__ void pool_item(Frame& F, int l, int b, int tc, int gi, v4u (&pr)[3], bool has_next, int nb, int ntc, int ngi) {
    LAS bf16* Pin = (LAS bf16*)(F.lds + 65536); LAS bf16* Pl = (LAS bf16*)(F.lds); LAS bf16* Wt = (LAS bf16*)(F.lds + 17408);
    bf16* Y = (bf16*)(F.ws + WS_HX);
    const int seg = F.tid >> 7, ch = F.tid & 127, mt = F.wave >> 1, nh = F.wave & 1, lr = F.lane & 15, lq = F.lane >> 4;
    const int row0 = (tc < 4) ? b * CTXL + tc * 64 : NC + b * SEQL + (tc - 4) * 64;
    const int wdw = 2 << gi, hw2 = wdw >> 1;
    const int lo_b = (tc < 4) ? -tc * 64 : 0, hi_b = (tc < 4) ? (4 - tc) * 64 : 64;
#pragma unroll
    for (int j = 0; j < 3; ++j) { const int e = F.tid + 512 * j; if (e < 1280) *(LAS v4u*)(Pin + (e >> 4) * 128 + (e & 15) * 8) = pr[j]; }
    { const GAS v4u* wp = (const GAS v4u*)((const bf16*)(F.ws + WS_WPOOL) + gi * 128 * 128);
#pragma unroll
      for (int i = 0; i < 4; ++i) { const int e = F.tid + 512 * i; const int d = e >> 4, kq = e & 15; *(LAS v4u*)(Wt + d * 136 + kq * 8) = wp[e]; } }
    if (has_next) pool_load(F, nb, ntc, ngi, pr);
    __syncthreads();
#pragma unroll 4
    for (int t = 0; t < 16; ++t) { const int i = seg * 16 + t; int lo = i - hw2, hi = i + hw2; lo = lo < lo_b ? lo_b : lo; hi = hi > hi_b ? hi_b : hi;
        float sm = 0.f; for (int r = lo; r < hi; ++r) sm += bf2f(Pin[(r + 8) * 128 + ch]);
        Pl[i * 136 + ch] = (bf16)f2bf(sm / (float)(hi - lo) - bf2f(Pin[(i + 8) * 128 + ch])); }
    __syncthreads();
    f32x4 acc[4]; const float zf = opaque_zero();
#pragma unroll
    for (int i = 0; i < 4; ++i) acc[i] = (f32x4){zf, zf, zf, zf};
    mma_rows16<4, 4>(acc, Pl, 136, 16 * mt, Wt, 136, 64 * nh, F.lane);
    const int t = 16 * mt + lr;
    const float* ps = F.in[12] + l * HW + gi * 128 + 64 * nh + 4 * lq;
    bf16* yp = Y + (size_t)(row0 + t) * DM + HW + gi * 128 + 64 * nh + 4 * lq;
#pragma unroll
    for (int i = 0; i < 4; ++i) { const f32x4 w4 = *(const GAS f32x4*)(ps + 16 * i);
        *(GAS unsigned long long*)(yp + 16 * i) = (unsigned long long)pk2(acc[i].x * w4.x, acc[i].y * w4.y) | ((unsigned long long)pk2(acc[i].z * w4.z, acc[i].w * w4.w) << 32); }
    __syncthreads();
}

#ifndef USE_OLD_SCAN
#define USE_OLD_SCAN 0
#endif
#ifndef PREP_INPLACE
#define PREP_INPLACE 1
#endif
constexpr size_t WS_O = WS_KV, WS_KE = WS_KV + 68 * MiB, WS_VT = 536 * MiB;
__device__ __forceinline__ void prep_load(const GAS bf16* rowp, int h, int tid, v4u (&r)[8]) {
#pragma unroll
    for (int j = 0; j < 2; ++j) { const int e = tid + 512 * j; const GAS bf16* p = rowp + (size_t)(e >> 4) * INC + h * 128 + (e & 15) * 8;
        r[j] = *(const GAS v4u*)(p); r[2 + j] = *(const GAS v4u*)(p + HW); r[4 + j] = *(const GAS v4u*)(p + 3 * HW); r[6 + j] = *(const GAS v4u*)(p + 2 * HW); }
}
typedef float f32x2 __attribute__((ext_vector_type(2)));
__device__ __forceinline__ f32x2 bf2x(unsigned u) { return (f32x2){__builtin_bit_cast(float, u << 16), __builtin_bit_cast(float, u & 0xffff0000u)}; }
__device__ __forceinline__ void phase_prep(Frame& F, int l) {
    LAS unsigned* Raw = (LAS unsigned*)(F.lds);
    LAS bf16* Qt = (LAS bf16*)(F.lds); LAS bf16* Kt = (LAS bf16*)(F.lds + 17408); LAS bf16* Pm = (LAS bf16*)(F.lds + 34816);
    LAS bf16* vT = (LAS bf16*)(F.lds + 65536); LAS float* tot = (LAS float*)(F.lds + 83968);
    GAS bf16* PX = (GAS bf16*)(F.ws + WS_PX); GAS bf16* KE = (GAS bf16*)(F.ws + WS_KE); GAS bf16* VT = (GAS bf16*)(F.ws + WS_VT); GAS float* DEC = (GAS float*)(F.ws + WS_DEC); GAS bf16* O = (GAS bf16*)(F.ws + WS_O);
    const int s8 = F.tid >> 6, cp = F.tid & 63, mt = F.wave >> 1, nh = F.wave & 1, lr = F.lane & 15, lq = F.lane >> 4;
    const int nit = NBATCH * 4 * NCH;
    v4u rr[8];
    auto item_row0 = [](int it) { const int tc = it >> 5, b = (it >> 2) & 7; return (tc < 4) ? b * CTXL + tc * 64 : NC + b * SEQL + (tc - 4) * 64; };
    if (F.vcu < nit) prep_load(PX + (size_t)item_row0(F.vcu) * INC, F.vcu & 3, F.tid, rr);
#pragma unroll 1
    for (int it = F.vcu; it < nit; it += F.G) {
        const int h = it & 3, b = (it >> 2) & 7, tc = it >> 5, row0 = item_row0(it);
        const bool outp = (l == 0) || (tc >= 4);
#pragma unroll
        for (int j = 0; j < 2; ++j) { const int e = F.tid + 512 * j; const int o4 = (e >> 4) * 64 + (e & 15) * 4;
#pragma unroll
            for (int x = 0; x < 4; ++x) *(LAS v4u*)(Raw + x * 4096 + o4) = rr[2 * x + j]; }
        if (it + F.G < nit) prep_load(PX + (size_t)item_row0(it + F.G) * INC, (it + F.G) & 3, F.tid, rr);
        __syncthreads();
        unsigned zf[8], zb[8], qv[8], vv[8];
#pragma unroll
        for (int t = 0; t < 8; ++t) { const int o = (s8 * 8 + t) * 64 + cp; zf[t] = Raw[o]; zb[t] = Raw[4096 + o]; qv[t] = Raw[8192 + o]; vv[t] = Raw[12288 + o]; }
        __syncthreads();
        { v4u lo, hi;
          lo.x = (vv[0] & 0xffffu) | (vv[1] << 16); lo.y = (vv[2] & 0xffffu) | (vv[3] << 16); lo.z = (vv[4] & 0xffffu) | (vv[5] << 16); lo.w = (vv[6] & 0xffffu) | (vv[7] << 16);
          hi.x = (vv[0] >> 16) | (vv[1] & 0xffff0000u); hi.y = (vv[2] >> 16) | (vv[3] & 0xffff0000u); hi.z = (vv[4] >> 16) | (vv[5] & 0xffff0000u); hi.w = (vv[6] >> 16) | (vv[7] & 0xffff0000u);
          *(LAS v4u*)(vT + (2 * cp) * 72 + s8 * 8) = lo; *(LAS v4u*)(vT + (2 * cp + 1) * 72 + s8 * 8) = hi;
          GAS bf16* vt = VT + (size_t)((b * 4 + h) * NCH + tc) * 8192;
          *(GAS v4u*)(vt + (2 * cp) * 64 + s8 * 8) = lo; *(GAS v4u*)(vt + (2 * cp + 1) * 64 + s8 * 8) = hi; }
        float qs0[8], qs1[8];
#pragma unroll
        for (int t = 0; t < 8; ++t) { const f32x2 q = bf2x(qv[t]); qs0[t] = q.x * sigmoidf_(q.x) * 0.08838834764831845f; qs1[t] = q.y * sigmoidf_(q.y) * 0.08838834764831845f; }
#pragma unroll 1
        for (int dir = 0; dir < 2; ++dir) {
            const int seq = (b * 4 + h) * 2 + dir, c = (tc < 4) ? (dir ? 3 - tc : tc) : (dir ? 71 - tc : tc);
            const float lb0 = lb_of(F, l, dir, h * 128 + 2 * cp), lb1 = lb_of(F, l, dir, h * 128 + 2 * cp + 1);
            const float lbf0 = fmaxf(lb0, 1e-30f), oml0 = 1.0f - lb0, lbf1 = fmaxf(lb1, 1e-30f), oml1 = 1.0f - lb1;
            float g0[8], g1[8], k0[8], k1[8];
#pragma unroll
            for (int t = 0; t < 8; ++t) { const f32x2 z = bf2x(dir ? zb[t] : zf[t]); const float a0 = sigmoidf_(z.x), a1 = sigmoidf_(z.y);
                g0[t] = __logf(lbf0 + oml0 * a0); k0[t] = oml0 * (1.0f - a0); g1[t] = __logf(lbf1 + oml1 * a1); k1[t] = oml1 * (1.0f - a1); }
            if (dir == 0) {
#pragma unroll
                for (int t = 1; t < 8; ++t) { g0[t] += g0[t - 1]; g1[t] += g1[t - 1]; }
                *(LAS f32x2*)(tot + s8 * 128 + 2 * cp) = (f32x2){g0[7], g1[7]};
            } else {
#pragma unroll
                for (int t = 6; t >= 0; --t) { g0[t] += g0[t + 1]; g1[t] += g1[t + 1]; }
                *(LAS f32x2*)(tot + s8 * 128 + 2 * cp) = (f32x2){g0[0], g1[0]};
            }
            __syncthreads();
            float off0 = 0.f, off1 = 0.f, m0 = 0.f, m1 = 0.f, bt0 = 0.f, bt1 = 0.f;
#pragma unroll
            for (int sg = 0; sg < 8; ++sg) { const f32x2 tv = *(const LAS f32x2*)(tot + sg * 128 + 2 * cp);
                const bool before = dir ? (sg > s8) : (sg < s8), firsthalf = dir ? (sg >= 4) : (sg < 4);
                if (before) { off0 += tv.x; off1 += tv.y; } if (firsthalf) { m0 += tv.x; m1 += tv.y; } bt0 += tv.x; bt1 += tv.y; }
            { unsigned ka[4], kb[4];
#pragma unroll
              for (int t = 0; t < 8; t += 2) { ka[t >> 1] = pg8::cvt_pk_bf16(k0[t] * __expf(bt0 - (g0[t] + off0)), k0[t + 1] * __expf(bt0 - (g0[t + 1] + off0)));
                  kb[t >> 1] = pg8::cvt_pk_bf16(k1[t] * __expf(bt1 - (g1[t] + off1)), k1[t + 1] * __expf(bt1 - (g1[t + 1] + off1))); }
              GAS bf16* ke = KE + (size_t)(seq * NCH + c) * 8192;
              *(GAS v4u*)(ke + (2 * cp) * 64 + s8 * 8) = (v4u){ka[0], ka[1], ka[2], ka[3]}; *(GAS v4u*)(ke + (2 * cp + 1) * 64 + s8 * 8) = (v4u){kb[0], kb[1], kb[2], kb[3]}; }
            if (s8 == 0) *(GAS f32x2*)(DEC + (size_t)(seq * NCH + c) * 128 + 2 * cp) = (f32x2){__expf(bt0), __expf(bt1)};
            if (outp) {
#pragma unroll
                for (int t = 0; t < 8; ++t) { const int tok = s8 * 8 + t; const float b0 = g0[t] + off0, b1 = g1[t] + off1;
                    if (PREP_INPLACE) *(GAS unsigned*)(PX + (size_t)(row0 + tok) * INC + dir * HW + h * 128 + 2 * cp) = pg8::cvt_pk_bf16(qs0[t] * __expf(fmaxf(b0, -80.f)), qs1[t] * __expf(fmaxf(b1, -80.f)));
                    *(LAS unsigned*)(Qt + tok * 136 + 2 * cp) = pg8::cvt_pk_bf16(qs0[t] * __expf(clamp80(b0 - m0)), qs1[t] * __expf(clamp80(b1 - m1)));
                    *(LAS unsigned*)(Kt + tok * 136 + 2 * cp) = pg8::cvt_pk_bf16(k0[t] * __expf(clamp80(m0 - b0)), k1[t] * __expf(clamp80(m1 - b1))); }
            }
            __syncthreads();
            if (outp) {
                const float zf0 = opaque_zero();
                f32x4 pa[2] = {(f32x4){zf0, zf0, zf0, zf0}, (f32x4){zf0, zf0, zf0, zf0}};
                mma_rows16<4, 2>(pa, Qt, 136, 16 * mt, Kt, 136, 32 * nh, F.lane);
                const int t = 16 * mt + lr;
#pragma unroll
                for (int i = 0; i < 2; ++i) { const int s0 = 32 * nh + 16 * i + 4 * lq; float p[4];
#pragma unroll
                    for (int x = 0; x < 4; ++x) { const int s = s0 + x; const bool keep = dir ? (s >= t) : (s <= t); p[x] = keep ? pa[i][x] : 0.f; }
                    *(LAS unsigned long long*)(Pm + t * 72 + s0) = (unsigned long long)pg8::cvt_pk_bf16(p[0], p[1]) | ((unsigned long long)pg8::cvt_pk_bf16(p[2], p[3]) << 32); }
            }
            __syncthreads();
            if (outp) {
                const float zf0 = opaque_zero();
                f32x4 oa[4];
#pragma unroll
                for (int i = 0; i < 4; ++i) oa[i] = (f32x4){zf0, zf0, zf0, zf0};
                mma_rows16<2, 4>(oa, Pm, 72, 16 * mt, vT, 72, 64 * nh, F.lane);
                GAS bf16* op = O + ((size_t)dir * NTOK + row0 + 16 * mt + lr) * HW + h * 128 + 64 * nh + 4 * lq;
#pragma unroll
                for (int i = 0; i < 4; ++i) *(GAS unsigned long long*)(op + 16 * i) = (unsigned long long)pg8::cvt_pk_bf16(oa[i].x, oa[i].y) | ((unsigned long long)pg8::cvt_pk_bf16(oa[i].z, oa[i].w) << 32);
            }
            __syncthreads();
        }
    }
}

__device__ __forceinline__ void scan2_load(const GAS bf16* qrow, const GAS bf16* ke, const GAS bf16* vt, int tid, v4u (&r)[6]) {
#pragma unroll
    for (int j = 0; j < 2; ++j) { const int e = tid + 512 * j; r[j] = *(const GAS v4u*)(qrow + (size_t)(e >> 4) * INC + (e & 15) * 8); r[2 + j] = ((const GAS v4u*)ke)[e]; r[4 + j] = ((const GAS v4u*)vt)[e]; }
}
__device__ __forceinline__ void scan_unit(Frame& F, int l, int u, bool dry = false) {
    constexpr int SETB = 54784;
    const GAS bf16* PX = (const GAS bf16*)(F.ws + WS_PX); const GAS bf16* KE = (const GAS bf16*)(F.ws + WS_KE); const GAS bf16* VT = (const GAS bf16*)(F.ws + WS_VT); const GAS float* DEC = (const GAS float*)(F.ws + WS_DEC);
    const int w = F.wave, lr = F.lane & 15, lq = F.lane >> 4;
    const int dir = u & 1, h = (u >> 1) & 3, b = u >> 3;
    GAS bf16* O = (GAS bf16*)(F.ws + WS_O) + (size_t)dir * NTOK * HW;
    const float zf = opaque_zero();
    f32x4 st[8];
#pragma unroll
    for (int i = 0; i < 8; ++i) st[i] = (f32x4){zf, zf, zf, zf};
    v4u ra[6], rb[6]; float da = 0.f, db = 0.f; unsigned long long oa[4] = {0ull, 0ull, 0ull, 0ull}, ob[4] = {0ull, 0ull, 0ull, 0ull};
#define SCAN_TC(c) (((c) < 4) ? (dir ? 3 - (c) : (c)) : (dir ? 71 - (c) : (c)))
#define SCAN_LOAD(R, D, OO, c) do { scan2_load(PX + (size_t)chunk_row0(b, dir, (c)) * INC + dir * HW + h * 128, KE + (size_t)(u * NCH + (c)) * 8192, VT + (size_t)((b * 4 + h) * NCH + SCAN_TC(c)) * 8192, F.tid, R); \
        if (F.tid < 128) D = DEC[(size_t)(u * NCH + (c)) * 128 + F.tid]; \
        if (l == 0 || (c) >= 4) { _Pragma("unroll") for (int m2 = 0; m2 < 4; ++m2) OO[m2] = *(const GAS unsigned long long*)(O + (size_t)(chunk_row0(b, dir, (c)) + 16 * m2 + lr) * HW + h * 128 + 16 * w + 4 * lq); } } while (0)
#define SCAN_STAGE(R, D, set) do { LAS bf16* q_ = (LAS bf16*)(F.lds + (set) * SETB); LAS bf16* k_ = (LAS bf16*)(F.lds + (set) * SETB + 17408); LAS bf16* v_ = (LAS bf16*)(F.lds + (set) * SETB + 35840); \
        _Pragma("unroll") for (int j = 0; j < 2; ++j) { const int e = F.tid + 512 * j; \
            *(LAS v4u*)(q_ + (e >> 4) * 136 + (e & 15) * 8) = R[j]; *(LAS v4u*)(k_ + (e >> 3) * 72 + (e & 7) * 8) = R[2 + j]; *(LAS v4u*)(v_ + (e >> 3) * 72 + (e & 7) * 8) = R[4 + j]; } \
        if (F.tid < 128) ((LAS float*)(F.lds + (set) * SETB + 54272))[F.tid] = D; } while (0)
#define SCAN_STEP(c, RN, DN, ON) do { \
        const int row0 = chunk_row0(b, dir, (c)), set = (c) & 1; const bool outp = (l == 0) || ((c) >= 4); \
        const LAS bf16* Qb = (const LAS bf16*)(F.lds + set * SETB); const LAS bf16* keT = (const LAS bf16*)(F.lds + set * SETB + 17408); const LAS bf16* vT = (const LAS bf16*)(F.lds + set * SETB + 35840); \
        const LAS float* decv = (const LAS float*)(F.lds + set * SETB + 54272); \
        unsigned long long oc_[4], onx_[4]; _Pragma("unroll") for (int m2 = 0; m2 < 4; ++m2) { oc_[m2] = ocur[m2]; onx_[m2] = ON[m2]; } \
        if ((c) + 1 < NCH) SCAN_STAGE(RN, DN, set ^ 1); \
        if ((c) + 3 < NCH) SCAN_LOAD(RN, DN, ON, (c) + 3); \
        if (outp) { \
            bf16x8 sf[4]; \
            _Pragma("unroll") for (int s = 0; s < 4; ++s) { const v4u x = (v4u){pk2(st[2 * s].x, st[2 * s].y), pk2(st[2 * s].z, st[2 * s].w), pk2(st[2 * s + 1].x, st[2 * s + 1].y), pk2(st[2 * s + 1].z, st[2 * s + 1].w)}; sf[s] = __builtin_bit_cast(bf16x8, x); } \
            _Pragma("unroll") for (int mp = 0; mp < 2; ++mp) {          \
                bf16x8 qa_[2][4]; f32x4 o_[2]; \
                _Pragma("unroll") for (int mm = 0; mm < 2; ++mm) { const int m2 = 2 * mp + mm; const LAS bf16* qrow = Qb + (16 * m2 + lr) * 136 + 4 * lq; \
                    _Pragma("unroll") for (int s = 0; s < 4; ++s) { const unsigned long long a0 = *(const LAS unsigned long long*)(qrow + 32 * s), a1 = *(const LAS unsigned long long*)(qrow + 32 * s + 16); \
                        const v4u ax = (v4u){(unsigned)a0, (unsigned)(a0 >> 32), (unsigned)a1, (unsigned)(a1 >> 32)}; qa_[mm][s] = __builtin_bit_cast(bf16x8, ax); } \
                    const unsigned long long ov = oc_[m2]; \
                    o_[mm] = (f32x4){bf2f((unsigned short)(ov & 0xffff)), bf2f((unsigned short)((ov >> 16) & 0xffff)), bf2f((unsigned short)((ov >> 32) & 0xffff)), bf2f((unsigned short)(ov >> 48))}; } \
                _Pragma("unroll") for (int s = 0; s < 4; ++s) \
                    _Pragma("unroll") for (int mm = 0; mm < 2; ++mm) o_[mm] = __builtin_amdgcn_mfma_f32_16x16x32_bf16(sf[s], qa_[mm][s], o_[mm], 0, 0, 0); \
                _Pragma("unroll") for (int mm = 0; mm < 2; ++mm) { const int m2 = 2 * mp + mm; \
                    GAS unsigned long long* op = (GAS unsigned long long*)(O + (size_t)(row0 + 16 * m2 + lr) * HW + h * 128 + 16 * w + 4 * lq); \
                    if (!dry) *op = (unsigned long long)pk2(o_[mm].x, o_[mm].y) | ((unsigned long long)pk2(o_[mm].z, o_[mm].w) << 32); else asm volatile("" :: "v"(o_[mm].x), "v"(o_[mm].y), "v"(o_[mm].z), "v"(o_[mm].w)); } \
            } \
        } \
        { _Pragma("unroll") for (int i = 0; i < 8; ++i) { const f32x4 d4 = *(const LAS f32x4*)(decv + 16 * i + 4 * lq); st[i] = st[i] * d4; } \
          _Pragma("unroll") for (int s2 = 0; s2 < 2; ++s2) { bf16x8 kb_[8];         \
              const bf16x8 va_ = *(const LAS bf16x8*)(vT + (16 * w + lr) * 72 + 32 * s2 + 8 * lq); \
              _Pragma("unroll") for (int i = 0; i < 8; ++i) kb_[i] = *(const LAS bf16x8*)(keT + (16 * i + lr) * 72 + 32 * s2 + 8 * lq); \
              _Pragma("unroll") for (int i = 0; i < 8; ++i) st[i] = __builtin_amdgcn_mfma_f32_16x16x32_bf16(kb_[i], va_, st[i], 0, 0, 0); } } \
        _Pragma("unroll") for (int m2 = 0; m2 < 4; ++m2) ocur[m2] = onx_[m2]; \
        __syncthreads(); } while (0)
    unsigned long long ocur[4];
    SCAN_LOAD(rb, db, ob, 0); SCAN_STAGE(rb, db, 0);
#pragma unroll
    for (int m2 = 0; m2 < 4; ++m2) ocur[m2] = ob[m2];
    SCAN_LOAD(ra, da, oa, 1); SCAN_LOAD(rb, db, ob, 2);
    __syncthreads();
    SCAN_STEP(0, ra, da, oa);
#pragma unroll 1
    for (int c = 1; c + 1 < NCH; c += 2) { SCAN_STEP(c, rb, db, ob); SCAN_STEP(c + 1, ra, da, oa); }
    SCAN_STEP(NCH - 1, rb, db, ob);
#undef SCAN_TC
#undef SCAN_LOAD
#undef SCAN_STAGE
#undef SCAN_STEP
}

#ifndef DIAG_CHECK_PREP
#define DIAG_CHECK_PREP 0
#endif
__device__ __forceinline__ void diag_check_prep(Frame& F, int l) {
    const GAS bf16* KE = (const GAS bf16*)(F.ws + WS_KE); const GAS bf16* VT = (const GAS bf16*)(F.ws + WS_VT); const GAS float* DEC = (const GAS float*)(F.ws + WS_DEC);
    bool bad = false;
    const size_t gt = (size_t)F.vcu * 512 + F.tid, gs = (size_t)F.G * 512;
    for (size_t i = gt; i < (size_t)NSEQ * NCH * 128; i += gs) { const float d = DEC[i]; if (!(d >= 0.f && d <= 1.0001f)) bad = true; }
    for (size_t i = gt; i < (size_t)NSEQ * NCH * 8192; i += gs) { const float k = bf2f(KE[i]); if (!(k >= 0.f && k <= 1.01f)) bad = true; }
    for (size_t i = gt; i < (size_t)NBATCH * 4 * NCH * 8192; i += gs) { const float v = bf2f(VT[i]); if (!(fabsf(v) < 100.f)) bad = true; }
    if (bad) ((float*)(F.ws + WS_MOD))[(size_t)9 * 6144 + 5120] = __builtin_nanf("");
}
#ifndef REP_SCAN
#define REP_SCAN 0
#endif
#ifndef REP_POOL
#define REP_POOL 0
#endif
__device__ __forceinline__ void phase_scan_pool(Frame& F, int l) {
    const bool split = F.G > NSEQ;
    if (!split || F.vcu < NSEQ) { for (int rep = 0; rep < 1 + REP_SCAN; ++rep) for (int u = F.vcu; u < NSEQ; u += F.G) scan_unit(F, l, u, rep < REP_SCAN); }
    if (!split || F.vcu >= NSEQ) {
        const int tc_lo = (l == 0) ? 0 : 4, nit = (NCH - tc_lo) * NBATCH * 4;
        const int start = split ? F.vcu - NSEQ : F.vcu, stride = split ? F.G - NSEQ : F.G;
        for (int rep = 0; rep < 1 + REP_POOL; ++rep) { v4u pr[3];
            if (start < nit) pool_load(F, (start >> 2) & 7, tc_lo + (start >> 5), start & 3, pr);
            for (int it = start; it < nit; it += stride) { const int nx = it + stride; pool_item(F, l, (it >> 2) & 7, tc_lo + (it >> 5), it & 3, pr, nx < nit, (nx >> 2) & 7, tc_lo + (nx >> 5), nx & 3); } }
    }
}
__device__ __forceinline__ void phase_hnorm(Frame& F, int l) {
    const bf16* PX = (const bf16*)(F.ws + WS_PX); const bf16* O = (const bf16*)(F.ws + WS_KV); bf16* Y = (bf16*)(F.ws + WS_HX);
    const int gw = F.vcu * NWAVES + F.wave, NGW = F.G * NWAVES, r_lo = (l == 0) ? 0 : NC;
    const f32x4 w0 = *(const GAS f32x4*)(F.in[10] + l * 128 + (F.lane & 15) * 8), w1 = *(const GAS f32x4*)(F.in[10] + l * 128 + (F.lane & 15) * 8 + 4);
    for (int row = r_lo + gw; row < NTOK; row += NGW) {
        const v4u a = *(const GAS v4u*)(O + (size_t)row * HW + F.lane * 8), bb = *(const GAS v4u*)(O + ((size_t)NTOK + row) * HW + F.lane * 8), gg = *(const GAS v4u*)(PX + (size_t)row * INC + 4 * HW + F.lane * 8);
        float o[8], gt[8];
        o[0] = bf2f((unsigned short)(a.x & 0xffff)) + bf2f((unsigned short)(bb.x & 0xffff)); o[1] = bf2f((unsigned short)(a.x >> 16)) + bf2f((unsigned short)(bb.x >> 16));
        o[2] = bf2f((unsigned short)(a.y & 0xffff)) + bf2f((unsigned short)(bb.y & 0xffff)); o[3] = bf2f((unsigned short)(a.y >> 16)) + bf2f((unsigned short)(bb.y >> 16));
        o[4] = bf2f((unsigned short)(a.z & 0xffff)) + bf2f((unsigned short)(bb.z & 0xffff)); o[5] = bf2f((unsigned short)(a.z >> 16)) + bf2f((unsigned short)(bb.z >> 16));
        o[6] = bf2f((unsigned short)(a.w & 0xffff)) + bf2f((unsigned short)(bb.w & 0xffff)); o[7] = bf2f((unsigned short)(a.w >> 16)) + bf2f((unsigned short)(bb.w >> 16));
        gt[0] = bf2f((unsigned short)(gg.x & 0xffff)); gt[1] = bf2f((unsigned short)(gg.x >> 16)); gt[2] = bf2f((unsigned short)(gg.y & 0xffff)); gt[3] = bf2f((unsigned short)(gg.y >> 16));
        gt[4] = bf2f((unsigned short)(gg.z & 0xffff)); gt[5] = bf2f((unsigned short)(gg.z >> 16)); gt[6] = bf2f((unsigned short)(gg.w & 0xffff)); gt[7] = bf2f((unsigned short)(gg.w >> 16));
        float s = 0.f;
#pragma unroll
        for (int i = 0; i < 8; ++i) s += o[i] * o[i];
        s += shx(s, 1, F.lane); s += shx(s, 2, F.lane); s += shx(s, 4, F.lane); s += shx(s, 8, F.lane);
        const float rn = 1.0f / sqrtf(s * (1.f / 128.f) + EPSN);
        const float wv[8] = {w0.x, w0.y, w0.z, w0.w, w1.x, w1.y, w1.z, w1.w}; float y[8];
#pragma unroll
        for (int i = 0; i < 8; ++i) y[i] = o[i] * rn * wv[i] * (gt[i] * sigmoidf_(gt[i]));
        *(GAS v4u*)(Y + (size_t)row * DM + F.lane * 8) = (v4u){pk2(y[0], y[1]), pk2(y[2], y[3]), pk2(y[4], y[5]), pk2(y[6], y[7])};
    }
}
__device__ __forceinline__ int moe_row_base(int l) { return l == 0 ? 0 : NC; }
__device__ __forceinline__ int moe_half_rows(int l) { return (l == 0 ? NTOK : NX) / NHALF; }


#ifndef DIAG_NAIVE_HGRN
#define DIAG_NAIVE_HGRN 0
#endif
#ifndef DIAG_ROUTER_F32
#define DIAG_ROUTER_F32 0
#endif
#ifndef DIAG_NAIVE_MOE
#define DIAG_NAIVE_MOE 0
#endif
#ifndef DIAG_NAIVE_ROUTE
#define DIAG_NAIVE_ROUTE 0
#endif
#ifndef DIAG_NAIVE_INPROJ
#define DIAG_NAIVE_INPROJ 0
#endif
#ifndef DIAG_NAIVE_OUTPROJ
#define DIAG_NAIVE_OUTPROJ 0
#endif
#ifndef DIAG_CHECK_SLOTS
#define DIAG_CHECK_SLOTS 0
#endif
#ifndef DIAG_NAIVE_MOD
#define DIAG_NAIVE_MOD 0
#endif
#ifndef DIAG_NAIVE_POOL
#define DIAG_NAIVE_POOL 0
#endif
__device__ __forceinline__ void diag_hgrn_scan(Frame& F, int l) {
    LAS float* fz = (LAS float*)(F.lds); LAS float* fk = fz + 128; LAS float* fq = fk + 128; LAS float* fv = fq + 128; LAS float* po = fv + 128;
    const bf16* PX = (const bf16*)(F.ws + WS_PX); float* OBUF = (float*)(F.ws + WS_KV);
    const int v = F.tid & 127, kq = F.tid >> 7;
    for (int it = F.vcu; it < NSEQ; it += F.G) {
        const int dir = it & 1, h = (it >> 1) & 3, b = it >> 3;
        float S[32];
#pragma unroll
        for (int i = 0; i < 32; ++i) S[i] = 0.f;
        const float lb = lb_of(F, l, dir, h * 128 + v), lbf = fmaxf(lb, 1e-30f), oml = 1.0f - lb;
        for (int step = 0; step < CTXL + SEQL; ++step) {
            int row;
            if (step < CTXL) row = b * CTXL + (dir ? CTXL - 1 - step : step);
            else { const int t = step - CTXL; row = NC + b * SEQL + (dir ? SEQL - 1 - t : t); }
            const bf16* pr = PX + (size_t)row * INC;
            if (kq == 0) { const float z = bf2f(pr[dir * HW + h * 128 + v]); const float sg = sigmoidf_(z); fz[v] = lbf + oml * sg; fk[v] = oml * (1.0f - sg); }
            if (kq == 1) { const float q = bf2f(pr[3 * HW + h * 128 + v]); fq[v] = q * sigmoidf_(q) * 0.08838834764831845f; }
            if (kq == 2) fv[v] = bf2f(pr[2 * HW + h * 128 + v]);
            __syncthreads();
            const float vv = fv[v]; float o = 0.f;
#pragma unroll
            for (int i = 0; i < 32; ++i) { const int k = kq * 32 + i; S[i] = fz[k] * S[i] + fk[k] * vv; o += S[i] * fq[k]; }
            po[kq * 128 + v] = o;
            __syncthreads();
            if (kq == 0) OBUF[((size_t)dir * NTOK + row) * HW + h * 128 + v] = (po[v] + po[128 + v]) + (po[256 + v] + po[384 + v]);
        }
        __syncthreads();
    }
}
__device__ __forceinline__ void diag_hgrn_norm(Frame& F, int l) {
    const bf16* PX = (const bf16*)(F.ws + WS_PX); const float* OBUF = (const float*)(F.ws + WS_KV); bf16* Y = (bf16*)(F.ws + WS_HX);
    const int gw = F.vcu * NWAVES + F.wave, NGW = F.G * NWAVES;
    const int r_lo = (l == 0) ? 0 : NC;
    for (int i = gw; i < (NTOK - r_lo) * 4; i += NGW) {
        const int row = r_lo + (i >> 2), h = i & 3;
        const float o0 = OBUF[(size_t)row * HW + h * 128 + F.lane] + OBUF[((size_t)NTOK + row) * HW + h * 128 + F.lane];
        const float o1 = OBUF[(size_t)row * HW + h * 128 + 64 + F.lane] + OBUF[((size_t)NTOK + row) * HW + h * 128 + 64 + F.lane];
        const float rn = 1.0f / sqrtf(wave_sum(o0 * o0 + o1 * o1, F.lane) * (1.f / 128.f) + EPSN);
        const float g0 = bf2f(PX[(size_t)row * INC + 4 * HW + h * 128 + F.lane]), g1 = bf2f(PX[(size_t)row * INC + 4 * HW + h * 128 + 64 + F.lane]);
        Y[(size_t)row * DM + h * 128 + F.lane] = (bf16)f2bf(o0 * rn * F.in[10][l * 128 + F.lane] * (g0 * sigmoidf_(g0)));
        Y[(size_t)row * DM + h * 128 + 64 + F.lane] = (bf16)f2bf(o1 * rn * F.in[10][l * 128 + 64 + F.lane] * (g1 * sigmoidf_(g1)));
    }
}
__device__ __forceinline__ void diag_pool(Frame& F, int l) {
    LAS float* pl = (LAS float*)(F.lds);
    const bf16* PX = (const bf16*)(F.ws + WS_PX); bf16* Y = (bf16*)(F.ws + WS_HX);
    const int sub = F.tid >> 7, d = F.tid & 127;
    const int r_lo = (l == 0) ? 0 : NC;
    for (int it = F.vcu; it < (NTOK - r_lo); it += F.G) {
        const int row = r_lo + it, gi = sub, wdw = 2 << gi, hw2 = wdw >> 1;
        int pos, n, srow;
        if (row < NC) { pos = row % CTXL; n = CTXL; srow = row - pos; } else { pos = (row - NC) % 64; n = 64; srow = row - pos; }
        int lo = pos - hw2, hi = pos + hw2; lo = lo < 0 ? 0 : lo; hi = hi > n ? n : hi;
        float sm = 0.f; for (int r = lo; r < hi; ++r) sm += bf2f(PX[(size_t)(srow + r) * INC + 5 * HW + gi * 128 + d]);
        pl[sub * 128 + d] = sm / (float)(hi - lo) - bf2f(PX[(size_t)row * INC + 5 * HW + gi * 128 + d]);
        __syncthreads();
        const float* wp = F.in[11] + (size_t)(l * 4 + gi) * 128 * 128;
        float o = 0.f; for (int c = 0; c < 128; ++c) o += pl[sub * 128 + c] * wp[c * 128 + d];
        Y[(size_t)row * DM + HW + gi * 128 + d] = (bf16)f2bf(o * F.in[12][l * HW + gi * 128 + d]);
        __syncthreads();
    }
}

__device__ __forceinline__ void diag_moe(Frame& F, int l, int half) {
    LAS float* xs = (LAS float*)(F.lds + F.wave * 16384);
    const bf16* HX = (const bf16*)(F.ws + WS_HX); bf16* YS = (bf16*)(F.ws + WS_YS);
    const int* blke = (const int*)(F.ws + RT_BLKE) + half * MAXBLK; const int* stok = (const int*)(F.ws + RT_STOK) + half * MAXSLOT;
    const int nblk = ((const int*)(F.ws + RT_MISC))[half];
    const int gw = F.vcu * NWAVES + F.wave, NGW = F.G * NWAVES;
    for (int it = gw; it < nblk * 64; it += NGW) {
        const int slot0 = it * 4, e = blke[slot0 >> 8];
        const float* w1 = (e < 64) ? F.in[16] + ((size_t)l * 64 + e) * DM * 256 : F.in[19] + (size_t)l * DM * 256;
        const float* w3 = (e < 64) ? F.in[17] + ((size_t)l * 64 + e) * DM * 256 : F.in[20] + (size_t)l * DM * 256;
        const float* w2 = (e < 64) ? F.in[18] + ((size_t)l * 64 + e) * 256 * DM : F.in[21] + (size_t)l * 256 * DM;
#pragma unroll
        for (int r = 0; r < 4; ++r) { const bf16* xr = HX + (size_t)stok[slot0 + r] * DM;
            for (int k = F.lane; k < DM; k += 64) xs[r * 1024 + k] = bf2f(xr[k]); }
        LDS_WAIT(); asm volatile("" ::: "memory");
        float a1[4][4], a3[4][4];
#pragma unroll
        for (int r = 0; r < 4; ++r)
#pragma unroll
            for (int i = 0; i < 4; ++i) { a1[r][i] = 0.f; a3[r][i] = 0.f; }
        for (int k = 0; k < DM; ++k) {
            float x4[4];
#pragma unroll
            for (int r = 0; r < 4; ++r) x4[r] = xs[r * 1024 + k];
#pragma unroll
            for (int i = 0; i < 4; ++i) { const float u1 = w1[(size_t)k * 256 + F.lane + 64 * i], u3 = w3[(size_t)k * 256 + F.lane + 64 * i];
#pragma unroll
                for (int r = 0; r < 4; ++r) { a1[r][i] += x4[r] * u1; a3[r][i] += x4[r] * u3; } }
        }
        LDS_WAIT(); asm volatile("" ::: "memory");
#pragma unroll
        for (int r = 0; r < 4; ++r)
#pragma unroll
            for (int i = 0; i < 4; ++i) xs[r * 256 + F.lane + 64 * i] = a1[r][i] * sigmoidf_(a1[r][i]) * a3[r][i];
        LDS_WAIT(); asm volatile("" ::: "memory");
#pragma unroll 1
        for (int dh = 0; dh < 4; ++dh) {
            float y[4][4];
#pragma unroll
            for (int r = 0; r < 4; ++r)
#pragma unroll
                for (int i = 0; i < 4; ++i) y[r][i] = 0.f;
            for (int n = 0; n < 256; ++n) {
                float h4[4];
#pragma unroll
                for (int r = 0; r < 4; ++r) h4[r] = xs[r * 256 + n];
#pragma unroll
                for (int i = 0; i < 4; ++i) { const float u = w2[(size_t)n * DM + dh * 256 + F.lane + 64 * i];
#pragma unroll
                    for (int r = 0; r < 4; ++r) y[r][i] += h4[r] * u; }
            }
#pragma unroll
            for (int r = 0; r < 4; ++r)
#pragma unroll
                for (int i = 0; i < 4; ++i) YS[(size_t)(slot0 + r) * DM + dh * 256 + F.lane + 64 * i] = (bf16)f2bf(y[r][i]);
        }
        LDS_WAIT(); asm volatile("" ::: "memory");
    }
}

__device__ __forceinline__ void diag_gemm(Frame& F, int l, int mode) {
    LAS float* As = (LAS float*)(F.lds); LAS float* Bs = As + 16 * 65;
    const int N = mode ? DM : INC, rbase = (mode && l == 1) ? NC : 0, M = NTOK - rbase;
    const bf16* A = (const bf16*)(F.ws + WS_HX) + (size_t)rbase * DM;
    const float* W = mode ? F.in[13] + (size_t)l * DM * DM : F.in[8] + (size_t)l * DM * INC;
    const int ty = F.tid >> 5, tx = F.tid & 31, ntn = N / 128;
    for (int it = F.vcu; it < (M / 64) * ntn; it += F.G) {
        const int m0 = (it / ntn) * 64, n0 = (it % ntn) * 128;
        float acc[4][4];
#pragma unroll
        for (int i = 0; i < 4; ++i)
#pragma unroll
            for (int j = 0; j < 4; ++j) acc[i][j] = 0.f;
        for (int k0 = 0; k0 < DM; k0 += 16) {
            { const int idx = F.tid * 2, r = idx >> 4, kk = idx & 15; const unsigned u = *(const unsigned*)(A + (size_t)(m0 + r) * DM + k0 + kk);
              As[kk * 65 + r] = bf2f((unsigned short)(u & 0xffff)); As[(kk + 1) * 65 + r] = bf2f((unsigned short)(u >> 16)); }
            { const int r = F.tid >> 5, c4 = (F.tid & 31) * 4; *(LAS f32x4*)(Bs + r * 128 + c4) = *(const GAS f32x4*)(W + (size_t)(k0 + r) * N + n0 + c4); }
            __syncthreads();
#pragma unroll
            for (int kk = 0; kk < 16; ++kk) { float a[4]; f32x4 b = *(const LAS f32x4*)(Bs + kk * 128 + tx * 4);
#pragma unroll
                for (int i = 0; i < 4; ++i) a[i] = As[kk * 65 + ty * 4 + i];
#pragma unroll
                for (int i = 0; i < 4; ++i) { acc[i][0] += a[i] * b.x; acc[i][1] += a[i] * b.y; acc[i][2] += a[i] * b.z; acc[i][3] += a[i] * b.w; } }
            __syncthreads();
        }
#pragma unroll
        for (int i = 0; i < 4; ++i) { const int row = rbase + m0 + ty * 4 + i, col = n0 + tx * 4;
            if (mode == 0) { bf16* px = (bf16*)(F.ws + WS_PX) + (size_t)row * INC + col;
                *(unsigned long long*)px = (unsigned long long)pk2(acc[i][0], acc[i][1]) | ((unsigned long long)pk2(acc[i][2], acc[i][3]) << 32); }
            else { const float* bp = resid_in_row(F, l, row) + col; float* op = resid_row(F, row) + col; const float* gt = (const float*)(F.ws + WS_MOD) + ((size_t)l * 9 + mod_row(row)) * 6144 + 2048 + col;
                const f32x4 b = *(const GAS f32x4*)bp, g = *(const GAS f32x4*)gt; *(GAS f32x4*)op = (f32x4){b.x + g.x * acc[i][0], b.y + g.y * acc[i][1], b.z + g.z * acc[i][2], b.w + g.w * acc[i][3]}; } }
    }
}

__device__ __forceinline__ void diag_check_slots(Frame& F, int l) {
    const int rb = moe_row_base(l), nhalf = moe_half_rows(l);
    const int* IDX = (const int*)(F.ws + RT_IDX); const int* TSLOT = (const int*)(F.ws + RT_TSLOT); const int* STOK = (const int*)(F.ws + RT_STOK); const int* BLKE = (const int*)(F.ws + RT_BLKE); const int* MISCT = (const int*)(F.ws + RT_MISC);
    bool bad = false;
    for (int a = F.vcu * 512 + F.tid; a < 2 * nhalf * 6; a += F.G * 512) {
        const int row = rb + a / 6, half = (a / 6) >= nhalf ? 1 : 0; const int slot = TSLOT[(size_t)rb * 6 + a], e = IDX[(size_t)rb * 6 + a];
        if (slot < 0 || slot >= MISCT[half] * 256) bad = true;
        else { if (STOK[half * MAXSLOT + slot] != row) bad = true; if (BLKE[half * MAXBLK + (slot >> 8)] != e) bad = true; }
    }
    for (int i = F.vcu * 512 + F.tid; i < 2 * nhalf; i += F.G * 512) { const int half = i >= nhalf ? 1 : 0, ii = i - half * nhalf; const int slot = MISCT[2 + half] + ii;
        if (STOK[half * MAXSLOT + slot] != rb + i) bad = true; if (BLKE[half * MAXBLK + (slot >> 8)] != 64) bad = true; }
    if (bad) F.out[0] = __builtin_nanf("");
    if (bad) ((float*)(F.ws + WS_MOD))[5120] = __builtin_nanf("");
}

__device__ __forceinline__ void diag_mod(Frame& F) {
    float* mod = (float*)(F.ws + WS_MOD);
    for (int i = F.vcu * 512 + F.tid; i < 2 * 6144; i += F.G * 512) {
        const int l = i / 6144, n = i % 6144; float acc[9];
        for (int r = 0; r < 9; ++r) acc[r] = 0.f;
        for (int k = 0; k < DM; ++k) { const float w = F.in[6][((size_t)l * DM + k) * 6144 + n];
            for (int r = 0; r < 9; ++r) { const float c = (r < 8) ? F.in[1][r * DM + k] : F.in[3][k]; acc[r] += (c / (1.0f + expf(-c))) * w; } }
        for (int r = 0; r < 9; ++r) mod[((size_t)l * 9 + r) * 6144 + n] = acc[r] + F.in[7][(size_t)l * 6144 + n];
    }
}

__device__ __forceinline__ void phase_route(Frame& F, int l, bool dry = false) {
    LAS bf16* Xt = (LAS bf16*)(F.lds);
    LAS float* Lg = (LAS float*)(F.lds + 32 * 2064);
    LAS unsigned* lcnt = (LAS unsigned*)(F.lds + 32 * 2064 + 8192);
    const GAS float* mod = (const GAS float*)(F.ws + WS_MOD) + (size_t)l * 9 * 6144;
    GAS bf16* HX = (GAS bf16*)(F.ws + WS_HX); const GAS bf16* WrT = (const GAS bf16*)(F.ws + WS_WR);
    GAS int* IDX = (GAS int*)(F.ws + RT_IDX); GAS float* GATE = (GAS float*)(F.ws + RT_GATE);
    const int rb = moe_row_base(l), nhalf = moe_half_rows(l), ntiles = NHALF * nhalf / 32;
    const int lr = F.lane & 15, lq = F.lane >> 4, w = F.wave;
    if (F.tid < 128) lcnt[F.tid] = 0u;
    if (F.vcu == 0) { unsigned z0 = 0u; asm volatile("" : "+v"(z0)); for (int i = F.tid; i < DM / 16; i += 512) ((GAS v4u*)((GAS unsigned char*)HX + (size_t)NTOK * DM))[i] = (v4u){z0, z0, z0, z0}; }
    const int mt = w >> 2, nt = w & 3;
    bf16x8 wf[32];
#pragma unroll
    for (int s2 = 0; s2 < 32; ++s2) wf[s2] = *(const GAS bf16x8*)(WrT + (size_t)(16 * nt + lr) * DM + 32 * s2 + 8 * lq);
    const float rbias = ((const GAS float*)F.in[15])[l * NE + F.lane];
    const GAS f32x4* nw = (const GAS f32x4*)(F.in[5] + l * DM);
    __syncthreads();
    for (int it = F.vcu; it < ntiles; it += F.G) {
        const int row0 = rb + it * 32;
        {
#pragma unroll
          for (int ip = 0; ip < 2; ++ip) { f32x4 xv[2][4];
#pragma unroll
          for (int i = 0; i < 2; ++i) { const GAS f32x4* xr = (const GAS f32x4*)resid_row(F, row0 + w * 4 + 2 * ip + i) + F.lane;
#pragma unroll
              for (int j = 0; j < 4; ++j) xv[i][j] = xr[64 * j]; }
#pragma unroll
          for (int i = 0; i < 2; ++i) { const int lrow = w * 4 + 2 * ip + i, row = row0 + lrow; const GAS float* md = mod + mod_row(row) * 6144;
              float ss = 0.f;
#pragma unroll
              for (int j = 0; j < 4; ++j) ss += (xv[i][j].x * xv[i][j].x + xv[i][j].y * xv[i][j].y) + (xv[i][j].z * xv[i][j].z + xv[i][j].w * xv[i][j].w);
              const float r = 1.0f / sqrtf(wave_sum(ss, F.lane) * (1.f / DM) + EPSN);
#pragma unroll
              for (int j = 0; j < 4; ++j) { const f32x4 w4 = nw[F.lane + 64 * j], s4 = ((const GAS f32x4*)(md + 4096))[F.lane + 64 * j], h4 = ((const GAS f32x4*)(md + 3072))[F.lane + 64 * j];
                  const f32x4 o = (xv[i][j] * r) * w4 * (s4 + 1.0f) + h4;
                  const unsigned long long pk = (unsigned long long)pk2(o.x, o.y) | ((unsigned long long)pk2(o.z, o.w) << 32);
                  int w8 = 0; w8 = __builtin_amdgcn_cvt_pk_fp8_f32(o.x, o.y, w8, false); w8 = __builtin_amdgcn_cvt_pk_fp8_f32(o.z, o.w, w8, true);
                  ((GAS unsigned*)((GAS unsigned char*)HX + (size_t)row * DM))[F.lane + 64 * j] = (unsigned)w8;
                  *(LAS unsigned long long*)(Xt + lrow * 1032 + 4 * (F.lane + 64 * j)) = pk; } } } }
        __syncthreads();
        { const float zf = opaque_zero(); f32x4 a4 = (f32x4){zf, zf, zf, zf};
#pragma unroll
          for (int s2 = 0; s2 < 32; ++s2) { const bf16x8 a = *(const LAS bf16x8*)(Xt + (16 * mt + lr) * 1032 + 32 * s2 + 8 * lq); a4 = __builtin_amdgcn_mfma_f32_16x16x32_bf16(wf[s2], a, a4, 0, 0, 0); }
          *(LAS f32x4*)(Lg + (16 * mt + lr) * 64 + 16 * nt + 4 * lq) = a4; }
        __syncthreads();
        { float sc[4], bs[4], gs[4], msk[4], ssum[4], myg2[4]; int myi[4], sel[4];
#pragma unroll
          for (int i = 0; i < 4; ++i) { sc[i] = sigmoidf_(Lg[(w * 4 + i) * 64 + F.lane]); bs[i] = sc[i] + rbias; ssum[i] = 0.f; sel[i] = 0; myi[i] = 0; myg2[i] = 0.f; }
          { float m1[4], m2[4];
#pragma unroll
            for (int i = 0; i < 4; ++i) m1[i] = bs[i];
#pragma unroll
            for (int o = 1; o < 8; o <<= 1)
#pragma unroll
                for (int i = 0; i < 4; ++i) m1[i] = fmaxf(m1[i], shx(m1[i], o, F.lane));
            const int gb = F.lane & ~7;
#pragma unroll
            for (int i = 0; i < 4; ++i) { const unsigned long long bal = __ballot(bs[i] == m1[i]); const unsigned gm = (unsigned)((bal >> gb) & 0xffull); const int first = gb + __ffs((int)gm) - 1; m2[i] = (F.lane == first) ? -3.0e38f : bs[i]; }
#pragma unroll
            for (int o = 1; o < 8; o <<= 1)
#pragma unroll
                for (int i = 0; i < 4; ++i) m2[i] = fmaxf(m2[i], shx(m2[i], o, F.lane));
#pragma unroll
            for (int i = 0; i < 4; ++i) gs[i] = m1[i] + m2[i]; }
          { const int myg = F.lane >> 3; int rank[4] = {0, 0, 0, 0};
#pragma unroll
            for (int g2 = 0; g2 < 8; ++g2)
#pragma unroll
                for (int i = 0; i < 4; ++i) { const float og = shl(gs[i], g2 * 8); rank[i] += ((og > gs[i]) || (og == gs[i] && g2 < myg)) ? 1 : 0; }
#pragma unroll
            for (int i = 0; i < 4; ++i) msk[i] = (rank[i] < 4) ? bs[i] : -1.0e4f; }
#pragma unroll
          for (int jj = 0; jj < 6; ++jj) { float mx[4];
#pragma unroll
              for (int i = 0; i < 4; ++i) mx[i] = msk[i];
#pragma unroll
              for (int o = 1; o < 64; o <<= 1)
#pragma unroll
                  for (int i = 0; i < 4; ++i) mx[i] = fmaxf(mx[i], shx(mx[i], o, F.lane));
#pragma unroll
              for (int i = 0; i < 4; ++i) { const unsigned long long b2 = __ballot(msk[i] == mx[i]); const int win = __ffsll((long long)b2) - 1;
                  const float wv = shl(sc[i], win); ssum[i] += wv; if (F.lane == jj) { myi[i] = win; myg2[i] = wv; } if (F.lane == win) { msk[i] = -3.0e38f; sel[i] = 1; } } }
#pragma unroll
          for (int i = 0; i < 4; ++i) { const int row = row0 + w * 4 + i; const float inv = 2.5f / ssum[i];
              if (F.lane < 6) { IDX[(size_t)row * 6 + F.lane] = myi[i]; GATE[(size_t)row * 6 + F.lane] = myg2[i] * inv; }
              const int half = (row - rb) >= nhalf ? 1 : 0;
              if (sel[i] && !dry) __hip_atomic_fetch_add(&lcnt[half * 64 + F.lane], 1u, __ATOMIC_RELAXED, __HIP_MEMORY_SCOPE_WORKGROUP); } }
        __syncthreads();
    }
    __syncthreads();
    if (F.tid < 128) { const unsigned v = lcnt[F.tid]; if (v) atomicAdd(F.ctl + CW_CNT + l * 128 + F.tid, v); }
}

__device__ __forceinline__ void phase_slots(Frame& F, int l) {
    LAS int* pstart = (LAS int*)(F.lds);
    LAS int* cntl = (LAS int*)(F.lds + 1024);
    LAS unsigned* lc = (LAS unsigned*)(F.lds + 2048);
    LAS unsigned* lbase = (LAS unsigned*)(F.lds + 2560);
    const int rb = moe_row_base(l), nhalf = moe_half_rows(l);
    const int* IDX = (const int*)(F.ws + RT_IDX); int* TSLOT = (int*)(F.ws + RT_TSLOT); int* STOK = (int*)(F.ws + RT_STOK); int* BLKE = (int*)(F.ws + RT_BLKE); int* MISC = (int*)(F.ws + RT_MISC);
    if (F.tid < 128) cntl[F.tid] = (int)__hip_atomic_load(F.ctl + CW_CNT + l * 128 + F.tid, __ATOMIC_RELAXED, __HIP_MEMORY_SCOPE_AGENT);
    __syncthreads();
    if (F.tid < NHALF) { int s = 0; for (int e = 0; e < 64; ++e) { pstart[F.tid * 66 + e] = s; s += (cntl[F.tid * 64 + e] + 255) & ~255; } pstart[F.tid * 66 + 64] = s; pstart[F.tid * 66 + 65] = s + nhalf; }
    __syncthreads();
    for (int w = F.vcu; w < NHALF * 65; w += F.G) {
        const int half = w / 65, e = w % 65; int* stok = STOK + half * MAXSLOT; int* blke = BLKE + half * MAXBLK;
        const int ps = pstart[half * 66 + e], pe = pstart[half * 66 + e + 1];
        for (int b = ps / 256 + F.tid; b < pe / 256; b += 512) blke[b] = e;
        if (e < 64) { for (int s = ps + cntl[half * 64 + e] + F.tid; s < pe; s += 512) stok[s] = NTOK; }
        else { for (int i = F.tid; i < nhalf; i += 512) stok[ps + i] = rb + half * nhalf + i;
               if (F.tid == 0) { MISC[half] = pe / 256; MISC[2 + half] = ps; } }
    }
    const int tpc = NHALF * nhalf / 256;
    for (int ck = F.vcu; ck < 256; ck += F.G) {
        const int half = (ck * tpc) / nhalf, tok0 = rb + ck * tpc; int* stok = STOK + half * MAXSLOT;
        if (F.tid < 64) lc[F.tid] = 0u;
        __syncthreads();
        int e0 = -1, e1 = -1; unsigned p0 = 0, p1 = 0; const int a0 = F.tid, a1 = F.tid + 512;
        if (a0 < tpc * 6) { e0 = IDX[(size_t)tok0 * 6 + a0]; p0 = __hip_atomic_fetch_add(&lc[e0], 1u, __ATOMIC_RELAXED, __HIP_MEMORY_SCOPE_WORKGROUP); }
        if (a1 < tpc * 6) { e1 = IDX[(size_t)tok0 * 6 + a1]; p1 = __hip_atomic_fetch_add(&lc[e1], 1u, __ATOMIC_RELAXED, __HIP_MEMORY_SCOPE_WORKGROUP); }
        __syncthreads();
        if (F.tid < 64) { const unsigned n = lc[F.tid]; lbase[F.tid] = n ? atomicAdd(F.ctl + CW_CUR + l * 128 + half * 64 + F.tid, n) : 0u; }
        __syncthreads();
        if (e0 >= 0) { const int slot = pstart[half * 66 + e0] + (int)(lbase[e0] + p0); stok[slot] = tok0 + a0 / 6; TSLOT[(size_t)tok0 * 6 + a0] = slot; }
        if (e1 >= 0) { const int slot = pstart[half * 66 + e1] + (int)(lbase[e1] + p1); stok[slot] = tok0 + a1 / 6; TSLOT[(size_t)tok0 * 6 + a1] = slot; }
        __syncthreads();
    }
}

__device__ __forceinline__ void phase_combine(Frame& F, int l, int half) {
    const int gw = F.vcu * NWAVES + F.wave, NGW = F.G * NWAVES;
    const int rb = moe_row_base(l), nhalf = moe_half_rows(l);
    const GAS float* mod = (const GAS float*)(F.ws + WS_MOD) + (size_t)l * 9 * 6144;
    const GAS int* TSLOT = (const GAS int*)(F.ws + RT_TSLOT); const GAS float* GATE = (const GAS float*)(F.ws + RT_GATE); const int* MISC = (const int*)(F.ws + RT_MISC);
    const GAS unsigned char* YS = (const GAS unsigned char*)(F.ws + WS_YS); GAS bf16* HX = (GAS bf16*)(F.ws + WS_HX);
    const int shs = MISC[2 + half], c0 = 8 * F.lane;
    int sl[6]; float gj[6];
    if (gw < nhalf) { const size_t a = (size_t)(rb + half * nhalf + gw) * 6;
#pragma unroll
        for (int j = 0; j < 6; ++j) { sl[j] = TSLOT[a + j]; gj[j] = GATE[a + j]; } }
    for (int i = gw; i < nhalf; i += NGW) {
        const int row = rb + half * nhalf + i;
        GAS float* xr = (GAS float*)resid_row(F, row); const GAS float* gt = mod + mod_row(row) * 6144 + 5120;
        unsigned long long ya[7][2];
#pragma unroll
        for (int j = 0; j < 6; ++j) { const GAS unsigned char* yp = YS + (size_t)sl[j] * DM + c0; ya[j][0] = *(const GAS unsigned long long*)yp; ya[j][1] = *(const GAS unsigned long long*)(yp + 512); }
        { const GAS unsigned char* yp = YS + (size_t)(shs + i) * DM + c0; ya[6][0] = *(const GAS unsigned long long*)yp; ya[6][1] = *(const GAS unsigned long long*)(yp + 512); }
        f32x4 xv[4], g4[4];
#pragma unroll
        for (int q = 0; q < 4; ++q) { const int co = c0 + (q >> 1) * 512 + (q & 1) * 4; xv[q] = *(const GAS f32x4*)(xr + co); g4[q] = *(const GAS f32x4*)(gt + co); }
        float gc[7];
#pragma unroll
        for (int j = 0; j < 6; ++j) gc[j] = gj[j] * (1.0f / pg8::YS_SCALE);
        gc[6] = 1.0f / pg8::YS_SCALE;
        if (i + NGW < nhalf) { const size_t a = (size_t)(row + NGW) * 6;
#pragma unroll
            for (int j = 0; j < 6; ++j) { sl[j] = TSLOT[a + j]; gj[j] = GATE[a + j]; } }
        float y[16]; const float zf = opaque_zero();
#pragma unroll
        for (int k = 0; k < 16; ++k) y[k] = zf;
#pragma unroll
        for (int j = 0; j < 7; ++j)
#pragma unroll
            for (int hh = 0; hh < 2; ++hh) { const int lo = (int)(unsigned)ya[j][hh], hi = (int)(unsigned)(ya[j][hh] >> 32);
                const pg8::f32v2_t a0 = __builtin_amdgcn_cvt_pk_f32_fp8(lo, false), a1 = __builtin_amdgcn_cvt_pk_f32_fp8(lo, true), a2 = __builtin_amdgcn_cvt_pk_f32_fp8(hi, false), a3 = __builtin_amdgcn_cvt_pk_f32_fp8(hi, true);
                y[8 * hh + 0] += gc[j] * a0.x; y[8 * hh + 1] += gc[j] * a0.y; y[8 * hh + 2] += gc[j] * a1.x; y[8 * hh + 3] += gc[j] * a1.y;
                y[8 * hh + 4] += gc[j] * a2.x; y[8 * hh + 5] += gc[j] * a2.y; y[8 * hh + 6] += gc[j] * a3.x; y[8 * hh + 7] += gc[j] * a3.y; }
        float ss = 0.f;
#pragma unroll
        for (int q = 0; q < 4; ++q) { xv[q] = xv[q] + g4[q] * (f32x4){y[4 * q], y[4 * q + 1], y[4 * q + 2], y[4 * q + 3]};
            ss += (xv[q].x * xv[q].x + xv[q].y * xv[q].y) + (xv[q].z * xv[q].z + xv[q].w * xv[q].w); }
        const float r = 1.0f / sqrtf(wave_sum(ss, F.lane) * (1.f / DM) + EPSN);
        if (l == 1) {
#pragma unroll
            for (int q = 0; q < 4; ++q) { const int co = c0 + (q >> 1) * 512 + (q & 1) * 4; const f32x4 w4 = *(const GAS f32x4*)((const GAS float*)F.in[22] + co); *(GAS f32x4*)(xr + co) = xv[q] * r * w4; }
        } else {
            const GAS float* md1 = mod + (size_t)(9 + mod_row(row)) * 6144; const GAS float* nw = (const GAS float*)F.in[4] + DM;
            unsigned pk[8];
#pragma unroll
            for (int q = 0; q < 4; ++q) { const int co = c0 + (q >> 1) * 512 + (q & 1) * 4; *(GAS f32x4*)(xr + co) = xv[q];
                const f32x4 w4 = *(const GAS f32x4*)(nw + co), s4 = *(const GAS f32x4*)(md1 + 1024 + co), h4 = *(const GAS f32x4*)(md1 + co);
                const f32x4 o = (xv[q] * r) * w4 * (s4 + 1.0f) + h4; pk[2 * q] = pk2(o.x, o.y); pk[2 * q + 1] = pk2(o.z, o.w); }
            *(GAS v4u*)(HX + (size_t)row * DM + c0) = (v4u){pk[0], pk[1], pk[2], pk[3]}; *(GAS v4u*)(HX + (size_t)row * DM + 512 + c0) = (v4u){pk[4], pk[5], pk[6], pk[7]};
        }
    }
}

constexpr int PH_PER_LAYER = 14, N_PHASES = 1 + 2 * PH_PER_LAYER;
#ifndef MK_PER_PHASE
#define MK_PER_PHASE 0
#endif
struct Args { const float* in[23]; float* out; unsigned char* ws; int ph_lo, ph_hi; };
__global__ void __launch_bounds__(NWAVES * 64, 2) mk_fwd(Args args) {
    {
        LAS unsigned char* lds = (LAS unsigned char*)g_lds;
        for (int u = threadIdx.x; u < (LDS_BYTES - LDSCTL_OFF) / 4; u += NWAVES * 64) ((LAS unsigned*)(lds + LDSCTL_OFF))[u] = 0u;
        __syncthreads();
        LAS unsigned long long* tab = (LAS unsigned long long*)(lds + TAB_OFF);
        if (threadIdx.x < 23) tab[threadIdx.x] = (unsigned long long)args.in[threadIdx.x];
        if (threadIdx.x == 23) tab[23] = (unsigned long long)args.out;
        if (threadIdx.x == 24) tab[24] = (unsigned long long)args.ws;
        __syncthreads();
#if !MK_PER_PHASE
        if (threadIdx.x == 0) (void)xb_add((unsigned*)(args.ws + WS_CTL) + CW_BAR + XB_XCNT(xb_xcc_id()), 1u);
#endif
    }
#if MK_PER_PHASE
    const int lo = args.ph_lo, hi = args.ph_hi;
#define IN(k) (lo <= (k) && (k) < hi)
#define SEAM(k) do { } while (0)
#else
#define IN(k) true
#define SEAM(k) do { grid_barrier(); if (REP_MASK & 0x10000u) { grid_barrier(); grid_barrier(); } if (TIMING_MASK) { if (blockIdx.x == 0 && threadIdx.x == 0) ((unsigned long long*)(args.ws + WS_CTL + 65536))[1 + seam_id] = __builtin_amdgcn_s_memrealtime(); ++seam_id; } } while (0)
#endif
#ifndef GEMM2_STAGGER
#define GEMM2_STAGGER 0
#endif
#ifndef REP_MASK
#define REP_MASK 0u
#endif
#ifndef TIMING_MASK
#define TIMING_MASK 0u
#endif
#define REP(c) (1 + ((REP_MASK >> (c)) & 1u))
#ifndef PH_MASK
#define PH_MASK 0xffffffffu
#endif
#define INM(k, c) (IN(k) && ((PH_MASK >> (c)) & 1u))
    int seam_id = 0; (void)seam_id;
    if (TIMING_MASK) { if (blockIdx.x == 0 && threadIdx.x == 0) ((unsigned long long*)(args.ws + WS_CTL + 65536))[0] = __builtin_amdgcn_s_memrealtime(); }
    if (INM(0, 0)) { Frame F = make_frame(); phase_mod(F); __syncthreads(); for (int rep = 0; rep < REP(12); ++rep) phase_wconv(F, 0); }
    SEAM(0);
#if DIAG_NAIVE_MOD
    { Frame F = make_frame(); diag_mod(F); } SEAM(0);
#endif
#pragma unroll 1
    for (int l = 0; l < 2; ++l) {
        const int P = 1 + l * PH_PER_LAYER; (void)P;
        if (l == 0) {
            if (INM(P + 0, 1)) for (int rep = 0; rep < REP(1); ++rep) { Frame F = make_frame(); phase_hx(F, l); }
            SEAM(P + 0);
        }
#if DIAG_NAIVE_INPROJ
        { Frame F = make_frame(); diag_gemm(F, l, 0); }
#else
        if (INM(P + 1, 2)) for (int rep = 0; rep < REP(2); ++rep) {
            Frame F = make_frame(); unsigned char* ws = F.ws;
            pg8::Gemm g{(const bf16*)(ws + WS_HX), (const bf16*)(ws + WS_WIN), DM, nullptr}; pg8::StaticOrder S; S.init(NTOK, INC, F.G, (int)blockIdx.x);
            pg8::EpiB16 E{(bf16*)(ws + WS_PX), INC, 0xffff};
            pg8::gemm_phase<pg8::EpiB16, pg8::StaticOrder, true, false>(F.lds, g, S, E);
        }
#endif
        SEAM(P + 1);
        if (INM(P + 2, 3)) for (int rep = 0; rep < REP(13); ++rep) { Frame F = make_frame(); phase_prep(F, l); }
        SEAM(P + 2);
#if DIAG_CHECK_PREP
        { Frame F = make_frame(); diag_check_prep(F, l); } SEAM(P + 2);
#endif
        if (INM(P + 2, 3)) { Frame F = make_frame(); phase_scan_pool(F, l); }
        SEAM(P + 2);
        if (INM(P + 3, 4)) for (int rep = 0; rep < REP(4); ++rep) { Frame F = make_frame(); phase_hnorm(F, l); }
        SEAM(P + 3);
#if DIAG_NAIVE_HGRN
        { Frame F = make_frame(); diag_hgrn_scan(F, l); } SEAM(P + 4);
        { Frame F = make_frame(); diag_hgrn_norm(F, l); } SEAM(P + 4);
#endif
#if DIAG_NAIVE_POOL
        { Frame F = make_frame(); diag_pool(F, l); } SEAM(P + 4);
#endif
#if DIAG_NAIVE_OUTPROJ
        { Frame F = make_frame(); diag_gemm(F, l, 1); }
#else
        if (INM(P + 5, 6)) for (int rep = 0; rep < (l == 0 ? REP(6) : 1); ++rep) {
            Frame F = make_frame(); unsigned char* ws = F.ws;
            const int rbase = l == 0 ? 0 : NC;
            pg8::Gemm g{(const bf16*)(ws + WS_HX) + (size_t)rbase * DM, (const bf16*)(ws + WS_WOUT), DM, nullptr}; pg8::StaticOrder S; S.init(NTOK - rbase, DM, F.G, (int)blockIdx.x);
            pg8::EpiRes E{l == 0 ? F.in[2] : (const float*)(ws + WS_CTXRES), l == 0 ? F.in[0] : (const float*)F.out, (float*)(ws + WS_CTXRES), F.out, (const float*)(ws + WS_MOD) + (size_t)l * 9 * 6144, 2048, rbase};
            pg8::gemm_phase<pg8::EpiRes, pg8::StaticOrder, true, false>(F.lds, g, S, E);
        }
#endif
        SEAM(P + 5);
        if (INM(P + 6, 7)) for (int rep = 0; rep < REP(7); ++rep) { Frame F = make_frame(); phase_route(F, l, rep + 1 < REP(7)); }
        SEAM(P + 6);
        if (INM(P + 7, 8)) { Frame F = make_frame(); phase_slots(F, l); }
        SEAM(P + 7);
#if DIAG_CHECK_SLOTS
        { Frame F = make_frame(); diag_check_slots(F, l); } SEAM(P + 7);
#endif
#pragma unroll 1
        for (int half = 0; half < NHALF; ++half) {
            const int Q = P + 8 + 3 * half; (void)Q;
            if (INM(Q + 0, 9)) for (int rep = 0; rep < REP(9); ++rep) {
                Frame F = make_frame(); unsigned char* ws = F.ws;
                const int* blke = (const int*)(ws + RT_BLKE) + half * MAXBLK; const int* stok = (const int*)(ws + RT_STOK) + half * MAXSLOT;
                const int nblk = __builtin_amdgcn_readfirstlane(((const int*)(ws + RT_MISC))[half]);
                int k1 = DM / 2; asm volatile("" : "+s"(k1));
                pg8::Gemm g{(const bf16*)(ws + WS_HX), (const bf16*)(ws + WS_W13), k1, stok, 0x7a7a7a7a}; pg8::MoeOrder S{blke, nblk, 2, F.G, F.vcu};
                pg8::EpiSwiglu E{(unsigned char*)(ws + WS_HS)};
                pg8::gemm_phase<pg8::EpiSwiglu, pg8::MoeOrder, true, true, true>(F.lds, g, S, E);
            }
            SEAM(Q + 0);
            if (INM(Q + 1, 10)) for (int rep = 0; rep < REP(10); ++rep) {
                Frame F = make_frame(); unsigned char* ws = F.ws;
                const int* blke = (const int*)(ws + RT_BLKE) + half * MAXBLK;
                const int nblk = __builtin_amdgcn_readfirstlane(((const int*)(ws + RT_MISC))[half]);
                if (GEMM2_STAGGER && (F.vcu & 1)) { const unsigned long long t0 = __builtin_amdgcn_s_memrealtime(); while (__builtin_amdgcn_s_memrealtime() - t0 < (unsigned long long)GEMM2_STAGGER) __builtin_amdgcn_s_sleep(8); }
                int k2 = 128; asm volatile("" : "+s"(k2));
                pg8::Gemm g{(const bf16*)(ws + WS_HS), (const bf16*)(ws + WS_W2), k2, nullptr, 0x7e7e7e7e};     pg8::MoeOrder S{blke, nblk, 4, F.G, F.vcu};
                pg8::EpiF8 E{(unsigned char*)(ws + WS_YS), 3, (rep + 1 < (int)REP(10)) ? 1 : 0};
                pg8::gemm_phase<pg8::EpiF8, pg8::MoeOrder, true, false, true>(F.lds, g, S, E);
            }
            SEAM(Q + 1);
#if DIAG_NAIVE_MOE
            { Frame F = make_frame(); diag_moe(F, l, half); } SEAM(Q + 1);
#endif
            if (INM(Q + 2, 11)) { Frame F = make_frame(); phase_combine(F, l, half); if (l == 0 && half == NHALF - 1) for (int rep = 0; rep < REP(12); ++rep) phase_wconv(F, 1); }
            if (!(l == 1 && half == NHALF - 1)) SEAM(Q + 2);
        }
    }
    if (TIMING_MASK) {
        SEAM(99);
        const unsigned long long* ts = (const unsigned long long*)(args.ws + WS_CTL + 65536);
        unsigned long long tk = 0ull;
        for (int k = 0; k < seam_id && k < 32; ++k) if ((TIMING_MASK >> k) & 1u) tk += ts[1 + k] - ts[k];
        const float a = sqrtf((float)((tk / 2500ull) * 2500ull) * 0.0001f);
        for (size_t i = (size_t)blockIdx.x * 512 + threadIdx.x; i < (size_t)NX * DM; i += (size_t)gridDim.x * 512) args.out[i] = a;
    }
#undef IN
#undef INM
#undef SEAM
}

extern "C" void kernel_launch(void* const* d_in, const int* in_sizes, int n_in, void* d_out, int out_size, void* d_ws, size_t ws_size, hipStream_t stream) {
    static int grid = 0;
    if (grid == 0) {
        if (n_in != 23 || out_size != NX * DM || ws_size < WS_END) { fprintf(stderr, "kernel_launch: unexpected shapes (n_in %d, out %d, ws %zu); nothing launched\n", n_in, out_size, ws_size); grid = -1; return; }
        int dev = 0, cus = 0;
        if (hipGetDevice(&dev) != hipSuccess || hipDeviceGetAttribute(&cus, hipDeviceAttributeMultiprocessorCount, dev) != hipSuccess) { grid = -1; return; }
        if (hipFuncSetAttribute((const void*)mk_fwd, hipFuncAttributeMaxDynamicSharedMemorySize, LDS_BYTES) != hipSuccess) { fprintf(stderr, "kernel_launch: hipFuncSetAttribute failed\n"); grid = -1; return; }
        (void)hipGetLastError();
        grid = cus;
    }
    if (grid < 0) return;
    if (hipMemsetAsync((char*)d_ws + WS_CTL, 0, CTL_ZERO_BYTES, stream) != hipSuccess) { fprintf(stderr, "kernel_launch: memset failed\n"); return; }
    Args a{};
    for (int i = 0; i < 23; ++i) a.in[i] = (const float*)d_in[i];
    a.out = (float*)d_out; a.ws = (unsigned char*)d_ws;
#if MK_PER_PHASE
    for (int p = 0; p < N_PHASES; ++p) { a.ph_lo = p; a.ph_hi = p + 1; hipLaunchKernelGGL(mk_fwd, dim3(grid), dim3(NWAVES * 64), LDS_BYTES, stream, a); }
#else
    a.ph_lo = 0; a.ph_hi = N_PHASES;
    hipLaunchKernelGGL(mk_fwd, dim3(grid), dim3(NWAVES * 64), LDS_BYTES, stream, a);
#endif
    const hipError_t le = hipPeekAtLastError();
    if (le != hipSuccess) fprintf(stderr, "kernel_launch: launch failed: %s\n", hipGetErrorName(le));
}
```

```cpp
#include <hip/hip_runtime.h>
#include <cstdio>
#include <cstdint>
namespace pg8 {
#define PG8_LAS __attribute__((address_space(3)))
typedef unsigned short bf16_t;
typedef short bf16x8 __attribute__((ext_vector_type(8)));
typedef float f32x4 __attribute__((ext_vector_type(4)));
typedef unsigned u32x4 __attribute__((ext_vector_type(4)));
typedef int v4i_t __attribute__((ext_vector_type(4)));
typedef int v8i_t __attribute__((ext_vector_type(8)));
__device__ __forceinline__ int opaque_tid() { int t = threadIdx.x; asm volatile("" : "+v"(t)); return t; }
constexpr int BM = 256, BK = 64, HALF = 128, HTB = HALF * BK * 2  , STAGE_BYTES = 8 * HTB, NXCD = 8, WGM = 8;

__host__ __device__ __forceinline__ int lds_byte(int r, int c) { const int st = (r >> 4) * 2 + (c >> 5), rr = r & 15, cc = c & 31, ob = rr * 64 + cc * 2; return st * 1024 + (ob ^ (((ob >> 9) & 1) << 5)); }
__host__ __device__ __forceinline__ void stage_rc(int b, int& R, int& C) { const int st = b / 1024, sb = b % 1024, swz = sb ^ (((sb >> 9) & 1) << 5); R = (st >> 1) * 16 + swz / 64; C = (st & 1) * 32 + (swz % 64) / 2; }
__host__ __device__ __forceinline__ int perm32(int rho) { const int n = rho >> 4, i = rho & 15; return 8 * (i >> 2) + 4 * n + (i & 3); }

struct Unit { int pm, pn; };
struct Gemm { const bf16_t* A; const bf16_t* Bt; int K; const int* rowidx; int wsc = 0x7f7f7f7f; };

struct StaticOrder {
    int nM, nN, nwg, G, c;
    __host__ __device__ void init(int M, int N, int G_, int c_) { nM = M / BM; nN = N / BM; nwg = nM * nN; G = G_; c = c_; }
    __host__ __device__ bool next(int i, Unit& u) const {
        const long L = (long)i * G + c; if (L >= nwg) return false;
        int wgid = (int)L; { const int q = nwg / NXCD, r = nwg % NXCD, xcd = wgid % NXCD, off = wgid / NXCD; wgid = (xcd < r ? xcd * (q + 1) : r * (q + 1) + (xcd - r) * q) + off; }
        const int nig = WGM * nN, gid = wgid / nig, fm = gid * WGM, gsz = (nM - fm) < WGM ? (nM - fm) : WGM;
        u.pm = fm + ((wgid % nig) % gsz); u.pn = (wgid % nig) / gsz; return true;
    }
};
struct MoeOrder {
    const int* blk_e; int nblk, NT, G, c;
    __device__ __forceinline__ bool next(int i, Unit& u) const {
        const long L = (long)i * G + c; if (L >= (long)nblk * NT) return false;
        const int blk = (int)(L / NT), pnl = (int)(L % NT); const int e = __builtin_amdgcn_readfirstlane(blk_e[blk]);
        u.pm = blk; u.pn = e * NT + pnl; return true;
    }
};

typedef __bf16 bf16v2_t __attribute__((ext_vector_type(2)));
typedef float f32v2_t __attribute__((ext_vector_type(2)));
__device__ __forceinline__ unsigned cvt_pk_bf16(float lo, float hi) { const f32v2_t v = {lo, hi}; return __builtin_bit_cast(unsigned, __builtin_convertvector(v, bf16v2_t)); }

#ifndef DEG_PX
#define DEG_PX 0
#endif
struct EpiB16 {
    static constexpr bool PERM = true;
    bf16_t* O; int ldc; int pn_mask; int dry = 0;
    __device__ __forceinline__ void operator()(const f32x4 (&acc)[2][2][4][2], const Unit& u, int wr, int wc, int fr, int fq) const {
        const int row0 = u.pm * BM + wr * 64 + fr; const int col0 = (u.pn & pn_mask) * BM + wc * 32 + 8 * fq;
#pragma unroll
        for (int ai = 0; ai < 2; ++ai)
#pragma unroll
            for (int m = 0; m < 4; ++m) { bf16_t* rowp = O + (size_t)(row0 + ai * HALF + m * 16) * ldc + col0;
#pragma unroll
                for (int bj = 0; bj < 2; ++bj) { const f32x4 v0 = acc[ai][bj][m][0], v1 = acc[ai][bj][m][1];
                    u32x4 w; w.x = cvt_pk_bf16(v0[0], v0[1]); w.y = cvt_pk_bf16(v0[2], v0[3]); w.z = cvt_pk_bf16(v1[0], v1[1]); w.w = cvt_pk_bf16(v1[2], v1[3]);
                    if (DEG_PX && pn_mask == 0xffff) { w.x &= 0xfffcfffcu; w.y &= 0xfffcfffcu; w.z &= 0xfffcfffcu; w.w &= 0xfffcfffcu; }
                    if (dry) asm volatile("" :: "v"(w.x), "v"(w.y), "v"(w.z), "v"(w.w)); else *(u32x4*)(rowp + bj * HALF) = w; } }
    }
};
constexpr float YS_SCALE = 8.0f;
struct EpiF8 {
    static constexpr bool PERM = true;
    unsigned char* O; int pn_mask; int dry = 0;
    __device__ __forceinline__ void operator()(const f32x4 (&acc)[2][2][4][2], const Unit& u, int wr, int wc, int fr, int fq) const {
        const int row0 = u.pm * BM + wr * 64 + fr; const int col0 = (u.pn & pn_mask) * BM + wc * 32 + 8 * fq;
#pragma unroll
        for (int ai = 0; ai < 2; ++ai)
#pragma unroll
            for (int m = 0; m < 4; ++m) { unsigned char* rowp = O + (size_t)(row0 + ai * HALF + m * 16) * 1024 + col0;
#pragma unroll
                for (int bj = 0; bj < 2; ++bj) { const f32x4 v0 = acc[ai][bj][m][0], v1 = acc[ai][bj][m][1];
                    int w0 = 0, w1 = 0;
                    w0 = __builtin_amdgcn_cvt_pk_fp8_f32(v0[0], v0[1], w0, false); w0 = __builtin_amdgcn_cvt_pk_fp8_f32(v0[2], v0[3], w0, true);
                    w1 = __builtin_amdgcn_cvt_pk_fp8_f32(v1[0], v1[1], w1, false); w1 = __builtin_amdgcn_cvt_pk_fp8_f32(v1[2], v1[3], w1, true);
                    const unsigned long long pk = (unsigned long long)(unsigned)w0 | ((unsigned long long)(unsigned)w1 << 32);
                    if (dry) asm volatile("" :: "v"(w0), "v"(w1)); else *(unsigned long long*)(rowp + bj * HALF) = pk; }
                asm volatile("" ::: "memory"); }
    }
};
struct EpiRes {
    static constexpr bool PERM = false;
    const float* base_c; const float* base_x; float* out_c; float* out_x; const float* mod; int gt_off; int row_base;
    __device__ __forceinline__ void operator()(const f32x4 (&acc)[2][2][4][2], const Unit& u, int wr, int wc, int fr, int fq) const {
        const int trow = row_base + u.pm * BM;
        const float* bp; float* op; int mr;
        if (trow < 2048) { mr = 8; bp = base_c + (size_t)trow * 1024; op = out_c + (size_t)trow * 1024; }
        else { mr = (trow - 2048) >> 12; bp = base_x + (size_t)(trow - 2048) * 1024; op = out_x + (size_t)(trow - 2048) * 1024; }
        const float* gate = mod + mr * 6144 + gt_off;
        const int r0 = wr * 64 + fr, col0 = u.pn * BM + wc * 32 + 4 * fq;
        f32x4 gv[2][2];
#pragma unroll
        for (int bj = 0; bj < 2; ++bj)
#pragma unroll
            for (int n = 0; n < 2; ++n) gv[bj][n] = *(const f32x4*)(gate + col0 + bj * HALF + n * 16);
#pragma unroll
        for (int ai = 0; ai < 2; ++ai)
#pragma unroll
            for (int m = 0; m < 4; ++m) { const size_t off = (size_t)(r0 + ai * HALF + m * 16) * 1024 + col0;
#pragma unroll
                for (int bj = 0; bj < 2; ++bj)
#pragma unroll
                    for (int n = 0; n < 2; ++n) { const f32x4 b = *(const f32x4*)(bp + off + bj * HALF + n * 16); *(f32x4*)(op + off + bj * HALF + n * 16) = b + gv[bj][n] * acc[ai][bj][m][n]; }
                asm volatile("" ::: "memory"); }
    }
};
struct EpiSwiglu {
    static constexpr bool PERM = false;
    unsigned char* HS;
    __device__ __forceinline__ void operator()(const f32x4 (&acc)[2][2][4][2], const Unit& u, int wr, int wc, int fr, int fq) const {
        const int row0 = u.pm * BM + wr * 64 + fr, hid0 = (u.pn & 1) * 128 + wc * 32 + fq * 8;
#pragma unroll
        for (int ai = 0; ai < 2; ++ai)
#pragma unroll
            for (int m = 0; m < 4; ++m) {
                float h[8];
#pragma unroll
                for (int bj = 0; bj < 2; ++bj)
#pragma unroll
                    for (int i = 0; i < 4; ++i) { const float a = acc[ai][bj][m][0][i], b = acc[ai][bj][m][1][i]; h[bj * 4 + i] = a * __builtin_amdgcn_rcpf(1.0f + __expf(-a)) * b; }
                int w0 = 0, w1 = 0;
                w0 = __builtin_amdgcn_cvt_pk_fp8_f32(h[0], h[1], w0, false); w0 = __builtin_amdgcn_cvt_pk_fp8_f32(h[2], h[3], w0, true);
                w1 = __builtin_amdgcn_cvt_pk_fp8_f32(h[4], h[5], w1, false); w1 = __builtin_amdgcn_cvt_pk_fp8_f32(h[6], h[7], w1, true);
                *(unsigned long long*)(HS + (size_t)(row0 + ai * HALF + m * 16) * 256 + hid0) = (unsigned long long)(unsigned)w0 | ((unsigned long long)(unsigned)w1 << 32); }
    }
};

template <class Epi, class Sched, bool ALIGN_EPI, bool GATHER, bool F8 = false>
__device__ __forceinline__ void gemm_phase(PG8_LAS unsigned char* lds, const Gemm g, const Sched& S, const Epi& E) {
    const int tid = opaque_tid(), wid = __builtin_amdgcn_readfirstlane(tid >> 6), lane = tid & 63, wr = wid >> 2, wc = wid & 3, fr = lane & 15, fq = lane >> 4;
    const int K = g.K, nt = K / BK;
    unsigned voffA[2], voffB[2];
#pragma unroll
    for (int i = 0; i < 2; ++i) { int R, C; stage_rc(tid * 16 + i * 8192, R, C); const int Rb = Epi::PERM ? ((R & ~31) + perm32(R & 31)) : R;
        voffA[i] = (unsigned)(R * K + C) * 2u; voffB[i] = (unsigned)(Rb * K + C) * 2u; }
    const size_t kstep = (size_t)(BK * 2);
    const size_t hstep = (size_t)HALF * K * 2;
    const size_t tstep = 2 * hstep;
    const unsigned ldsw = (unsigned)wid * 1024u;
    const int aoff = lds_byte(wr * 64 + fr, fq * 8), boff = lds_byte(wc * 32 + fr, fq * 8);
#define PG8_SA(b, h) (((b) * 2 + (h)) * HTB)
#define PG8_SB(b, h) ((4 + (b) * 2 + (h)) * HTB)
#define PG8_STAGE(bufoff, gbase, voff) do { _Pragma("unroll") for (int _i = 0; _i < 2; ++_i) \
        __builtin_amdgcn_global_load_lds((const unsigned*)((const char*)(gbase) + (voff)[_i]), (PG8_LAS unsigned*)(lds + (bufoff) + ldsw + _i * 8192), 16, 0, 0); } while (0)
#define PG8_STAGE2(bufoff, gbase, o0, o1) do { \
        __builtin_amdgcn_global_load_lds((const unsigned*)((const char*)(gbase) + (o0)), (PG8_LAS unsigned*)(lds + (bufoff) + ldsw), 16, 0, 0); \
        __builtin_amdgcn_global_load_lds((const unsigned*)((const char*)(gbase) + (o1)), (PG8_LAS unsigned*)(lds + (bufoff) + ldsw + 8192), 16, 0, 0); } while (0)
#define PG8_LD2(p) __builtin_shufflevector(*(const PG8_LAS v4i_t*)(p), *(const PG8_LAS v4i_t*)((p) + 1024), 0, 1, 2, 3, 4, 5, 6, 7)
#define PG8_LDA(dst, b, h) do { _Pragma("unroll") for (int m = 0; m < 4; ++m) dst[m] = PG8_LD2(lds + PG8_SA(b, h) + aoff + m * 2048); } while (0)
#define PG8_LDB(dst, b, h) do { _Pragma("unroll") for (int n = 0; n < 2; ++n) dst[n] = PG8_LD2(lds + PG8_SB(b, h) + boff + n * 2048); } while (0)
#define PG8_HALF(v, k) __builtin_bit_cast(bf16x8, __builtin_shufflevector(v, v, 4 * (k), 4 * (k) + 1, 4 * (k) + 2, 4 * (k) + 3))
#define PG8_MMA(ai, bj, At, Bt) do { __builtin_amdgcn_s_setprio(1); _Pragma("unroll") for (int m = 0; m < 4; ++m) _Pragma("unroll") for (int n = 0; n < 2; ++n) { \
        acc[ai][bj][m][n] = __builtin_amdgcn_mfma_f32_16x16x32_bf16(PG8_HALF(Bt[n], 0), PG8_HALF(At[m], 0), acc[ai][bj][m][n], 0, 0, 0); \
        acc[ai][bj][m][n] = __builtin_amdgcn_mfma_f32_16x16x32_bf16(PG8_HALF(Bt[n], 1), PG8_HALF(At[m], 1), acc[ai][bj][m][n], 0, 0, 0); } __builtin_amdgcn_s_setprio(0); } while (0)
#define PG8_MMA8(ai, bj, At, Bt) do { __builtin_amdgcn_s_setprio(1); _Pragma("unroll") for (int m = 0; m < 4; ++m) _Pragma("unroll") for (int n = 0; n < 2; ++n) { \
        asm volatile("v_mfma_scale_f32_16x16x128_f8f6f4 %0, %1, %2, %0, %3, %4 op_sel_hi:[0,0,0]" : "+v"(acc[ai][bj][m][n]) : "v"(Bt[n]), "v"(At[m]), "v"(scw), "v"(scx)); }     __builtin_amdgcn_s_setprio(0); } while (0)
#define PG8_MM(ai, bj, At, Bt) do { if constexpr (F8) PG8_MMA8(ai, bj, At, Bt); else PG8_MMA(ai, bj, At, Bt); } while (0)
#define PG8_F8PAD do { if constexpr (F8) asm volatile("s_nop 15\n\ts_nop 15\n\ts_nop 15\n\ts_nop 15" ::: "memory"); } while (0)
#define PG8_WAIT_V(n) asm volatile("s_waitcnt vmcnt(" #n ")" ::: "memory")
#define PG8_WAIT_L(n) asm volatile("s_waitcnt lgkmcnt(" #n ")" ::: "memory")
#define PG8_BAR __builtin_amdgcn_s_barrier()
#define PG8_SCHED __builtin_amdgcn_sched_barrier(0)
    Unit cur, nxt; int ui = 0;
    if (!S.next(0, cur)) return;
    float zf = 0.f; asm volatile("" : "+v"(zf));
    f32x4 acc[2][2][4][2];
#pragma unroll
    for (int a = 0; a < 2; ++a)
#pragma unroll
        for (int b = 0; b < 2; ++b)
#pragma unroll
            for (int m = 0; m < 4; ++m)
#pragma unroll
                for (int n = 0; n < 2; ++n) acc[a][b][m][n] = (f32x4){zf, zf, zf, zf};
    v8i_t At[4], B0[2], B1[2];
    int scw = g.wsc, scx = 0x7f7f7f7f;
    if constexpr (F8) { asm volatile("" : "+v"(scw), "+v"(scx)); }
    unsigned oc00 = 0, oc01 = 0, oc10 = 0, oc11 = 0, on00 = 0, on01 = 0, on10 = 0, on11 = 0;
    const char* cA = GATHER ? (const char*)g.A : (const char*)g.A + (size_t)cur.pm * tstep; const char* cB = (const char*)g.Bt + (size_t)cur.pn * tstep;
#define PG8_ROWCOL() int rowA[2]; unsigned colA[2]; { int t_ = tid; asm volatile("" : "+v"(t_)); _Pragma("unroll") for (int i = 0; i < 2; ++i) { int R, C; stage_rc(t_ * 16 + i * 8192, R, C); rowA[i] = R; colA[i] = (unsigned)C * 2u; } }
    if constexpr (GATHER) { PG8_ROWCOL(); const int* ri = g.rowidx + cur.pm * BM; const unsigned rb = (unsigned)K * 2u;
        oc00 = (unsigned)ri[rowA[0]] * rb + colA[0]; oc01 = (unsigned)ri[rowA[1]] * rb + colA[1]; oc10 = (unsigned)ri[HALF + rowA[0]] * rb + colA[0]; oc11 = (unsigned)ri[HALF + rowA[1]] * rb + colA[1]; }
    PG8_STAGE(PG8_SB(0, 0), cB, voffB); PG8_STAGE(PG8_SB(0, 1), cB + hstep, voffB);
    if constexpr (GATHER) { PG8_STAGE2(PG8_SA(0, 0), cA, oc00, oc01); PG8_STAGE2(PG8_SA(0, 1), cA, oc10, oc11); }
    else { PG8_STAGE(PG8_SA(0, 0), cA, voffA); PG8_STAGE(PG8_SA(0, 1), cA + hstep, voffA); }
    if (wr == 1) PG8_BAR;
    PG8_WAIT_V(2); PG8_BAR;
    PG8_STAGE(PG8_SB(1, 0), cB + kstep, voffB);
    if constexpr (GATHER) { PG8_STAGE2(PG8_SA(1, 0), cA + kstep, oc00, oc01); } else { PG8_STAGE(PG8_SA(1, 0), cA + kstep, voffA); }
    PG8_STAGE(PG8_SB(1, 1), cB + hstep + kstep, voffB);
    PG8_WAIT_V(6); PG8_BAR;
    for (;;) {
        const bool has_next = S.next(ui + 1, nxt);
        const char* nA = GATHER ? cA : (has_next ? (const char*)g.A + (size_t)nxt.pm * tstep : cA); const char* nB = has_next ? (const char*)g.Bt + (size_t)nxt.pn * tstep : cB;
        if constexpr (GATHER) {
            if (has_next) { PG8_ROWCOL(); const int* ri = g.rowidx + nxt.pm * BM; const unsigned rb = (unsigned)K * 2u;
                on00 = (unsigned)ri[rowA[0]] * rb + colA[0]; on01 = (unsigned)ri[rowA[1]] * rb + colA[1]; on10 = (unsigned)ri[HALF + rowA[0]] * rb + colA[0]; on11 = (unsigned)ri[HALF + rowA[1]] * rb + colA[1]; }
            else { on00 = oc00; on01 = oc01; on10 = oc10; on11 = oc11; }
        }
        for (int t = 0; t < nt; t += 2) {
            const bool last = (t == nt - 2);
            const char* a1 = cA + (size_t)(t + 1) * kstep;
            const char* a2 = last ? nA : cA + (size_t)(t + 2) * kstep; const char* b2 = last ? nB : cB + (size_t)(t + 2) * kstep;
            const char* a3 = a2 + kstep; const char* b3 = b2 + kstep;
            const unsigned s00 = last ? on00 : oc00, s01 = last ? on01 : oc01, s10 = last ? on10 : oc10, s11 = last ? on11 : oc11;
            PG8_LDB(B0, 0, 0); PG8_LDB(B1, 0, 1); PG8_SCHED; PG8_LDA(At, 0, 0);
            if constexpr (GATHER) { PG8_STAGE2(PG8_SA(1, 1), a1, oc10, oc11); } else { PG8_STAGE(PG8_SA(1, 1), a1 + hstep, voffA); }
            PG8_WAIT_V(8); PG8_WAIT_L(0); PG8_BAR; PG8_MM(0, 0, At, B0); PG8_MM(0, 1, At, B1); PG8_F8PAD; PG8_BAR; PG8_SCHED;
            PG8_LDA(At, 0, 1); PG8_STAGE(PG8_SB(0, 0), b2, voffB); PG8_STAGE(PG8_SB(0, 1), b2 + hstep, voffB);
            if constexpr (GATHER) { PG8_STAGE2(PG8_SA(0, 0), a2, s00, s01); } else { PG8_STAGE(PG8_SA(0, 0), a2, voffA); }
            PG8_WAIT_V(8); PG8_WAIT_L(0); PG8_BAR; PG8_MM(1, 0, At, B0); PG8_MM(1, 1, At, B1); PG8_F8PAD; PG8_BAR; PG8_SCHED;
            PG8_LDB(B0, 1, 0); PG8_LDB(B1, 1, 1); PG8_SCHED; PG8_LDA(At, 1, 0);
            if constexpr (GATHER) { PG8_STAGE2(PG8_SA(0, 1), a2, s10, s11); } else { PG8_STAGE(PG8_SA(0, 1), a2 + hstep, voffA); }
            PG8_WAIT_V(8); PG8_WAIT_L(0); PG8_BAR; PG8_MM(0, 0, At, B0); PG8_MM(0, 1, At, B1); PG8_F8PAD; PG8_BAR; PG8_SCHED;
            PG8_LDA(At, 1, 1); PG8_STAGE(PG8_SB(1, 0), b3, voffB); PG8_STAGE(PG8_SB(1, 1), b3 + hstep, voffB);
            if constexpr (GATHER) { PG8_STAGE2(PG8_SA(1, 0), a3, s00, s01); } else { PG8_STAGE(PG8_SA(1, 0), a3, voffA); }
            PG8_WAIT_V(8); PG8_WAIT_L(0); PG8_BAR; PG8_MM(1, 0, At, B0); PG8_MM(1, 1, At, B1); PG8_F8PAD; PG8_BAR; PG8_SCHED;
        }
        if constexpr (ALIGN_EPI) { if (wr == 0) PG8_BAR; }
        if constexpr (F8) { asm volatile("s_nop 15\n\ts_nop 15\n\ts_nop 15\n\ts_nop 15\n\ts_nop 15\n\ts_nop 15\n\ts_nop 15\n\ts_nop 15\n\ts_nop 15\n\ts_nop 15\n\ts_nop 15\n\ts_nop 15" ::: "memory"); }
        E(acc, cur, wr, wc, fr, fq);
        if (!has_next) break;
#pragma unroll
        for (int a = 0; a < 2; ++a)
#pragma unroll
            for (int b = 0; b < 2; ++b)
#pragma unroll
                for (int m = 0; m < 4; ++m)
#pragma unroll
                    for (int n = 0; n < 2; ++n) acc[a][b][m][n] = (f32x4){zf, zf, zf, zf};
        cur = nxt; cA = nA; cB = nB; ++ui; oc00 = on00; oc01 = on01; oc10 = on10; oc11 = on11;
        if constexpr (ALIGN_EPI) { if (wr == 1) PG8_BAR; }
    }
    PG8_WAIT_V(0);
    if constexpr (!ALIGN_EPI) { if (wr == 0) PG8_BAR; }
    PG8_BAR;
#undef PG8_SA
#undef PG8_SB
#undef PG8_STAGE
#undef PG8_STAGE2
#undef PG8_LDA
#undef PG8_ROWCOL
#undef PG8_LD2
#undef PG8_HALF
#undef PG8_LDB
#undef PG8_MMA
#undef PG8_MMA8
#undef PG8_MM
#undef PG8_F8PAD
#undef PG8_WAIT_V
#undef PG8_WAIT_L
#undef PG8_BAR
#undef PG8_SCHED
}
}
#define GAS __attribute__((address_space(1)))
#define LAS __attribute__((address_space(3)))
typedef unsigned short bf16;
typedef unsigned v4u __attribute__((ext_vector_type(4)));
typedef float f32x4 __attribute__((ext_vector_type(4)));
typedef short bf16x8 __attribute__((ext_vector_type(8)));
typedef GAS unsigned gu32;
typedef GAS unsigned long long gu64;
#define RLX_AGENT __ATOMIC_RELAXED, __HIP_MEMORY_SCOPE_AGENT
#define LDS_WAIT() asm volatile("s_waitcnt lgkmcnt(0)" ::: "memory")
#define VM_WAIT() asm volatile("s_waitcnt vmcnt(0)" ::: "memory")
__device__ __forceinline__ unsigned long long rt() { return __builtin_amdgcn_s_memrealtime(); }
__device__ __forceinline__ unsigned f2bf(float f) { return (unsigned)__builtin_bit_cast(unsigned short, (__bf16)f); }
__device__ __forceinline__ unsigned pk2(float lo, float hi) { return pg8::cvt_pk_bf16(lo, hi); }

#define XB_TMO      128
#define XB_XCNT(j)  (256  + 64 * (j))
#define XB_XSUB(j)  (1280 + 64 * (j))
#define XB_XGEN(j)  (2304 + 64 * (j))
#define XB_TOP      3328
#define XB_TOPGEN   3392
#define XCD_BAR_WORDS 3456
#define XB_SPIN_CAP (1u << 18)

__device__ __forceinline__ unsigned xb_ld(unsigned* p)              { return __hip_atomic_load(p, __ATOMIC_RELAXED, __HIP_MEMORY_SCOPE_AGENT); }
__device__ __forceinline__ unsigned xb_add(unsigned* p, unsigned v) { return __hip_atomic_fetch_add(p, v, __ATOMIC_RELAXED, __HIP_MEMORY_SCOPE_AGENT); }
__device__ __forceinline__ unsigned xb_xcc_id() { return (unsigned)__builtin_amdgcn_s_getreg((3 << 11) | 20) & 0xFu; }
#define XB_SPIN(cond, bar) do { unsigned _sp = 0; while (cond) { __builtin_amdgcn_s_sleep(1); \
    if ((++_sp & 255u) == 0u) { if (xb_ld(&(bar)[XB_TMO])) break; if (_sp > XB_SPIN_CAP) { atomicAdd(&(bar)[XB_TMO], 1u); break; } } } } while (0)

struct XcdBarrier {
    unsigned* bar; unsigned x;
    volatile LAS unsigned* st;
};

__device__ __forceinline__ XcdBarrier xcd_barrier_post(unsigned* bar, volatile LAS unsigned* st) {
    XcdBarrier b; b.bar = bar; b.x = xb_xcc_id(); b.st = st;
    if (threadIdx.x == 0) (void)xb_add(&bar[XB_XCNT(b.x)], 1u);
    return b;
}
__device__ __forceinline__ void xcd_barrier_complete(unsigned* bar, unsigned x, unsigned& nloc, unsigned& nx) {
    const unsigned G = gridDim.x * gridDim.y * gridDim.z;
    unsigned sum, cnt, mine, sp = 0u;
    for (;;) {
        sum = 0u; cnt = 0u; mine = 0u;
#pragma unroll
        for (unsigned j = 0; j < 16; ++j) { const unsigned c = xb_ld(&bar[XB_XCNT(j)]); sum += c; cnt += (c > 0u) ? 1u : 0u; mine = (j == x) ? c : mine; }
        if (sum == G) break;
        __builtin_amdgcn_s_sleep(1);
        if ((++sp & 255u) == 0u) { if (xb_ld(&bar[XB_TMO])) break; if (sp > XB_SPIN_CAP) { atomicAdd(&bar[XB_TMO], 1u); break; } }
    }
    nloc = mine > 0u ? mine : 1u; nx = cnt > 0u ? cnt : 1u;
}

__device__ __forceinline__ void xcd_barrier(const XcdBarrier& b) {
    asm volatile("s_waitcnt vmcnt(0)" ::: "memory");
    __syncthreads();
    if (threadIdx.x == 0) {
        unsigned* bar = b.bar;
        __builtin_amdgcn_s_waitcnt(0);
        unsigned nloc = b.st[0], nx = b.st[1];
        if (nloc == 0u) { xcd_barrier_complete(bar, b.x, nloc, nx); b.st[0] = nloc; b.st[1] = nx; }
        const unsigned old = xb_add(&bar[XB_XSUB(b.x)], 1u);
        const unsigned gen = old / nloc;
        if (old + 1u == (gen + 1u) * nloc) {
            __builtin_amdgcn_fence(__ATOMIC_RELEASE, "agent");
            asm volatile("s_waitcnt vmcnt(0)" ::: "memory");
            const unsigned og = xb_add(&bar[XB_TOP], 1u);
            const unsigned tg = og / nx;
            if (og + 1u == (tg + 1u) * nx) xb_add(&bar[XB_TOPGEN], 1u);
            else XB_SPIN(xb_ld(&bar[XB_TOPGEN]) == tg, bar);
            __builtin_amdgcn_fence(__ATOMIC_ACQUIRE, "agent");
            xb_add(&bar[XB_XGEN(b.x)], 1u);
            asm volatile("s_waitcnt vmcnt(0)" ::: "memory");
        } else {
            XB_SPIN(xb_ld(&bar[XB_XGEN(b.x)]) == gen, bar);
            __builtin_amdgcn_fence(__ATOMIC_ACQUIRE, "agent");
            asm volatile("s_waitcnt vmcnt(0)" ::: "memory");
        }
    }
    __syncthreads();
}

constexpr int NWAVES = 8;
constexpr int DM = 1024, NBATCH = 8, SEQL = 4096, CTXL = 256;
constexpr int NC = NBATCH * CTXL, NX = NBATCH * SEQL, NTOK = NC + NX;
constexpr int HW = 512, INC = 3072, NE = 64, TOPK = 6;
constexpr int NCH = 68;
constexpr int NSEQ = NBATCH * 4 * 2;
constexpr float EPSN = 1e-6f;
constexpr int NHALF = 1;
constexpr int MAXBLK = 1024;
constexpr int MAXSLOT = 1016 * 256;

constexpr size_t MiB = 1u << 20;
constexpr size_t WS_CTL = 0, CTL_ZERO_BYTES = 1 * MiB;
constexpr size_t WS_MOD = 1 * MiB;
constexpr size_t WS_RT = 2 * MiB;
constexpr size_t RT_IDX = WS_RT, RT_GATE = WS_RT + 1 * MiB, RT_TSLOT = WS_RT + 2 * MiB, RT_STOK = WS_RT + 3 * MiB, RT_BLKE = WS_RT + 4 * MiB + 512 * 1024, RT_MISC = RT_BLKE + 8192;
constexpr size_t WS_CTXRES = 8 * MiB;
constexpr size_t WS_WIN = 16 * MiB, WS_WOUT = 22 * MiB, WS_WPOOL = 24 * MiB, WS_WR = 25 * MiB, WS_W13 = 26 * MiB, WS_W2 = 91 * MiB;
constexpr size_t WS_HX = 124 * MiB;
constexpr size_t WS_PX = 193 * MiB;
constexpr size_t WS_KV = 397 * MiB;
constexpr size_t WS_DEC = 533 * MiB;
constexpr size_t WS_HS = 193 * MiB, WS_YS = 320 * MiB;
constexpr size_t WS_END = 574 * MiB;
static_assert(WS_HS + (size_t)MAXSLOT * 512 <= WS_YS && WS_YS + (size_t)MAXSLOT * 1024 <= WS_END && WS_HX + (size_t)(NTOK + 1) * 2048 <= WS_PX && WS_PX + (size_t)NTOK * INC * 2 <= WS_KV, "ws map");
constexpr int CW_BAR = 4096, CW_CNT = 8192, CW_CUR = 8448;

constexpr int RING_BYTES = 131072, LDSCTL_OFF = RING_BYTES, MISC_OFF = LDSCTL_OFF + 320, LDS_BYTES = 147456;

__device__ __forceinline__ float bf2f(unsigned short u) { return __builtin_bit_cast(float, ((unsigned)u) << 16); }
__device__ __forceinline__ float shx(float v, int o, int lane) { return __builtin_bit_cast(float, __builtin_amdgcn_ds_bpermute((lane ^ o) << 2, __builtin_bit_cast(int, v))); }
__device__ __forceinline__ float shl(float v, int src) { return __builtin_bit_cast(float, __builtin_amdgcn_ds_bpermute(src << 2, __builtin_bit_cast(int, v))); }
__device__ __forceinline__ float wave_sum(float v, int lane) {
#pragma unroll
    for (int o = 1; o < 64; o <<= 1) v += shx(v, o, lane);
    return v;
}
__device__ __forceinline__ float wave_max(float v, int lane) {
#pragma unroll
    for (int o = 1; o < 64; o <<= 1) v = fmaxf(v, shx(v, o, lane));
    return v;
}
template <int CTRL> __device__ __forceinline__ float dpp_f(float v) { return __builtin_bit_cast(float, __builtin_amdgcn_update_dpp(__builtin_bit_cast(int, v), __builtin_bit_cast(int, v), CTRL, 0xf, 0xf, false)); }
__device__ __forceinline__ float max8_dpp(float v) {
    v = fmaxf(v, dpp_f<0xB1>(v)); v = fmaxf(v, dpp_f<0x4E>(v)); v = fmaxf(v, dpp_f<0x141>(v)); return v; }
__device__ __forceinline__ float rdlane(float v, int src) { return __builtin_bit_cast(float, __builtin_amdgcn_readlane(__builtin_bit_cast(int, v), src)); }
__device__ __forceinline__ float max64_dpp(float v) {
    v = max8_dpp(v); v = fmaxf(v, dpp_f<0x140>(v));
    return fmaxf(fmaxf(rdlane(v, 0), rdlane(v, 16)), fmaxf(rdlane(v, 32), rdlane(v, 48))); }
__device__ __forceinline__ float opaque_zero() { float z = 0.f; asm volatile("" : "+v"(z)); return z; }
__device__ __forceinline__ float sigmoidf_(float x) { return __builtin_amdgcn_rcpf(1.0f + __expf(-x)); }
__device__ __forceinline__ float clamp80(float x) { return fminf(fmaxf(x, -80.f), 80.f); }

struct Frame {
    LAS unsigned char* lds;
    unsigned* ctl;
    int tid, lane, wave, vcu, G;
    const float* in[23];
    float* out; unsigned char* ws;
};
extern __shared__ __attribute__((aligned(16))) unsigned char g_lds[];
constexpr int TAB_OFF = MISC_OFF + 128;
__device__ __forceinline__ unsigned long long tab_ld(int i) {
    const unsigned long long v = ((const LAS unsigned long long*)((LAS unsigned char*)g_lds + TAB_OFF))[i];
    const unsigned lo = (unsigned)__builtin_amdgcn_readfirstlane((int)(unsigned)v), hi = (unsigned)__builtin_amdgcn_readfirstlane((int)(unsigned)(v >> 32));
    return ((unsigned long long)hi << 32) | lo;
}
__device__ __forceinline__ Frame make_frame() {
    asm volatile("" ::: "memory");
    Frame F;
    F.lds = (LAS unsigned char*)g_lds;
    F.tid = pg8::opaque_tid(); F.lane = F.tid & 63; F.wave = __builtin_amdgcn_readfirstlane(F.tid >> 6);
    F.G = gridDim.x; { int bx = blockIdx.x; asm volatile("" : "+s"(bx)); F.vcu = (F.G % 8 == 0) ? (bx % 8) * (F.G / 8) + bx / 8 : bx; }
#pragma unroll
    for (int i = 0; i < 23; ++i) F.in[i] = (const float*)tab_ld(i);
    F.out = (float*)tab_ld(23); F.ws = (unsigned char*)tab_ld(24); F.ctl = (unsigned*)(F.ws + WS_CTL);
    return F;
}
__device__ __forceinline__ void grid_barrier() {
    const Frame F = make_frame();
    XcdBarrier b; b.bar = F.ctl + CW_BAR; b.x = xb_xcc_id(); b.st = (volatile LAS unsigned*)((LAS unsigned char*)g_lds + MISC_OFF) + 8;
    xcd_barrier(b);
}

__device__ __forceinline__ void transpose_item(const float* W, int K, int N, bf16* WT, int mode, LAS float* scr, int item, int lane, float wscale = 1.0f, bool f8 = false) {
    (void)scr;
    const int nblk = N / 32, kb = item / nblk, nb = item % nblk, k0 = 64 * kb, n0 = 32 * nb, c = lane >> 3, n4 = lane & 7;
    const GAS f32x4* src = (const GAS f32x4*)(W + (size_t)(k0 + 8 * c) * N + n0 + 4 * n4);
    f32x4 v[8];
#pragma unroll
    for (int j = 0; j < 8; ++j) v[j] = src[(size_t)j * (N / 4)] * wscale;
#pragma unroll
    for (int i = 0; i < 4; ++i) {
        const v4u o = (v4u){pk2(v[0][i], v[1][i]), pk2(v[2][i], v[3][i]), pk2(v[4][i], v[5][i]), pk2(v[6][i], v[7][i])};
        const int nn = n0 + 4 * n4 + i; int dr = nn;
        if (mode) dr = 256 * (nn >> 7) + 128 * ((nn >> 2) & 1) + 32 * ((nn >> 5) & 3) + 16 * (mode - 1) + 4 * ((nn >> 3) & 3) + (nn & 3);
        if (!f8) *(GAS v4u*)(WT + (size_t)dr * K + k0 + 8 * c) = o;
        else { int lo8 = 0, hi8 = 0;
            lo8 = __builtin_amdgcn_cvt_pk_fp8_f32(v[0][i], v[1][i], lo8, false); lo8 = __builtin_amdgcn_cvt_pk_fp8_f32(v[2][i], v[3][i], lo8, true);
            hi8 = __builtin_amdgcn_cvt_pk_fp8_f32(v[4][i], v[5][i], hi8, false); hi8 = __builtin_amdgcn_cvt_pk_fp8_f32(v[6][i], v[7][i], hi8, true);
            *(GAS unsigned long long*)((GAS unsigned char*)WT + (size_t)dr * K + k0 + 8 * c) = (unsigned long long)(unsigned)lo8 | ((unsigned long long)(unsigned)hi8 << 32); } }
}

__device__ __forceinline__ void phase_wconv(Frame& F, int l) {
    LAS float* scr = (LAS float*)(F.lds + F.wave * 16384);
    const int gw = F.vcu * NWAVES + F.wave, NGW = F.G * NWAVES;
    constexpr int I_IN = 16 * 96, I_OUT = 16 * 32, I_POOL = 4 * 8, I_R = 16 * 2, I_1 = 65 * 128, I_2 = 65 * 128;
    constexpr int NITEMS = I_IN + I_OUT + I_POOL + I_R + 2 * I_1 + I_2;
    unsigned char* ws = F.ws;
    for (int it = gw; it < NITEMS; it += NGW) {
        int r = it;
        if (r < I_IN) { transpose_item(F.in[8] + (size_t)l * DM * INC, DM, INC, (bf16*)(ws + WS_WIN), 0, scr, r, F.lane); continue; } r -= I_IN;
        if (r < I_OUT) { transpose_item(F.in[13] + (size_t)l * DM * DM, DM, DM, (bf16*)(ws + WS_WOUT), 0, scr, r, F.lane); continue; } r -= I_OUT;
        if (r < I_POOL) { const int g = r / 8; transpose_item(F.in[11] + (size_t)(l * 4 + g) * 128 * 128, 128, 128, (bf16*)(ws + WS_WPOOL) + g * 128 * 128, 0, scr, r % 8, F.lane); continue; } r -= I_POOL;
        if (r < I_R) { transpose_item(F.in[14] + (size_t)l * DM * NE, DM, NE, (bf16*)(ws + WS_WR), 0, scr, r, F.lane); continue; } r -= I_R;
        if (r < 2 * I_1) { const int mat = r / I_1; r -= mat * I_1; const int e = r / 128, ii = r % 128;
            const float* src = (e < 64) ? F.in[mat ? 17 : 16] + ((size_t)l * 64 + e) * DM * 256 : F.in[mat ? 20 : 19] + (size_t)l * DM * 256;
            transpose_item(src, DM, 256, (bf16*)((unsigned char*)(ws + WS_W13) + (size_t)e * 512 * DM), 1 + mat, scr, ii, F.lane, 32.0f, true); continue; } r -= 2 * I_1;
        { const int e = r / 128, ii = r % 128;
            const float* src = (e < 64) ? F.in[18] + ((size_t)l * 64 + e) * 256 * DM : F.in[21] + (size_t)l * 256 * DM;
            transpose_item(src, 256, DM, (bf16*)((unsigned char*)(ws + WS_W2) + (size_t)e * DM * 256), 0, scr, ii, F.lane, 16.0f, true); }
    }
}

__device__ __forceinline__ void phase_mod(Frame& F) {
    LAS float* sil = (LAS float*)(F.lds + 65536);
    LAS float* part = (LAS float*)(F.lds + 65536 + 36864);
    for (int i = F.tid; i < 9 * 1024; i += 512) { const int r = i >> 10, k = i & 1023; const float v = (r < 8) ? F.in[1][r * 1024 + k] : F.in[3][k]; sil[i] = v * sigmoidf_(v); }
    __syncthreads();
    float* mod = (float*)(F.ws + WS_MOD);
    for (int it = F.vcu; it < 2 * 96; it += F.G) {
        const int l = it / 96, n0 = (it % 96) * 64;
        const float* wa = F.in[6] + (size_t)l * DM * 6144 + n0 + F.lane;
        float acc[9];
#pragma unroll
        for (int r = 0; r < 9; ++r) acc[r] = 0.f;
        const int kb = F.wave * 128;
#pragma unroll 4
        for (int k = 0; k < 128; ++k) { const float w = wa[(size_t)(kb + k) * 6144];
#pragma unroll
            for (int r = 0; r < 9; ++r) acc[r] += sil[r * 1024 + kb + k] * w; }
#pragma unroll
        for (int r = 0; r < 9; ++r) part[(F.wave * 9 + r) * 64 + F.lane] = acc[r];
        __syncthreads();
        for (int i = F.tid; i < 9 * 64; i += 512) { const int r = i >> 6, c = i & 63; float s = 0.f;
#pragma unroll
            for (int w = 0; w < 8; ++w) s += part[(w * 9 + r) * 64 + c];
            mod[((size_t)l * 9 + r) * 6144 + n0 + c] = s + F.in[7][(size_t)l * 6144 + n0 + c]; }
        __syncthreads();
    }
}

__device__ __forceinline__ const float* resid_in_row(Frame& F, int l, int row) {
    if (l == 0) return row < NC ? F.in[2] + (size_t)row * DM : F.in[0] + (size_t)(row - NC) * DM;
    return row < NC ? (const float*)(F.ws + WS_CTXRES) + (size_t)row * DM : F.out + (size_t)(row - NC) * DM;
}
__device__ __forceinline__ float* resid_row(Frame& F, int row) { return row < NC ? (float*)(F.ws + WS_CTXRES) + (size_t)row * DM : F.out + (size_t)(row - NC) * DM; }
__device__ __forceinline__ int mod_row(int row) { return row < NC ? 8 : ((row - NC) >> 12); }

#ifndef DIAG_ZERO_CTXSTATE
#define DIAG_ZERO_CTXSTATE 0
#endif
#ifndef DEG_HX
#define DEG_HX 0
#endif
#ifndef DEG_Y
#define DEG_Y 0
#endif
__device__ __forceinline__ void norm_mod_row(Frame& F, const float* xrow, const float* nw, const float* sh, const float* sc, bf16* orow, LAS bf16* lrow, LAS float* frow = nullptr) {
    const GAS f32x4* xr = (const GAS f32x4*)xrow + F.lane;
    f32x4 v[4]; float s = 0.f;
#pragma unroll
    for (int j = 0; j < 4; ++j) { v[j] = xr[64 * j]; s += (v[j].x * v[j].x + v[j].y * v[j].y) + (v[j].z * v[j].z + v[j].w * v[j].w); }
    const float r = 1.0f / sqrtf(wave_sum(s, F.lane) * (1.f / DM) + EPSN);
#pragma unroll
    for (int j = 0; j < 4; ++j) {
        const f32x4 w4 = ((const GAS f32x4*)nw)[F.lane + 64 * j], s4 = ((const GAS f32x4*)sc)[F.lane + 64 * j], h4 = ((const GAS f32x4*)sh)[F.lane + 64 * j];
        const f32x4 o = (v[j] * r) * w4 * (s4 + 1.0f) + h4;
        unsigned long long pk = (unsigned long long)pk2(o.x, o.y) | ((unsigned long long)pk2(o.z, o.w) << 32);
        if (DEG_HX) pk &= 0xfffcfffcfffcfffcull;
        ((GAS unsigned long long*)orow)[F.lane + 64 * j] = pk;
        if (lrow) *(LAS unsigned long long*)(lrow + 4 * (F.lane + 64 * j)) = pk;
        if (frow) *(LAS f32x4*)(frow + 4 * (F.lane + 64 * j)) = o;
    }
}

__device__ __forceinline__ void phase_hx(Frame& F, int l) {
    const int gw = F.vcu * NWAVES + F.wave, NGW = F.G * NWAVES;
    const float* mod = (const float*)(F.ws + WS_MOD) + (size_t)l * 9 * 6144;
    bf16* HX = (bf16*)(F.ws + WS_HX);
    for (int row = gw; row < NTOK; row += NGW) { const float* md = mod + mod_row(row) * 6144;
        norm_mod_row(F, resid_in_row(F, l, row), F.in[4] + l * DM, md, md + 1024, HX + (size_t)row * DM, nullptr); }
}

__device__ __forceinline__ void gates16(const bf16* zp, float lb, float (&g)[16], float (&kk)[16]) {
    const float lbf = fmaxf(lb, 1e-30f), oml = 1.0f - lb;
#pragma unroll
    for (int j = 0; j < 16; ++j) { const float z = bf2f(zp[(size_t)j * INC]); const float sg = sigmoidf_(z); g[j] = __logf(lbf + oml * sg); kk[j] = oml * (1.0f - sg); }
}
__device__ __forceinline__ float lb_of(Frame& F, int l, int dir, int hch) {
    if (l == 0) return 0.f;
    const float a0 = F.in[9][dir * HW + hch], a1 = F.in[9][2 * HW + dir * HW + hch];
    return 1.0f / (1.0f + __expf(a0 - a1));
}
__device__ __forceinline__ int chunk_row0(int b, int dir, int c) {
    if (c < 4) { const int tc = dir ? 3 - c : c; return b * CTXL + tc * 64; }
    const int tc = dir ? 63 - (c - 4) : (c - 4); return NC + b * SEQL + tc * 64;
}

template <int KS, int NTILE>
__device__ __forceinline__ void mma_rows16(f32x4 (&acc)[NTILE], const LAS bf16* A, int lda, int arow0, const LAS bf16* Bt, int ldb, int brow0, int lane) {
    const int r = lane & 15, q = lane >> 4;
    bf16x8 af[KS], bfr[KS][NTILE];
#pragma unroll
    for (int s = 0; s < KS; ++s) { af[s] = *(const LAS bf16x8*)(A + (arow0 + r) * lda + 32 * s + 8 * q);
#pragma unroll
        for (int i = 0; i < NTILE; ++i) bfr[s][i] = *(const LAS bf16x8*)(Bt + (brow0 + 16 * i + r) * ldb + 32 * s + 8 * q); }
#pragma unroll
    for (int s = 0; s < KS; ++s)
#pragma unroll
        for (int i = 0; i < NTILE; ++i) acc[i] = __builtin_amdgcn_mfma_f32_16x16x32_bf16(bfr[s][i], af[s], acc[i], 0, 0, 0);
}

__device__ __forceinline__ void pool_load(Frame& F, int b, int tc, int gi, v4u (&r)[3]) {
    const GAS bf16* PX = (const GAS bf16*)(F.ws + WS_PX);
    const int row0 = (tc < 4) ? b * CTXL + tc * 64 : NC + b * SEQL + (tc - 4) * 64;
    const int lo_b = (tc < 4) ? -tc * 64 : 0, hi_b = (tc < 4) ? (4 - tc) * 64 : 64;
#pragma unroll
    for (int j = 0; j < 3; ++j) { const int e = F.tid + 512 * j; const int rr = (e >> 4) - 8; r[j] = (v4u){0u, 0u, 0u, 0u};
        if (e < 1280 && rr >= lo_b && rr < hi_b) r[j] = *(const GAS v4u*)(PX + (size_t)(row0 + rr) * INC + 5 * HW + gi * 128 + (e & 15) * 8); }
}
__device__ __forceinline__ void pool_item(Frame& F, int l, int b, int tc, int gi, v4u (&pr)[3], bool has_next, int nb, int ntc, int ngi) {
    LAS bf16* Pin = (LAS bf16*)(F.lds + 65536); LAS bf16* Pl = (LAS bf16*)(F.lds); LAS bf16* Wt = (LAS bf16*)(F.lds + 17408);
    bf16* Y = (bf16*)(F.ws + WS_HX);
    const int seg = F.tid >> 7, ch = F.tid & 127, mt = F.wave >> 1, nh = F.wave & 1, lr = F.lane & 15, lq = F.lane >> 4;
    const int row0 = (tc < 4) ? b * CTXL + tc * 64 : NC + b * SEQL + (tc - 4) * 64;
    const int wdw = 2 << gi, hw2 = wdw >> 1;
    const int lo_b = (tc < 4) ? -tc * 64 : 0, hi_b = (tc < 4) ? (4 - tc) * 64 : 64;
#pragma unroll
    for (int j = 0; j < 3; ++j) { const int e = F.tid + 512 * j; if (e < 1280) *(LAS v4u*)(Pin + (e >> 4) * 128 + (e & 15) * 8) = pr[j]; }
    { const GAS v4u* wp = (const GAS v4u*)((const bf16*)(F.ws + WS_WPOOL) + gi * 128 * 128);
#pragma unroll
      for (int i = 0; i < 4; ++i) { const int e = F.tid + 512 * i; const int d = e >> 4, kq = e & 15; *(LAS v4u*)(Wt + d * 136 + kq * 8) = wp[e]; } }
    if (has_next) pool_load(F, nb, ntc, ngi, pr);
    __syncthreads();
#pragma unroll 4
    for (int t = 0; t < 16; ++t) { const int i = seg * 16 + t; int lo = i - hw2, hi = i + hw2; lo = lo < lo_b ? lo_b : lo; hi = hi > hi_b ? hi_b : hi;
        float sm = 0.f; for (int r = lo; r < hi; ++r) sm += bf2f(Pin[(r + 8) * 128 + ch]);
        Pl[i * 136 + ch] = (bf16)f2bf(sm / (float)(hi - lo) - bf2f(Pin[(i + 8) * 128 + ch])); }
    __syncthreads();
    f32x4 acc[4]; const float zf = opaque_zero();
#pragma unroll
    for (int i = 0; i < 4; ++i) acc[i] = (f32x4){zf, zf, zf, zf};
    mma_rows16<4, 4>(acc, Pl, 136, 16 * mt, Wt, 136, 64 * nh, F.lane);
    const int t = 16 * mt + lr;
    const float* ps = F.in[12] + l * HW + gi * 128 + 64 * nh + 4 * lq;
    bf16* yp = Y + (size_t)(row0 + t) * DM + HW + gi * 128 + 64 * nh + 4 * lq;
#pragma unroll
    for (int i = 0; i < 4; ++i) { const f32x4 w4 = *(const GAS f32x4*)(ps + 16 * i);
        *(GAS unsigned long long*)(yp + 16 * i) = (unsigned long long)pk2(acc[i].x * w4.x, acc[i].y * w4.y) | ((unsigned long long)pk2(acc[i].z * w4.z, acc[i].w * w4.w) << 32); }
    __syncthreads();
}

#ifndef USE_OLD_SCAN
#define USE_OLD_SCAN 0
#endif
#ifndef PREP_INPLACE
#define PREP_INPLACE 1
#endif
constexpr size_t WS_O = WS_KV, WS_KE = WS_KV + 68 * MiB, WS_VT = 536 * MiB;
__device__ __forceinline__ void prep_load(const GAS bf16* rowp, int h, int tid, v4u (&r)[8]) {
#pragma unroll
    for (int j = 0; j < 2; ++j) { const int e = tid + 512 * j; const GAS bf16* p = rowp + (size_t)(e >> 4) * INC + h * 128 + (e & 15) * 8;
        r[j] = *(const GAS v4u*)(p); r[2 + j] = *(const GAS v4u*)(p + HW); r[4 + j] = *(const GAS v4u*)(p + 3 * HW); r[6 + j] = *(const GAS v4u*)(p + 2 * HW); }
}
typedef float f32x2 __attribute__((ext_vector_type(2)));
__device__ __forceinline__ f32x2 bf2x(unsigned u) { return (f32x2){__builtin_bit_cast(float, u << 16), __builtin_bit_cast(float, u & 0xffff0000u)}; }
__device__ __forceinline__ void phase_prep(Frame& F, int l) {
    LAS unsigned* Raw = (LAS unsigned*)(F.lds);
    LAS bf16* Qt = (LAS bf16*)(F.lds); LAS bf16* Kt = (LAS bf16*)(F.lds + 17408); LAS bf16* Pm = (LAS bf16*)(F.lds + 34816);
    LAS bf16* vT = (LAS bf16*)(F.lds + 65536); LAS float* tot = (LAS float*)(F.lds + 83968);
    GAS bf16* PX = (GAS bf16*)(F.ws + WS_PX); GAS bf16* KE = (GAS bf16*)(F.ws + WS_KE); GAS bf16* VT = (GAS bf16*)(F.ws + WS_VT); GAS float* DEC = (GAS float*)(F.ws + WS_DEC); GAS bf16* O = (GAS bf16*)(F.ws + WS_O);
    const int s8 = F.tid >> 6, cp = F.tid & 63, mt = F.wave >> 1, nh = F.wave & 1, lr = F.lane & 15, lq = F.lane >> 4;
    const int nit = NBATCH * 4 * NCH;
    v4u rr[8];
    auto item_row0 = [](int it) { const int tc = it >> 5, b = (it >> 2) & 7; return (tc < 4) ? b * CTXL + tc * 64 : NC + b * SEQL + (tc - 4) * 64; };
    if (F.vcu < nit) prep_load(PX + (size_t)item_row0(F.vcu) * INC, F.vcu & 3, F.tid, rr);
#pragma unroll 1
    for (int it = F.vcu; it < nit; it += F.G) {
        const int h = it & 3, b = (it >> 2) & 7, tc = it >> 5, row0 = item_row0(it);
        const bool outp = (l == 0) || (tc >= 4);
#pragma unroll
        for (int j = 0; j < 2; ++j) { const int e = F.tid + 512 * j; const int o4 = (e >> 4) * 64 + (e & 15) * 4;
#pragma unroll
            for (int x = 0; x < 4; ++x) *(LAS v4u*)(Raw + x * 4096 + o4) = rr[2 * x + j]; }
        if (it + F.G < nit) prep_load(PX + (size_t)item_row0(it + F.G) * INC, (it + F.G) & 3, F.tid, rr);
        __syncthreads();
        unsigned zf[8], zb[8], qv[8], vv[8];
#pragma unroll
        for (int t = 0; t < 8; ++t) { const int o = (s8 * 8 + t) * 64 + cp; zf[t] = Raw[o]; zb[t] = Raw[4096 + o]; qv[t] = Raw[8192 + o]; vv[t] = Raw[12288 + o]; }
        __syncthreads();
        { v4u lo, hi;
          lo.x = (vv[0] & 0xffffu) | (vv[1] << 16); lo.y = (vv[2] & 0xffffu) | (vv[3] << 16); lo.z = (vv[4] & 0xffffu) | (vv[5] << 16); lo.w = (vv[6] & 0xffffu) | (vv[7] << 16);
          hi.x = (vv[0] >> 16) | (vv[1] & 0xffff0000u); hi.y = (vv[2] >> 16) | (vv[3] & 0xffff0000u); hi.z = (vv[4] >> 16) | (vv[5] & 0xffff0000u); hi.w = (vv[6] >> 16) | (vv[7] & 0xffff0000u);
          *(LAS v4u*)(vT + (2 * cp) * 72 + s8 * 8) = lo; *(LAS v4u*)(vT + (2 * cp + 1) * 72 + s8 * 8) = hi;
          GAS bf16* vt = VT + (size_t)((b * 4 + h) * NCH + tc) * 8192;
          *(GAS v4u*)(vt + (2 * cp) * 64 + s8 * 8) = lo; *(GAS v4u*)(vt + (2 * cp + 1) * 64 + s8 * 8) = hi; }
        float qs0[8], qs1[8];
#pragma unroll
        for (int t = 0; t < 8; ++t) { const f32x2 q = bf2x(qv[t]); qs0[t] = q.x * sigmoidf_(q.x) * 0.08838834764831845f; qs1[t] = q.y * sigmoidf_(q.y) * 0.08838834764831845f; }
#pragma unroll 1
        for (int dir = 0; dir < 2; ++dir) {
            const int seq = (b * 4 + h) * 2 + dir, c = (tc < 4) ? (dir ? 3 - tc : tc) : (dir ? 71 - tc : tc);
            const float lb0 = lb_of(F, l, dir, h * 128 + 2 * cp), lb1 = lb_of(F, l, dir, h * 128 + 2 * cp + 1);
            const float lbf0 = fmaxf(lb0, 1e-30f), oml0 = 1.0f - lb0, lbf1 = fmaxf(lb1, 1e-30f), oml1 = 1.0f - lb1;
            float g0[8], g1[8], k0[8], k1[8];
#pragma unroll
            for (int t = 0; t < 8; ++t) { const f32x2 z = bf2x(dir ? zb[t] : zf[t]); const float a0 = sigmoidf_(z.x), a1 = sigmoidf_(z.y);
                g0[t] = __logf(lbf0 + oml0 * a0); k0[t] = oml0 * (1.0f - a0); g1[t] = __logf(lbf1 + oml1 * a1); k1[t] = oml1 * (1.0f - a1); }
            if (dir == 0) {
#pragma unroll
                for (int t = 1; t < 8; ++t) { g0[t] += g0[t - 1]; g1[t] += g1[t - 1]; }
                *(LAS f32x2*)(tot + s8 * 128 + 2 * cp) = (f32x2){g0[7], g1[7]};
            } else {
#pragma unroll
                for (int t = 6; t >= 0; --t) { g0[t] += g0[t + 1]; g1[t] += g1[t + 1]; }
                *(LAS f32x2*)(tot + s8 * 128 + 2 * cp) = (f32x2){g0[0], g1[0]};
            }
            __syncthreads();
            float off0 = 0.f, off1 = 0.f, m0 = 0.f, m1 = 0.f, bt0 = 0.f, bt1 = 0.f;
#pragma unroll
            for (int sg = 0; sg < 8; ++sg) { const f32x2 tv = *(const LAS f32x2*)(tot + sg * 128 + 2 * cp);
                const bool before = dir ? (sg > s8) : (sg < s8), firsthalf = dir ? (sg >= 4) : (sg < 4);
                if (before) { off0 += tv.x; off1 += tv.y; } if (firsthalf) { m0 += tv.x; m1 += tv.y; } bt0 += tv.x; bt1 += tv.y; }
            { unsigned ka[4], kb[4];
#pragma unroll
              for (int t = 0; t < 8; t += 2) { ka[t >> 1] = pg8::cvt_pk_bf16(k0[t] * __expf(bt0 - (g0[t] + off0)), k0[t + 1] * __expf(bt0 - (g0[t + 1] + off0)));
                  kb[t >> 1] = pg8::cvt_pk_bf16(k1[t] * __expf(bt1 - (g1[t] + off1)), k1[t + 1] * __expf(bt1 - (g1[t + 1] + off1))); }
              GAS bf16* ke = KE + (size_t)(seq * NCH + c) * 8192;
              *(GAS v4u*)(ke + (2 * cp) * 64 + s8 * 8) = (v4u){ka[0], ka[1], ka[2], ka[3]}; *(GAS v4u*)(ke + (2 * cp + 1) * 64 + s8 * 8) = (v4u){kb[0], kb[1], kb[2], kb[3]}; }
            if (s8 == 0) *(GAS f32x2*)(DEC + (size_t)(seq * NCH + c) * 128 + 2 * cp) = (f32x2){__expf(bt0), __expf(bt1)};
            if (outp) {
#pragma unroll
                for (int t = 0; t < 8; ++t) { const int tok = s8 * 8 + t; const float b0 = g0[t] + off0, b1 = g1[t] + off1;
                    if (PREP_INPLACE) *(GAS unsigned*)(PX + (size_t)(row0 + tok) * INC + dir * HW + h * 128 + 2 * cp) = pg8::cvt_pk_bf16(qs0[t] * __expf(fmaxf(b0, -80.f)), qs1[t] * __expf(fmaxf(b1, -80.f)));
                    *(LAS unsigned*)(Qt + tok * 136 + 2 * cp) = pg8::cvt_pk_bf16(qs0[t] * __expf(clamp80(b0 - m0)), qs1[t] * __expf(clamp80(b1 - m1)));
                    *(LAS unsigned*)(Kt + tok * 136 + 2 * cp) = pg8::cvt_pk_bf16(k0[t] * __expf(clamp80(m0 - b0)), k1[t] * __expf(clamp80(m1 - b1))); }
            }
            __syncthreads();
            if (outp) {
                const float zf0 = opaque_zero();
                f32x4 pa[2] = {(f32x4){zf0, zf0, zf0, zf0}, (f32x4){zf0, zf0, zf0, zf0}};
                mma_rows16<4, 2>(pa, Qt, 136, 16 * mt, Kt, 136, 32 * nh, F.lane);
                const int t = 16 * mt + lr;
#pragma unroll
                for (int i = 0; i < 2; ++i) { const int s0 = 32 * nh + 16 * i + 4 * lq; float p[4];
#pragma unroll
                    for (int x = 0; x < 4; ++x) { const int s = s0 + x; const bool keep = dir ? (s >= t) : (s <= t); p[x] = keep ? pa[i][x] : 0.f; }
                    *(LAS unsigned long long*)(Pm + t * 72 + s0) = (unsigned long long)pg8::cvt_pk_bf16(p[0], p[1]) | ((unsigned long long)pg8::cvt_pk_bf16(p[2], p[3]) << 32); }
            }
            __syncthreads();
            if (outp) {
                const float zf0 = opaque_zero();
                f32x4 oa[4];
#pragma unroll
                for (int i = 0; i < 4; ++i) oa[i] = (f32x4){zf0, zf0, zf0, zf0};
                mma_rows16<2, 4>(oa, Pm, 72, 16 * mt, vT, 72, 64 * nh, F.lane);
                GAS bf16* op = O + ((size_t)dir * NTOK + row0 + 16 * mt + lr) * HW + h * 128 + 64 * nh + 4 * lq;
#pragma unroll
                for (int i = 0; i < 4; ++i) *(GAS unsigned long long*)(op + 16 * i) = (unsigned long long)pg8::cvt_pk_bf16(oa[i].x, oa[i].y) | ((unsigned long long)pg8::cvt_pk_bf16(oa[i].z, oa[i].w) << 32);
            }
            __syncthreads();
        }
    }
}

__device__ __forceinline__ void scan2_load(const GAS bf16* qrow, const GAS bf16* ke, const GAS bf16* vt, int tid, v4u (&r)[6]) {
#pragma unroll
    for (int j = 0; j < 2; ++j) { const int e = tid + 512 * j; r[j] = *(const GAS v4u*)(qrow + (size_t)(e >> 4) * INC + (e & 15) * 8); r[2 + j] = ((const GAS v4u*)ke)[e]; r[4 + j] = ((const GAS v4u*)vt)[e]; }
}
__device__ __forceinline__ void scan_unit(Frame& F, int l, int u, bool dry = false) {
    constexpr int SETB = 54784;
    const GAS bf16* PX = (const GAS bf16*)(F.ws + WS_PX); const GAS bf16* KE = (const GAS bf16*)(F.ws + WS_KE); const GAS bf16* VT = (const GAS bf16*)(F.ws + WS_VT); const GAS float* DEC = (const GAS float*)(F.ws + WS_DEC);
    const int w = F.wave, lr = F.lane & 15, lq = F.lane >> 4;
    const int dir = u & 1, h = (u >> 1) & 3, b = u >> 3;
    GAS bf16* O = (GAS bf16*)(F.ws + WS_O) + (size_t)dir * NTOK * HW;
    const float zf = opaque_zero();
    f32x4 st[8];
#pragma unroll
    for (int i = 0; i < 8; ++i) st[i] = (f32x4){zf, zf, zf, zf};
    v4u ra[6], rb[6]; float da = 0.f, db = 0.f; unsigned long long oa[4] = {0ull, 0ull, 0ull, 0ull}, ob[4] = {0ull, 0ull, 0ull, 0ull};
#define SCAN_TC(c) (((c) < 4) ? (dir ? 3 - (c) : (c)) : (dir ? 71 - (c) : (c)))
#define SCAN_LOAD(R, D, OO, c) do { scan2_load(PX + (size_t)chunk_row0(b, dir, (c)) * INC + dir * HW + h * 128, KE + (size_t)(u * NCH + (c)) * 8192, VT + (size_t)((b * 4 + h) * NCH + SCAN_TC(c)) * 8192, F.tid, R); \
        if (F.tid < 128) D = DEC[(size_t)(u * NCH + (c)) * 128 + F.tid]; \
        if (l == 0 || (c) >= 4) { _Pragma("unroll") for (int m2 = 0; m2 < 4; ++m2) OO[m2] = *(const GAS unsigned long long*)(O + (size_t)(chunk_row0(b, dir, (c)) + 16 * m2 + lr) * HW + h * 128 + 16 * w + 4 * lq); } } while (0)
#define SCAN_STAGE(R, D, set) do { LAS bf16* q_ = (LAS bf16*)(F.lds + (set) * SETB); LAS bf16* k_ = (LAS bf16*)(F.lds + (set) * SETB + 17408); LAS bf16* v_ = (LAS bf16*)(F.lds + (set) * SETB + 35840); \
        _Pragma("unroll") for (int j = 0; j < 2; ++j) { const int e = F.tid + 512 * j; \
            *(LAS v4u*)(q_ + (e >> 4) * 136 + (e & 15) * 8) = R[j]; *(LAS v4u*)(k_ + (e >> 3) * 72 + (e & 7) * 8) = R[2 + j]; *(LAS v4u*)(v_ + (e >> 3) * 72 + (e & 7) * 8) = R[4 + j]; } \
        if (F.tid < 128) ((LAS float*)(F.lds + (set) * SETB + 54272))[F.tid] = D; } while (0)
#define SCAN_STEP(c, RN, DN, ON) do { \
        const int row0 = chunk_row0(b, dir, (c)), set = (c) & 1; const bool outp = (l == 0) || ((c) >= 4); \
        const LAS bf16* Qb = (const LAS bf16*)(F.lds + set * SETB); const LAS bf16* keT = (const LAS bf16*)(F.lds + set * SETB + 17408); const LAS bf16* vT = (const LAS bf16*)(F.lds + set * SETB + 35840); \
        const LAS float* decv = (const LAS float*)(F.lds + set * SETB + 54272); \
        unsigned long long oc_[4], onx_[4]; _Pragma("unroll") for (int m2 = 0; m2 < 4; ++m2) { oc_[m2] = ocur[m2]; onx_[m2] = ON[m2]; } \
        if ((c) + 1 < NCH) SCAN_STAGE(RN, DN, set ^ 1); \
        if ((c) + 3 < NCH) SCAN_LOAD(RN, DN, ON, (c) + 3); \
        if (outp) { \
            bf16x8 sf[4]; \
            _Pragma("unroll") for (int s = 0; s < 4; ++s) { const v4u x = (v4u){pk2(st[2 * s].x, st[2 * s].y), pk2(st[2 * s].z, st[2 * s].w), pk2(st[2 * s + 1].x, st[2 * s + 1].y), pk2(st[2 * s + 1].z, st[2 * s + 1].w)}; sf[s] = __builtin_bit_cast(bf16x8, x); } \
            _Pragma("unroll") for (int mp = 0; mp < 2; ++mp) {          \
                bf16x8 qa_[2][4]; f32x4 o_[2]; \
                _Pragma("unroll") for (int mm = 0; mm < 2; ++mm) { const int m2 = 2 * mp + mm; const LAS bf16* qrow = Qb + (16 * m2 + lr) * 136 + 4 * lq; \
                    _Pragma("unroll") for (int s = 0; s < 4; ++s) { const unsigned long long a0 = *(const LAS unsigned long long*)(qrow + 32 * s), a1 = *(const LAS unsigned long long*)(qrow + 32 * s + 16); \
                        const v4u ax = (v4u){(unsigned)a0, (unsigned)(a0 >> 32), (unsigned)a1, (unsigned)(a1 >> 32)}; qa_[mm][s] = __builtin_bit_cast(bf16x8, ax); } \
                    const unsigned long long ov = oc_[m2]; \
                    o_[mm] = (f32x4){bf2f((unsigned short)(ov & 0xffff)), bf2f((unsigned short)((ov >> 16) & 0xffff)), bf2f((unsigned short)((ov >> 32) & 0xffff)), bf2f((unsigned short)(ov >> 48))}; } \
                _Pragma("unroll") for (int s = 0; s < 4; ++s) \
                    _Pragma("unroll") for (int mm = 0; mm < 2; ++mm) o_[mm] = __builtin_amdgcn_mfma_f32_16x16x32_bf16(sf[s], qa_[mm][s], o_[mm], 0, 0, 0); \
                _Pragma("unroll") for (int mm = 0; mm < 2; ++mm) { const int m2 = 2 * mp + mm; \
                    GAS unsigned long long* op = (GAS unsigned long long*)(O + (size_t)(row0 + 16 * m2 + lr) * HW + h * 128 + 16 * w + 4 * lq); \
                    if (!dry) *op = (unsigned long long)pk2(o_[mm].x, o_[mm].y) | ((unsigned long long)pk2(o_[mm].z, o_[mm].w) << 32); else asm volatile("" :: "v"(o_[mm].x), "v"(o_[mm].y), "v"(o_[mm].z), "v"(o_[mm].w)); } \
            } \
        } \
        { _Pragma("unroll") for (int i = 0; i < 8; ++i) { const f32x4 d4 = *(const LAS f32x4*)(decv + 16 * i + 4 * lq); st[i] = st[i] * d4; } \
          _Pragma("unroll") for (int s2 = 0; s2 < 2; ++s2) { bf16x8 kb_[8];         \
              const bf16x8 va_ = *(const LAS bf16x8*)(vT + (16 * w + lr) * 72 + 32 * s2 + 8 * lq); \
              _Pragma("unroll") for (int i = 0; i < 8; ++i) kb_[i] = *(const LAS bf16x8*)(keT + (16 * i + lr) * 72 + 32 * s2 + 8 * lq); \
              _Pragma("unroll") for (int i = 0; i < 8; ++i) st[i] = __builtin_amdgcn_mfma_f32_16x16x32_bf16(kb_[i], va_, st[i], 0, 0, 0); } } \
        _Pragma("unroll") for (int m2 = 0; m2 < 4; ++m2) ocur[m2] = onx_[m2]; \
        __syncthreads(); } while (0)
    unsigned long long ocur[4];
    SCAN_LOAD(rb, db, ob, 0); SCAN_STAGE(rb, db, 0);
#pragma unroll
    for (int m2 = 0; m2 < 4; ++m2) ocur[m2] = ob[m2];
    SCAN_LOAD(ra, da, oa, 1); SCAN_LOAD(rb, db, ob, 2);
    __syncthreads();
    SCAN_STEP(0, ra, da, oa);
#pragma unroll 1
    for (int c = 1; c + 1 < NCH; c += 2) { SCAN_STEP(c, rb, db, ob); SCAN_STEP(c + 1, ra, da, oa); }
    SCAN_STEP(NCH - 1, rb, db, ob);
#undef SCAN_TC
#undef SCAN_LOAD
#undef SCAN_STAGE
#undef SCAN_STEP
}

#ifndef DIAG_CHECK_PREP
#define DIAG_CHECK_PREP 0
#endif
__device__ __forceinline__ void diag_check_prep(Frame& F, int l) {
    const GAS bf16* KE = (const GAS bf16*)(F.ws + WS_KE); const GAS bf16* VT = (const GAS bf16*)(F.ws + WS_VT); const GAS float* DEC = (const GAS float*)(F.ws + WS_DEC);
    bool bad = false;
    const size_t gt = (size_t)F.vcu * 512 + F.tid, gs = (size_t)F.G * 512;
    for (size_t i = gt; i < (size_t)NSEQ * NCH * 128; i += gs) { const float d = DEC[i]; if (!(d >= 0.f && d <= 1.0001f)) bad = true; }
    for (size_t i = gt; i < (size_t)NSEQ * NCH * 8192; i += gs) { const float k = bf2f(KE[i]); if (!(k >= 0.f && k <= 1.01f)) bad = true; }
    for (size_t i = gt; i < (size_t)NBATCH * 4 * NCH * 8192; i += gs) { const float v = bf2f(VT[i]); if (!(fabsf(v) < 100.f)) bad = true; }
    if (bad) ((float*)(F.ws + WS_MOD))[(size_t)9 * 6144 + 5120] = __builtin_nanf("");
}
#ifndef REP_SCAN
#define REP_SCAN 0
#endif
#ifndef REP_POOL
#define REP_POOL 0
#endif
__device__ __forceinline__ void phase_scan_pool(Frame& F, int l) {
    const bool split = F.G > NSEQ;
    if (!split || F.vcu < NSEQ) { for (int rep = 0; rep < 1 + REP_SCAN; ++rep) for (int u = F.vcu; u < NSEQ; u += F.G) scan_unit(F, l, u, rep < REP_SCAN); }
    if (!split || F.vcu >= NSEQ) {
        const int tc_lo = (l == 0) ? 0 : 4, nit = (NCH - tc_lo) * NBATCH * 4;
        const int start = split ? F.vcu - NSEQ : F.vcu, stride = split ? F.G - NSEQ : F.G;
        for (int rep = 0; rep < 1 + REP_POOL; ++rep) { v4u pr[3];
            if (start < nit) pool_load(F, (start >> 2) & 7, tc_lo + (start >> 5), start & 3, pr);
            for (int it = start; it < nit; it += stride) { const int nx = it + stride; pool_item(F, l, (it >> 2) & 7, tc_lo + (it >> 5), it & 3, pr, nx < nit, (nx >> 2) & 7, tc_lo + (nx >> 5), nx & 3); } }
    }
}
__device__ __forceinline__ void phase_hnorm(Frame& F, int l) {
    const bf16* PX = (const bf16*)(F.ws + WS_PX); const bf16* O = (const bf16*)(F.ws + WS_KV); bf16* Y = (bf16*)(F.ws + WS_HX);
    const int gw = F.vcu * NWAVES + F.wave, NGW = F.G * NWAVES, r_lo = (l == 0) ? 0 : NC;
    const f32x4 w0 = *(const GAS f32x4*)(F.in[10] + l * 128 + (F.lane & 15) * 8), w1 = *(const GAS f32x4*)(F.in[10] + l * 128 + (F.lane & 15) * 8 + 4);
    for (int row = r_lo + gw; row < NTOK; row += NGW) {
        const v4u a = *(const GAS v4u*)(O + (size_t)row * HW + F.lane * 8), bb = *(const GAS v4u*)(O + ((size_t)NTOK + row) * HW + F.lane * 8), gg = *(const GAS v4u*)(PX + (size_t)row * INC + 4 * HW + F.lane * 8);
        float o[8], gt[8];
        o[0] = bf2f((unsigned short)(a.x & 0xffff)) + bf2f((unsigned short)(bb.x & 0xffff)); o[1] = bf2f((unsigned short)(a.x >> 16)) + bf2f((unsigned short)(bb.x >> 16));
        o[2] = bf2f((unsigned short)(a.y & 0xffff)) + bf2f((unsigned short)(bb.y & 0xffff)); o[3] = bf2f((unsigned short)(a.y >> 16)) + bf2f((unsigned short)(bb.y >> 16));
        o[4] = bf2f((unsigned short)(a.z & 0xffff)) + bf2f((unsigned short)(bb.z & 0xffff)); o[5] = bf2f((unsigned short)(a.z >> 16)) + bf2f((unsigned short)(bb.z >> 16));
        o[6] = bf2f((unsigned short)(a.w & 0xffff)) + bf2f((unsigned short)(bb.w & 0xffff)); o[7] = bf2f((unsigned short)(a.w >> 16)) + bf2f((unsigned short)(bb.w >> 16));
        gt[0] = bf2f((unsigned short)(gg.x & 0xffff)); gt[1] = bf2f((unsigned short)(gg.x >> 16)); gt[2] = bf2f((unsigned short)(gg.y & 0xffff)); gt[3] = bf2f((unsigned short)(gg.y >> 16));
        gt[4] = bf2f((unsigned short)(gg.z & 0xffff)); gt[5] = bf2f((unsigned short)(gg.z >> 16)); gt[6] = bf2f((unsigned short)(gg.w & 0xffff)); gt[7] = bf2f((unsigned short)(gg.w >> 16));
        float s = 0.f;
#pragma unroll
        for (int i = 0; i < 8; ++i) s += o[i] * o[i];
        s += shx(s, 1, F.lane); s += shx(s, 2, F.lane); s += shx(s, 4, F.lane); s += shx(s, 8, F.lane);
        const float rn = 1.0f / sqrtf(s * (1.f / 128.f) + EPSN);
        const float wv[8] = {w0.x, w0.y, w0.z, w0.w, w1.x, w1.y, w1.z, w1.w}; float y[8];
#pragma unroll
        for (int i = 0; i < 8; ++i) y[i] = o[i] * rn * wv[i] * (gt[i] * sigmoidf_(gt[i]));
        *(GAS v4u*)(Y + (size_t)row * DM + F.lane * 8) = (v4u){pk2(y[0], y[1]), pk2(y[2], y[3]), pk2(y[4], y[5]), pk2(y[6], y[7])};
    }
}
__device__ __forceinline__ int moe_row_base(int l) { return l == 0 ? 0 : NC; }
__device__ __forceinline__ int moe_half_rows(int l) { return (l == 0 ? NTOK : NX) / NHALF; }


#ifndef DIAG_NAIVE_HGRN
#define DIAG_NAIVE_HGRN 0
#endif
#ifndef DIAG_ROUTER_F32
#define DIAG_ROUTER_F32 0
#endif
#ifndef DIAG_NAIVE_MOE
#define DIAG_NAIVE_MOE 0
#endif
#ifndef DIAG_NAIVE_ROUTE
#define DIAG_NAIVE_ROUTE 0
#endif
#ifndef DIAG_NAIVE_INPROJ
#define DIAG_NAIVE_INPROJ 0
#endif
#ifndef DIAG_NAIVE_OUTPROJ
#define DIAG_NAIVE_OUTPROJ 0
#endif
#ifndef DIAG_CHECK_SLOTS
#define DIAG_CHECK_SLOTS 0
#endif
#ifndef DIAG_NAIVE_MOD
#define DIAG_NAIVE_MOD 0
#endif
#ifndef DIAG_NAIVE_POOL
#define DIAG_NAIVE_POOL 0
#endif
__device__ __forceinline__ void diag_hgrn_scan(Frame& F, int l) {
    LAS float* fz = (LAS float*)(F.lds); LAS float* fk = fz + 128; LAS float* fq = fk + 128; LAS float* fv = fq + 128; LAS float* po = fv + 128;
    const bf16* PX = (const bf16*)(F.ws + WS_PX); float* OBUF = (float*)(F.ws + WS_KV);
    const int v = F.tid & 127, kq = F.tid >> 7;
    for (int it = F.vcu; it < NSEQ; it += F.G) {
        const int dir = it & 1, h = (it >> 1) & 3, b = it >> 3;
        float S[32];
#pragma unroll
        for (int i = 0; i < 32; ++i) S[i] = 0.f;
        const float lb = lb_of(F, l, dir, h * 128 + v), lbf = fmaxf(lb, 1e-30f), oml = 1.0f - lb;
        for (int step = 0; step < CTXL + SEQL; ++step) {
            int row;
            if (step < CTXL) row = b * CTXL + (dir ? CTXL - 1 - step : step);
            else { const int t = step - CTXL; row = NC + b * SEQL + (dir ? SEQL - 1 - t : t); }
            const bf16* pr = PX + (size_t)row * INC;
            if (kq == 0) { const float z = bf2f(pr[dir * HW + h * 128 + v]); const float sg = sigmoidf_(z); fz[v] = lbf + oml * sg; fk[v] = oml * (1.0f - sg); }
            if (kq == 1) { const float q = bf2f(pr[3 * HW + h * 128 + v]); fq[v] = q * sigmoidf_(q) * 0.08838834764831845f; }
            if (kq == 2) fv[v] = bf2f(pr[2 * HW + h * 128 + v]);
            __syncthreads();
            const float vv = fv[v]; float o = 0.f;
#pragma unroll
            for (int i = 0; i < 32; ++i) { const int k = kq * 32 + i; S[i] = fz[k] * S[i] + fk[k] * vv; o += S[i] * fq[k]; }
            po[kq * 128 + v] = o;
            __syncthreads();
            if (kq == 0) OBUF[((size_t)dir * NTOK + row) * HW + h * 128 + v] = (po[v] + po[128 + v]) + (po[256 + v] + po[384 + v]);
        }
        __syncthreads();
    }
}
__device__ __forceinline__ void diag_hgrn_norm(Frame& F, int l) {
    const bf16* PX = (const bf16*)(F.ws + WS_PX); const float* OBUF = (const float*)(F.ws + WS_KV); bf16* Y = (bf16*)(F.ws + WS_HX);
    const int gw = F.vcu * NWAVES + F.wave, NGW = F.G * NWAVES;
    const int r_lo = (l == 0) ? 0 : NC;
    for (int i = gw; i < (NTOK - r_lo) * 4; i += NGW) {
        const int row = r_lo + (i >> 2), h = i & 3;
        const float o0 = OBUF[(size_t)row * HW + h * 128 + F.lane] + OBUF[((size_t)NTOK + row) * HW + h * 128 + F.lane];
        const float o1 = OBUF[(size_t)row * HW + h * 128 + 64 + F.lane] + OBUF[((size_t)NTOK + row) * HW + h * 128 + 64 + F.lane];
        const float rn = 1.0f / sqrtf(wave_sum(o0 * o0 + o1 * o1, F.lane) * (1.f / 128.f) + EPSN);
        const float g0 = bf2f(PX[(size_t)row * INC + 4 * HW + h * 128 + F.lane]), g1 = bf2f(PX[(size_t)row * INC + 4 * HW + h * 128 + 64 + F.lane]);
        Y[(size_t)row * DM + h * 128 + F.lane] = (bf16)f2bf(o0 * rn * F.in[10][l * 128 + F.lane] * (g0 * sigmoidf_(g0)));
        Y[(size_t)row * DM + h * 128 + 64 + F.lane] = (bf16)f2bf(o1 * rn * F.in[10][l * 128 + 64 + F.lane] * (g1 * sigmoidf_(g1)));
    }
}
__device__ __forceinline__ void diag_pool(Frame& F, int l) {
    LAS float* pl = (LAS float*)(F.lds);
    const bf16* PX = (const bf16*)(F.ws + WS_PX); bf16* Y = (bf16*)(F.ws + WS_HX);
    const int sub = F.tid >> 7, d = F.tid & 127;
    const int r_lo = (l == 0) ? 0 : NC;
    for (int it = F.vcu; it < (NTOK - r_lo); it += F.G) {
        const int row = r_lo + it, gi = sub, wdw = 2 << gi, hw2 = wdw >> 1;
        int pos, n, srow;
        if (row < NC) { pos = row % CTXL; n = CTXL; srow = row - pos; } else { pos = (row - NC) % 64; n = 64; srow = row - pos; }
        int lo = pos - hw2, hi = pos + hw2; lo = lo < 0 ? 0 : lo; hi = hi > n ? n : hi;
        float sm = 0.f; for (int r = lo; r < hi; ++r) sm += bf2f(PX[(size_t)(srow + r) * INC + 5 * HW + gi * 128 + d]);
        pl[sub * 128 + d] = sm / (float)(hi - lo) - bf2f(PX[(size_t)row * INC + 5 * HW + gi * 128 + d]);
        __syncthreads();
        const float* wp = F.in[11] + (size_t)(l * 4 + gi) * 128 * 128;
        float o = 0.f; for (int c = 0; c < 128; ++c) o += pl[sub * 128 + c] * wp[c * 128 + d];
        Y[(size_t)row * DM + HW + gi * 128 + d] = (bf16)f2bf(o * F.in[12][l * HW + gi * 128 + d]);
        __syncthreads();
    }
}

__device__ __forceinline__ void diag_moe(Frame& F, int l, int half) {
    LAS float* xs = (LAS float*)(F.lds + F.wave * 16384);
    const bf16* HX = (const bf16*)(F.ws + WS_HX); bf16* YS = (bf16*)(F.ws + WS_YS);
    const int* blke = (const int*)(F.ws + RT_BLKE) + half * MAXBLK; const int* stok = (const int*)(F.ws + RT_STOK) + half * MAXSLOT;
    const int nblk = ((const int*)(F.ws + RT_MISC))[half];
    const int gw = F.vcu * NWAVES + F.wave, NGW = F.G * NWAVES;
    for (int it = gw; it < nblk * 64; it += NGW) {
        const int slot0 = it * 4, e = blke[slot0 >> 8];
        const float* w1 = (e < 64) ? F.in[16] + ((size_t)l * 64 + e) * DM * 256 : F.in[19] + (size_t)l * DM * 256;
        const float* w3 = (e < 64) ? F.in[17] + ((size_t)l * 64 + e) * DM * 256 : F.in[20] + (size_t)l * DM * 256;
        const float* w2 = (e < 64) ? F.in[18] + ((size_t)l * 64 + e) * 256 * DM : F.in[21] + (size_t)l * 256 * DM;
#pragma unroll
        for (int r = 0; r < 4; ++r) { const bf16* xr = HX + (size_t)stok[slot0 + r] * DM;
            for (int k = F.lane; k < DM; k += 64) xs[r * 1024 + k] = bf2f(xr[k]); }
        LDS_WAIT(); asm volatile("" ::: "memory");
        float a1[4][4], a3[4][4];
#pragma unroll
        for (int r = 0; r < 4; ++r)
#pragma unroll
            for (int i = 0; i < 4; ++i) { a1[r][i] = 0.f; a3[r][i] = 0.f; }
        for (int k = 0; k < DM; ++k) {
            float x4[4];
#pragma unroll
            for (int r = 0; r < 4; ++r) x4[r] = xs[r * 1024 + k];
#pragma unroll
            for (int i = 0; i < 4; ++i) { const float u1 = w1[(size_t)k * 256 + F.lane + 64 * i], u3 = w3[(size_t)k * 256 + F.lane + 64 * i];
#pragma unroll
                for (int r = 0; r < 4; ++r) { a1[r][i] += x4[r] * u1; a3[r][i] += x4[r] * u3; } }
        }
        LDS_WAIT(); asm volatile("" ::: "memory");
#pragma unroll
        for (int r = 0; r < 4; ++r)
#pragma unroll
            for (int i = 0; i < 4; ++i) xs[r * 256 + F.lane + 64 * i] = a1[r][i] * sigmoidf_(a1[r][i]) * a3[r][i];
        LDS_WAIT(); asm volatile("" ::: "memory");
#pragma unroll 1
        for (int dh = 0; dh < 4; ++dh) {
            float y[4][4];
#pragma unroll
            for (int r = 0; r < 4; ++r)
#pragma unroll
                for (int i = 0; i < 4; ++i) y[r][i] = 0.f;
            for (int n = 0; n < 256; ++n) {
                float h4[4];
#pragma unroll
                for (int r = 0; r < 4; ++r) h4[r] = xs[r * 256 + n];
#pragma unroll
                for (int i = 0; i < 4; ++i) { const float u = w2[(size_t)n * DM + dh * 256 + F.lane + 64 * i];
#pragma unroll
                    for (int r = 0; r < 4; ++r) y[r][i] += h4[r] * u; }
            }
#pragma unroll
            for (int r = 0; r < 4; ++r)
#pragma unroll
                for (int i = 0; i < 4; ++i) YS[(size_t)(slot0 + r) * DM + dh * 256 + F.lane + 64 * i] = (bf16)f2bf(y[r][i]);
        }
        LDS_WAIT(); asm volatile("" ::: "memory");
    }
}

__device__ __forceinline__ void diag_gemm(Frame& F, int l, int mode) {
    LAS float* As = (LAS float*)(F.lds); LAS float* Bs = As + 16 * 65;
    const int N = mode ? DM : INC, rbase = (mode && l == 1) ? NC : 0, M = NTOK - rbase;
    const bf16* A = (const bf16*)(F.ws + WS_HX) + (size_t)rbase * DM;
    const float* W = mode ? F.in[13] + (size_t)l * DM * DM : F.in[8] + (size_t)l * DM * INC;
    const int ty = F.tid >> 5, tx = F.tid & 31, ntn = N / 128;
    for (int it = F.vcu; it < (M / 64) * ntn; it += F.G) {
        const int m0 = (it / ntn) * 64, n0 = (it % ntn) * 128;
        float acc[4][4];
#pragma unroll
        for (int i = 0; i < 4; ++i)
#pragma unroll
            for (int j = 0; j < 4; ++j) acc[i][j] = 0.f;
        for (int k0 = 0; k0 < DM; k0 += 16) {
            { const int idx = F.tid * 2, r = idx >> 4, kk = idx & 15; const unsigned u = *(const unsigned*)(A + (size_t)(m0 + r) * DM + k0 + kk);
              As[kk * 65 + r] = bf2f((unsigned short)(u & 0xffff)); As[(kk + 1) * 65 + r] = bf2f((unsigned short)(u >> 16)); }
            { const int r = F.tid >> 5, c4 = (F.tid & 31) * 4; *(LAS f32x4*)(Bs + r * 128 + c4) = *(const GAS f32x4*)(W + (size_t)(k0 + r) * N + n0 + c4); }
            __syncthreads();
#pragma unroll
            for (int kk = 0; kk < 16; ++kk) { float a[4]; f32x4 b = *(const LAS f32x4*)(Bs + kk * 128 + tx * 4);
#pragma unroll
                for (int i = 0; i < 4; ++i) a[i] = As[kk * 65 + ty * 4 + i];
#pragma unroll
                for (int i = 0; i < 4; ++i) { acc[i][0] += a[i] * b.x; acc[i][1] += a[i] * b.y; acc[i][2] += a[i] * b.z; acc[i][3] += a[i] * b.w; } }
            __syncthreads();
        }
#pragma unroll
        for (int i = 0; i < 4; ++i) { const int row = rbase + m0 + ty * 4 + i, col = n0 + tx * 4;
            if (mode == 0) { bf16* px = (bf16*)(F.ws + WS_PX) + (size_t)row * INC + col;
                *(unsigned long long*)px = (unsigned long long)pk2(acc[i][0], acc[i][1]) | ((unsigned long long)pk2(acc[i][2], acc[i][3]) << 32); }
            else { const float* bp = resid_in_row(F, l, row) + col; float* op = resid_row(F, row) + col; const float* gt = (const float*)(F.ws + WS_MOD) + ((size_t)l * 9 + mod_row(row)) * 6144 + 2048 + col;
                const f32x4 b = *(const GAS f32x4*)bp, g = *(const GAS f32x4*)gt; *(GAS f32x4*)op = (f32x4){b.x + g.x * acc[i][0], b.y + g.y * acc[i][1], b.z + g.z * acc[i][2], b.w + g.w * acc[i][3]}; } }
    }
}

__device__ __forceinline__ void diag_check_slots(Frame& F, int l) {
    const int rb = moe_row_base(l), nhalf = moe_half_rows(l);
    const int* IDX = (const int*)(F.ws + RT_IDX); const int* TSLOT = (const int*)(F.ws + RT_TSLOT); const int* STOK = (const int*)(F.ws + RT_STOK); const int* BLKE = (const int*)(F.ws + RT_BLKE); const int* MISCT = (const int*)(F.ws + RT_MISC);
    bool bad = false;
    for (int a = F.vcu * 512 + F.tid; a < 2 * nhalf * 6; a += F.G * 512) {
        const int row = rb + a / 6, half = (a / 6) >= nhalf ? 1 : 0; const int slot = TSLOT[(size_t)rb * 6 + a], e = IDX[(size_t)rb * 6 + a];
        if (slot < 0 || slot >= MISCT[half] * 256) bad = true;
        else { if (STOK[half * MAXSLOT + slot] != row) bad = true; if (BLKE[half * MAXBLK + (slot >> 8)] != e) bad = true; }
    }
    for (int i = F.vcu * 512 + F.tid; i < 2 * nhalf; i += F.G * 512) { const int half = i >= nhalf ? 1 : 0, ii = i - half * nhalf; const int slot = MISCT[2 + half] + ii;
        if (STOK[half * MAXSLOT + slot] != rb + i) bad = true; if (BLKE[half * MAXBLK + (slot >> 8)] != 64) bad = true; }
    if (bad) F.out[0] = __builtin_nanf("");
    if (bad) ((float*)(F.ws + WS_MOD))[5120] = __builtin_nanf("");
}

__device__ __forceinline__ void diag_mod(Frame& F) {
    float* mod = (float*)(F.ws + WS_MOD);
    for (int i = F.vcu * 512 + F.tid; i < 2 * 6144; i += F.G * 512) {
        const int l = i / 6144, n = i % 6144; float acc[9];
        for (int r = 0; r < 9; ++r) acc[r] = 0.f;
        for (int k = 0; k < DM; ++k) { const float w = F.in[6][((size_t)l * DM + k) * 6144 + n];
            for (int r = 0; r < 9; ++r) { const float c = (r < 8) ? F.in[1][r * DM + k] : F.in[3][k]; acc[r] += (c / (1.0f + expf(-c))) * w; } }
        for (int r = 0; r < 9; ++r) mod[((size_t)l * 9 + r) * 6144 + n] = acc[r] + F.in[7][(size_t)l * 6144 + n];
    }
}

__device__ __forceinline__ void phase_route(Frame& F, int l, bool dry = false) {
    LAS bf16* Xt = (LAS bf16*)(F.lds);
    LAS float* Lg = (LAS float*)(F.lds + 32 * 2064);
    LAS unsigned* lcnt = (LAS unsigned*)(F.lds + 32 * 2064 + 8192);
    const GAS float* mod = (const GAS float*)(F.ws + WS_MOD) + (size_t)l * 9 * 6144;
    GAS bf16* HX = (GAS bf16*)(F.ws + WS_HX); const GAS bf16* WrT = (const GAS bf16*)(F.ws + WS_WR);
    GAS int* IDX = (GAS int*)(F.ws + RT_IDX); GAS float* GATE = (GAS float*)(F.ws + RT_GATE);
    const int rb = moe_row_base(l), nhalf = moe_half_rows(l), ntiles = NHALF * nhalf / 32;
    const int lr = F.lane & 15, lq = F.lane >> 4, w = F.wave;
    if (F.tid < 128) lcnt[F.tid] = 0u;
    if (F.vcu == 0) { unsigned z0 = 0u; asm volatile("" : "+v"(z0)); for (int i = F.tid; i < DM / 16; i += 512) ((GAS v4u*)((GAS unsigned char*)HX + (size_t)NTOK * DM))[i] = (v4u){z0, z0, z0, z0}; }
    const int mt = w >> 2, nt = w & 3;
    bf16x8 wf[32];
#pragma unroll
    for (int s2 = 0; s2 < 32; ++s2) wf[s2] = *(const GAS bf16x8*)(WrT + (size_t)(16 * nt + lr) * DM + 32 * s2 + 8 * lq);
    const float rbias = ((const GAS float*)F.in[15])[l * NE + F.lane];
    const GAS f32x4* nw = (const GAS f32x4*)(F.in[5] + l * DM);
    __syncthreads();
    for (int it = F.vcu; it < ntiles; it += F.G) {
        const int row0 = rb + it * 32;
        {
#pragma unroll
          for (int ip = 0; ip < 2; ++ip) { f32x4 xv[2][4];
#pragma unroll
          for (int i = 0; i < 2; ++i) { const GAS f32x4* xr = (const GAS f32x4*)resid_row(F, row0 + w * 4 + 2 * ip + i) + F.lane;
#pragma unroll
              for (int j = 0; j < 4; ++j) xv[i][j] = xr[64 * j]; }
#pragma unroll
          for (int i = 0; i < 2; ++i) { const int lrow = w * 4 + 2 * ip + i, row = row0 + lrow; const GAS float* md = mod + mod_row(row) * 6144;
              float ss = 0.f;
#pragma unroll
              for (int j = 0; j < 4; ++j) ss += (xv[i][j].x * xv[i][j].x + xv[i][j].y * xv[i][j].y) + (xv[i][j].z * xv[i][j].z + xv[i][j].w * xv[i][j].w);
              const float r = 1.0f / sqrtf(wave_sum(ss, F.lane) * (1.f / DM) + EPSN);
#pragma unroll
              for (int j = 0; j < 4; ++j) { const f32x4 w4 = nw[F.lane + 64 * j], s4 = ((const GAS f32x4*)(md + 4096))[F.lane + 64 * j], h4 = ((const GAS f32x4*)(md + 3072))[F.lane + 64 * j];
                  const f32x4 o = (xv[i][j] * r) * w4 * (s4 + 1.0f) + h4;
                  const unsigned long long pk = (unsigned long long)pk2(o.x, o.y) | ((unsigned long long)pk2(o.z, o.w) << 32);
                  int w8 = 0; w8 = __builtin_amdgcn_cvt_pk_fp8_f32(o.x, o.y, w8, false); w8 = __builtin_amdgcn_cvt_pk_fp8_f32(o.z, o.w, w8, true);
                  ((GAS unsigned*)((GAS unsigned char*)HX + (size_t)row * DM))[F.lane + 64 * j] = (unsigned)w8;
                  *(LAS unsigned long long*)(Xt + lrow * 1032 + 4 * (F.lane + 64 * j)) = pk; } } } }
        __syncthreads();
        { const float zf = opaque_zero(); f32x4 a4 = (f32x4){zf, zf, zf, zf};
#pragma unroll
          for (int s2 = 0; s2 < 32; ++s2) { const bf16x8 a = *(const LAS bf16x8*)(Xt + (16 * mt + lr) * 1032 + 32 * s2 + 8 * lq); a4 = __builtin_amdgcn_mfma_f32_16x16x32_bf16(wf[s2], a, a4, 0, 0, 0); }
          *(LAS f32x4*)(Lg + (16 * mt + lr) * 64 + 16 * nt + 4 * lq) = a4; }
        __syncthreads();
        { float sc[4], bs[4], gs[4], msk[4], ssum[4], myg2[4]; int myi[4], sel[4];
#pragma unroll
          for (int i = 0; i < 4; ++i) { sc[i] = sigmoidf_(Lg[(w * 4 + i) * 64 + F.lane]); bs[i] = sc[i] + rbias; ssum[i] = 0.f; sel[i] = 0; myi[i] = 0; myg2[i] = 0.f; }
          { float m1[4], m2[4];
#pragma unroll
            for (int i = 0; i < 4; ++i) m1[i] = bs[i];
#pragma unroll
            for (int i = 0; i < 4; ++i) m1[i] = max8_dpp(m1[i]);
            const int gb = F.lane & ~7;
#pragma unroll
            for (int i = 0; i < 4; ++i) { const unsigned long long bal = __ballot(bs[i] == m1[i]); const unsigned gm = (unsigned)((bal >> gb) & 0xffull); const int first = gb + __ffs((int)gm) - 1; m2[i] = (F.lane == first) ? -3.0e38f : bs[i]; }
#pragma unroll
            for (int i = 0; i < 4; ++i) m2[i] = max8_dpp(m2[i]);
#pragma unroll
            for (int i = 0; i < 4; ++i) gs[i] = m1[i] + m2[i]; }
          { const int myg = F.lane >> 3; int rank[4] = {0, 0, 0, 0};
#pragma unroll
            for (int g2 = 0; g2 < 8; ++g2)
#pragma unroll
                for (int i = 0; i < 4; ++i) { const float og = rdlane(gs[i], g2 * 8); rank[i] += ((og > gs[i]) || (og == gs[i] && g2 < myg)) ? 1 : 0; }
#pragma unroll
            for (int i = 0; i < 4; ++i) msk[i] = (rank[i] < 4) ? bs[i] : -1.0e4f; }
#pragma unroll
          for (int jj = 0; jj < 6; ++jj) { float mx[4];
#pragma unroll
              for (int i = 0; i < 4; ++i) mx[i] = max64_dpp(msk[i]);
#pragma unroll
              for (int i = 0; i < 4; ++i) { const unsigned long long b2 = __ballot(msk[i] == mx[i]); const int win = __ffsll((long long)b2) - 1;
                  const float wv = rdlane(sc[i], win); ssum[i] += wv; if (F.lane == jj) { myi[i] = win; myg2[i] = wv; } if (F.lane == win) { msk[i] = -3.0e38f; sel[i] = 1; } } }
#pragma unroll
          for (int i = 0; i < 4; ++i) { const int row = row0 + w * 4 + i; const float inv = 2.5f / ssum[i];
              if (F.lane < 6) { IDX[(size_t)row * 6 + F.lane] = myi[i]; GATE[(size_t)row * 6 + F.lane] = myg2[i] * inv; }
              const int half = (row - rb) >= nhalf ? 1 : 0;
              if (sel[i] && !dry) __hip_atomic_fetch_add(&lcnt[half * 64 + F.lane], 1u, __ATOMIC_RELAXED, __HIP_MEMORY_SCOPE_WORKGROUP); } }
        __syncthreads();
    }
    __syncthreads();
    if (F.tid < 128) { const unsigned v = lcnt[F.tid]; if (v) atomicAdd(F.ctl + CW_CNT + l * 128 + F.tid, v); }
}

__device__ __forceinline__ void phase_slots(Frame& F, int l) {
    LAS int* pstart = (LAS int*)(F.lds);
    LAS int* cntl = (LAS int*)(F.lds + 1024);
    LAS unsigned* lc = (LAS unsigned*)(F.lds + 2048);
    LAS unsigned* lbase = (LAS unsigned*)(F.lds + 2560);
    const int rb = moe_row_base(l), nhalf = moe_half_rows(l);
    const int* IDX = (const int*)(F.ws + RT_IDX); int* TSLOT = (int*)(F.ws + RT_TSLOT); int* STOK = (int*)(F.ws + RT_STOK); int* BLKE = (int*)(F.ws + RT_BLKE); int* MISC = (int*)(F.ws + RT_MISC);
    if (F.tid < 128) cntl[F.tid] = (int)__hip_atomic_load(F.ctl + CW_CNT + l * 128 + F.tid, __ATOMIC_RELAXED, __HIP_MEMORY_SCOPE_AGENT);
    __syncthreads();
    if (F.tid < NHALF) { int s = 0; for (int e = 0; e < 64; ++e) { pstart[F.tid * 66 + e] = s; s += (cntl[F.tid * 64 + e] + 255) & ~255; } pstart[F.tid * 66 + 64] = s; pstart[F.tid * 66 + 65] = s + nhalf; }
    __syncthreads();
    for (int w = F.vcu; w < NHALF * 65; w += F.G) {
        const int half = w / 65, e = w % 65; int* stok = STOK + half * MAXSLOT; int* blke = BLKE + half * MAXBLK;
        const int ps = pstart[half * 66 + e], pe = pstart[half * 66 + e + 1];
        for (int b = ps / 256 + F.tid; b < pe / 256; b += 512) blke[b] = e;
        if (e < 64) { for (int s = ps + cntl[half * 64 + e] + F.tid; s < pe; s += 512) stok[s] = NTOK; }
        else { for (int i = F.tid; i < nhalf; i += 512) stok[ps + i] = rb + half * nhalf + i;
               if (F.tid == 0) { MISC[half] = pe / 256; MISC[2 + half] = ps; } }
    }
    const int tpc = NHALF * nhalf / 256;
    for (int ck = F.vcu; ck < 256; ck += F.G) {
        const int half = (ck * tpc) / nhalf, tok0 = rb + ck * tpc; int* stok = STOK + half * MAXSLOT;
        if (F.tid < 64) lc[F.tid] = 0u;
        __syncthreads();
        int e0 = -1, e1 = -1; unsigned p0 = 0, p1 = 0; const int a0 = F.tid, a1 = F.tid + 512;
        if (a0 < tpc * 6) { e0 = IDX[(size_t)tok0 * 6 + a0]; p0 = __hip_atomic_fetch_add(&lc[e0], 1u, __ATOMIC_RELAXED, __HIP_MEMORY_SCOPE_WORKGROUP); }
        if (a1 < tpc * 6) { e1 = IDX[(size_t)tok0 * 6 + a1]; p1 = __hip_atomic_fetch_add(&lc[e1], 1u, __ATOMIC_RELAXED, __HIP_MEMORY_SCOPE_WORKGROUP); }
        __syncthreads();
        if (F.tid < 64) { const unsigned n = lc[F.tid]; lbase[F.tid] = n ? atomicAdd(F.ctl + CW_CUR + l * 128 + half * 64 + F.tid, n) : 0u; }
        __syncthreads();
        if (e0 >= 0) { const int slot = pstart[half * 66 + e0] + (int)(lbase[e0] + p0); stok[slot] = tok0 + a0 / 6; TSLOT[(size_t)tok0 * 6 + a0] = slot; }
        if (e1 >= 0) { const int slot = pstart[half * 66 + e1] + (int)(lbase[e1] + p1); stok[slot] = tok0 + a1 / 6; TSLOT[(size_t)tok0 * 6 + a1] = slot; }
        __syncthreads();
    }
}

__device__ __forceinline__ void phase_combine(Frame& F, int l, int half) {
    const int gw = F.vcu * NWAVES + F.wave, NGW = F.G * NWAVES;
    const int rb = moe_row_base(l), nhalf = moe_half_rows(l);
    const GAS float* mod = (const GAS float*)(F.ws + WS_MOD) + (size_t)l * 9 * 6144;
    const GAS int* TSLOT = (const GAS int*)(F.ws + RT_TSLOT); const GAS float* GATE = (const GAS float*)(F.ws + RT_GATE); const int* MISC = (const int*)(F.ws + RT_MISC);
    const GAS unsigned char* YS = (const GAS unsigned char*)(F.ws + WS_YS); GAS bf16* HX = (GAS bf16*)(F.ws + WS_HX);
    const int shs = MISC[2 + half], c0 = 8 * F.lane;
    int sl[6]; float gj[6];
    if (gw < nhalf) { const size_t a = (size_t)(rb + half * nhalf + gw) * 6;
#pragma unroll
        for (int j = 0; j < 6; ++j) { sl[j] = TSLOT[a + j]; gj[j] = GATE[a + j]; } }
    for (int i = gw; i < nhalf; i += NGW) {
        const int row = rb + half * nhalf + i;
        GAS float* xr = (GAS float*)resid_row(F, row); const GAS float* gt = mod + mod_row(row) * 6144 + 5120;
        unsigned long long ya[7][2];
#pragma unroll
        for (int j = 0; j < 6; ++j) { const GAS unsigned char* yp = YS + (size_t)sl[j] * DM + c0; ya[j][0] = *(const GAS unsigned long long*)yp; ya[j][1] = *(const GAS unsigned long long*)(yp + 512); }
        { const GAS unsigned char* yp = YS + (size_t)(shs + i) * DM + c0; ya[6][0] = *(const GAS unsigned long long*)yp; ya[6][1] = *(const GAS unsigned long long*)(yp + 512); }
        f32x4 xv[4], g4[4];
#pragma unroll
        for (int q = 0; q < 4; ++q) { const int co = c0 + (q >> 1) * 512 + (q & 1) * 4; xv[q] = *(const GAS f32x4*)(xr + co); g4[q] = *(const GAS f32x4*)(gt + co); }
        float gc[7];
#pragma unroll
        for (int j = 0; j < 6; ++j) gc[j] = gj[j] * (1.0f / pg8::YS_SCALE);
        gc[6] = 1.0f / pg8::YS_SCALE;
        if (i + NGW < nhalf) { const size_t a = (size_t)(row + NGW) * 6;
#pragma unroll
            for (int j = 0; j < 6; ++j) { sl[j] = TSLOT[a + j]; gj[j] = GATE[a + j]; } }
        float y[16]; const float zf = opaque_zero();
#pragma unroll
        for (int k = 0; k < 16; ++k) y[k] = zf;
#pragma unroll
        for (int j = 0; j < 7; ++j)
#pragma unroll
            for (int hh = 0; hh < 2; ++hh) { const int lo = (int)(unsigned)ya[j][hh], hi = (int)(unsigned)(ya[j][hh] >> 32);
                const pg8::f32v2_t a0 = __builtin_amdgcn_cvt_pk_f32_fp8(lo, false), a1 = __builtin_amdgcn_cvt_pk_f32_fp8(lo, true), a2 = __builtin_amdgcn_cvt_pk_f32_fp8(hi, false), a3 = __builtin_amdgcn_cvt_pk_f32_fp8(hi, true);
                y[8 * hh + 0] += gc[j] * a0.x; y[8 * hh + 1] += gc[j] * a0.y; y[8 * hh + 2] += gc[j] * a1.x; y[8 * hh + 3] += gc[j] * a1.y;
                y[8 * hh + 4] += gc[j] * a2.x; y[8 * hh + 5] += gc[j] * a2.y; y[8 * hh + 6] += gc[j] * a3.x; y[8 * hh + 7] += gc[j] * a3.y; }
        float ss = 0.f;
#pragma unroll
        for (int q = 0; q < 4; ++q) { xv[q] = xv[q] + g4[q] * (f32x4){y[4 * q], y[4 * q + 1], y[4 * q + 2], y[4 * q + 3]};
            ss += (xv[q].x * xv[q].x + xv[q].y * xv[q].y) + (xv[q].z * xv[q].z + xv[q].w * xv[q].w); }
        const float r = 1.0f / sqrtf(wave_sum(ss, F.lane) * (1.f / DM) + EPSN);
        if (l == 1) {
#pragma unroll
            for (int q = 0; q < 4; ++q) { const int co = c0 + (q >> 1) * 512 + (q & 1) * 4; const f32x4 w4 = *(const GAS f32x4*)((const GAS float*)F.in[22] + co); *(GAS f32x4*)(xr + co) = xv[q] * r * w4; }
        } else {
            const GAS float* md1 = mod + (size_t)(9 + mod_row(row)) * 6144; const GAS float* nw = (const GAS float*)F.in[4] + DM;
            unsigned pk[8];
#pragma unroll
            for (int q = 0; q < 4; ++q) { const int co = c0 + (q >> 1) * 512 + (q & 1) * 4; *(GAS f32x4*)(xr + co) = xv[q];
                const f32x4 w4 = *(const GAS f32x4*)(nw + co), s4 = *(const GAS f32x4*)(md1 + 1024 + co), h4 = *(const GAS f32x4*)(md1 + co);
                const f32x4 o = (xv[q] * r) * w4 * (s4 + 1.0f) + h4; pk[2 * q] = pk2(o.x, o.y); pk[2 * q + 1] = pk2(o.z, o.w); }
            *(GAS v4u*)(HX + (size_t)row * DM + c0) = (v4u){pk[0], pk[1], pk[2], pk[3]}; *(GAS v4u*)(HX + (size_t)row * DM + 512 + c0) = (v4u){pk[4], pk[5], pk[6], pk[7]};
        }
    }
}

constexpr int PH_PER_LAYER = 14, N_PHASES = 1 + 2 * PH_PER_LAYER;
#ifndef MK_PER_PHASE
#define MK_PER_PHASE 0
#endif
struct Args { const float* in[23]; float* out; unsigned char* ws; int ph_lo, ph_hi; };
__global__ void __launch_bounds__(NWAVES * 64, 2) mk_fwd(Args args) {
    {
        LAS unsigned char* lds = (LAS unsigned char*)g_lds;
        for (int u = threadIdx.x; u < (LDS_BYTES - LDSCTL_OFF) / 4; u += NWAVES * 64) ((LAS unsigned*)(lds + LDSCTL_OFF))[u] = 0u;
        __syncthreads();
        LAS unsigned long long* tab = (LAS unsigned long long*)(lds + TAB_OFF);
        if (threadIdx.x < 23) tab[threadIdx.x] = (unsigned long long)args.in[threadIdx.x];
        if (threadIdx.x == 23) tab[23] = (unsigned long long)args.out;
        if (threadIdx.x == 24) tab[24] = (unsigned long long)args.ws;
        __syncthreads();
#if !MK_PER_PHASE
        if (threadIdx.x == 0) (void)xb_add((unsigned*)(args.ws + WS_CTL) + CW_BAR + XB_XCNT(xb_xcc_id()), 1u);
#endif
    }
#if MK_PER_PHASE
    const int lo = args.ph_lo, hi = args.ph_hi;
#define IN(k) (lo <= (k) && (k) < hi)
#define SEAM(k) do { } while (0)
#else
#define IN(k) true
#define SEAM(k) do { grid_barrier(); if (REP_MASK & 0x10000u) { grid_barrier(); grid_barrier(); } if (TIMING_MASK) { if (blockIdx.x == 0 && threadIdx.x == 0) ((unsigned long long*)(args.ws + WS_CTL + 65536))[1 + seam_id] = __builtin_amdgcn_s_memrealtime(); ++seam_id; } } while (0)
#endif
#ifndef GEMM2_STAGGER
#define GEMM2_STAGGER 0
#endif
#ifndef REP_MASK
#define REP_MASK 0u
#endif
#ifndef TIMING_MASK
#define TIMING_MASK 0u
#endif
#define REP(c) (1 + ((REP_MASK >> (c)) & 1u))
#ifndef PH_MASK
#define PH_MASK 0xffffffffu
#endif
#define INM(k, c) (IN(k) && ((PH_MASK >> (c)) & 1u))
    int seam_id = 0; (void)seam_id;
    if (TIMING_MASK) { if (blockIdx.x == 0 && threadIdx.x == 0) ((unsigned long long*)(args.ws + WS_CTL + 65536))[0] = __builtin_amdgcn_s_memrealtime(); }
    if (INM(0, 0)) { Frame F = make_frame(); phase_mod(F); __syncthreads(); for (int rep = 0; rep < REP(12); ++rep) phase_wconv(F, 0); }
    SEAM(0);
#if DIAG_NAIVE_MOD
    { Frame F = make_frame(); diag_mod(F); } SEAM(0);
#endif
#pragma unroll 1
    for (int l = 0; l < 2; ++l) {
        const int P = 1 + l * PH_PER_LAYER; (void)P;
        if (l == 0) {
            if (INM(P + 0, 1)) for (int rep = 0; rep < REP(1); ++rep) { Frame F = make_frame(); phase_hx(F, l); }
            SEAM(P + 0);
        }
#if DIAG_NAIVE_INPROJ
        { Frame F = make_frame(); diag_gemm(F, l, 0); }
#else
        if (INM(P + 1, 2)) for (int rep = 0; rep < REP(2); ++rep) {
            Frame F = make_frame(); unsigned char* ws = F.ws;
            pg8::Gemm g{(const bf16*)(ws + WS_HX), (const bf16*)(ws + WS_WIN), DM, nullptr}; pg8::StaticOrder S; S.init(NTOK, INC, F.G, (int)blockIdx.x);
            pg8::EpiB16 E{(bf16*)(ws + WS_PX), INC, 0xffff};
            pg8::gemm_phase<pg8::EpiB16, pg8::StaticOrder, true, false>(F.lds, g, S, E);
        }
#endif
        SEAM(P + 1);
        if (INM(P + 2, 3)) for (int rep = 0; rep < REP(13); ++rep) { Frame F = make_frame(); phase_prep(F, l); }
        SEAM(P + 2);
#if DIAG_CHECK_PREP
        { Frame F = make_frame(); diag_check_prep(F, l); } SEAM(P + 2);
#endif
        if (INM(P + 2, 3)) { Frame F = make_frame(); phase_scan_pool(F, l); }
        SEAM(P + 2);
        if (INM(P + 3, 4)) for (int rep = 0; rep < REP(4); ++rep) { Frame F = make_frame(); phase_hnorm(F, l); }
        SEAM(P + 3);
#if DIAG_NAIVE_HGRN
        { Frame F = make_frame(); diag_hgrn_scan(F, l); } SEAM(P + 4);
        { Frame F = make_frame(); diag_hgrn_norm(F, l); } SEAM(P + 4);
#endif
#if DIAG_NAIVE_POOL
        { Frame F = make_frame(); diag_pool(F, l); } SEAM(P + 4);
#endif
#if DIAG_NAIVE_OUTPROJ
        { Frame F = make_frame(); diag_gemm(F, l, 1); }
#else
        if (INM(P + 5, 6)) for (int rep = 0; rep < (l == 0 ? REP(6) : 1); ++rep) {
            Frame F = make_frame(); unsigned char* ws = F.ws;
            const int rbase = l == 0 ? 0 : NC;
            pg8::Gemm g{(const bf16*)(ws + WS_HX) + (size_t)rbase * DM, (const bf16*)(ws + WS_WOUT), DM, nullptr}; pg8::StaticOrder S; S.init(NTOK - rbase, DM, F.G, (int)blockIdx.x);
            pg8::EpiRes E{l == 0 ? F.in[2] : (const float*)(ws + WS_CTXRES), l == 0 ? F.in[0] : (const float*)F.out, (float*)(ws + WS_CTXRES), F.out, (const float*)(ws + WS_MOD) + (size_t)l * 9 * 6144, 2048, rbase};
            pg8::gemm_phase<pg8::EpiRes, pg8::StaticOrder, true, false>(F.lds, g, S, E);
        }
#endif
        SEAM(P + 5);
        if (INM(P + 6, 7)) for (int rep = 0; rep < REP(7); ++rep) { Frame F = make_frame(); phase_route(F, l, rep + 1 < REP(7)); }
        SEAM(P + 6);
        if (INM(P + 7, 8)) { Frame F = make_frame(); phase_slots(F, l); }
        SEAM(P + 7);
#if DIAG_CHECK_SLOTS
        { Frame F = make_frame(); diag_check_slots(F, l); } SEAM(P + 7);
#endif
#pragma unroll 1
        for (int half = 0; half < NHALF; ++half) {
            const int Q = P + 8 + 3 * half; (void)Q;
            if (INM(Q + 0, 9)) for (int rep = 0; rep < REP(9); ++rep) {
                Frame F = make_frame(); unsigned char* ws = F.ws;
                const int* blke = (const int*)(ws + RT_BLKE) + half * MAXBLK; const int* stok = (const int*)(ws + RT_STOK) + half * MAXSLOT;
                const int nblk = __builtin_amdgcn_readfirstlane(((const int*)(ws + RT_MISC))[half]);
                int k1 = DM / 2; asm volatile("" : "+s"(k1));
                pg8::Gemm g{(const bf16*)(ws + WS_HX), (const bf16*)(ws + WS_W13), k1, stok, 0x7a7a7a7a}; pg8::MoeOrder S{blke, nblk, 2, F.G, F.vcu};
                pg8::EpiSwiglu E{(unsigned char*)(ws + WS_HS)};
                pg8::gemm_phase<pg8::EpiSwiglu, pg8::MoeOrder, true, true, true>(F.lds, g, S, E);
            }
            SEAM(Q + 0);
            if (INM(Q + 1, 10)) for (int rep = 0; rep < REP(10); ++rep) {
                Frame F = make_frame(); unsigned char* ws = F.ws;
                const int* blke = (const int*)(ws + RT_BLKE) + half * MAXBLK;
                const int nblk = __builtin_amdgcn_readfirstlane(((const int*)(ws + RT_MISC))[half]);
                if (GEMM2_STAGGER && (F.vcu & 1)) { const unsigned long long t0 = __builtin_amdgcn_s_memrealtime(); while (__builtin_amdgcn_s_memrealtime() - t0 < (unsigned long long)GEMM2_STAGGER) __builtin_amdgcn_s_sleep(8); }
                int k2 = 128; asm volatile("" : "+s"(k2));
                pg8::Gemm g{(const bf16*)(ws + WS_HS), (const bf16*)(ws + WS_W2), k2, nullptr, 0x7e7e7e7e};     pg8::MoeOrder S{blke, nblk, 4, F.G, F.vcu};
                pg8::EpiF8 E{(unsigned char*)(ws + WS_YS), 3, (rep + 1 < (int)REP(10)) ? 1 : 0};
                pg8::gemm_phase<pg8::EpiF8, pg8::MoeOrder, true, false, true>(F.lds, g, S, E);
            }
            SEAM(Q + 1);
#if DIAG_NAIVE_MOE
            { Frame F = make_frame(); diag_moe(F, l, half); } SEAM(Q + 1);
#endif
            if (INM(Q + 2, 11)) { Frame F = make_frame(); phase_combine(F, l, half); if (l == 0 && half == NHALF - 1) for (int rep = 0; rep < REP(12); ++rep) phase_wconv(F, 1); }
            if (!(l == 1 && half == NHALF - 1)) SEAM(Q + 2);
        }
    }
    if (TIMING_MASK) {
        SEAM(99);
        const unsigned long long* ts = (const unsigned long long*)(args.ws + WS_CTL + 65536);
        unsigned long long tk = 0ull;
        for (int k = 0; k < seam_id && k < 32; ++k) if ((TIMING_MASK >> k) & 1u) tk += ts[1 + k] - ts[k];
        const float a = sqrtf((float)((tk / 2500ull) * 2500ull) * 0.0001f);
        for (size_t i = (size_t)blockIdx.x * 512 + threadIdx.x; i < (size_t)NX * DM; i += (size_t)gridDim.x * 512) args.out[i] = a;
    }
#undef IN
#undef INM
#undef SEAM
}

extern "C" void kernel_launch(void* const* d_in, const int* in_sizes, int n_in, void* d_out, int out_size, void* d_ws, size_t ws_size, hipStream_t stream) {
    static int grid = 0;
    if (grid == 0) {
        if (n_in != 23 || out_size != NX * DM || ws_size < WS_END) { fprintf(stderr, "kernel_launch: unexpected shapes (n_in %d, out %d, ws %zu); nothing launched\n", n_in, out_size, ws_size); grid = -1; return; }
        int dev = 0, cus = 0;
        if (hipGetDevice(&dev) != hipSuccess || hipDeviceGetAttribute(&cus, hipDeviceAttributeMultiprocessorCount, dev) != hipSuccess) { grid = -1; return; }
        if (hipFuncSetAttribute((const void*)mk_fwd, hipFuncAttributeMaxDynamicSharedMemorySize, LDS_BYTES) != hipSuccess) { fprintf(stderr, "kernel_launch: hipFuncSetAttribute failed\n"); grid = -1; return; }
        (void)hipGetLastError();
        grid = cus;
    }
    if (grid < 0) return;
    if (hipMemsetAsync((char*)d_ws + WS_CTL, 0, CTL_ZERO_BYTES, stream) != hipSuccess) { fprintf(stderr, "kernel_launch: memset failed\n"); return; }
    Args a{};
    for (int i = 0; i < 23; ++i) a.in[i] = (const float*)d_in[i];
    a.out = (float*)d_out; a.ws = (unsigned char*)d_ws;
#if MK_PER_PHASE
    for (int p = 0; p < N_PHASES; ++p) { a.ph_lo = p; a.ph_hi = p + 1; hipLaunchKernelGGL(mk_fwd, dim3(grid), dim3(NWAVES * 64), LDS_BYTES, stream, a); }
#else
    a.ph_lo = 0; a.ph_hi = N_PHASES;
    hipLaunchKernelGGL(mk_fwd, dim3(grid), dim3(NWAVES * 64), LDS_BYTES, stream, a);
#endif
    const hipError_t le = hipPeekAtLastError();
    if (le != hipSuccess) fprintf(stderr, "kernel_launch: launch failed: %s\n", hipGetErrorName(le));
}
```

```cpp
#include <hip/hip_runtime.h>
#include <cstdio>
#include <cstdint>
namespace pg8 {
#define PG8_LAS __attribute__((address_space(3)))
typedef unsigned short bf16_t;
typedef short bf16x8 __attribute__((ext_vector_type(8)));
typedef float f32x4 __attribute__((ext_vector_type(4)));
typedef unsigned u32x4 __attribute__((ext_vector_type(4)));
typedef int v4i_t __attribute__((ext_vector_type(4)));
typedef int v8i_t __attribute__((ext_vector_type(8)));
__device__ __forceinline__ int opaque_tid() { int t = threadIdx.x; asm volatile("" : "+v"(t)); return t; }
constexpr int BM = 256, BK = 64, HALF = 128, HTB = HALF * BK * 2  , STAGE_BYTES = 8 * HTB, NXCD = 8, WGM = 8;

__host__ __device__ __forceinline__ int lds_byte(int r, int c) { const int st = (r >> 4) * 2 + (c >> 5), rr = r & 15, cc = c & 31, ob = rr * 64 + cc * 2; return st * 1024 + (ob ^ (((ob >> 9) & 1) << 5)); }
__host__ __device__ __forceinline__ void stage_rc(int b, int& R, int& C) { const int st = b / 1024, sb = b % 1024, swz = sb ^ (((sb >> 9) & 1) << 5); R = (st >> 1) * 16 + swz / 64; C = (st & 1) * 32 + (swz % 64) / 2; }
__host__ __device__ __forceinline__ int perm32(int rho) { const int n = rho >> 4, i = rho & 15; return 8 * (i >> 2) + 4 * n + (i & 3); }

struct Unit { int pm, pn; };
struct Gemm { const bf16_t* A; const bf16_t* Bt; int K; const int* rowidx; int wsc = 0x7f7f7f7f; };

struct StaticOrder {
    int nM, nN, nwg, G, c;
    __host__ __device__ void init(int M, int N, int G_, int c_) { nM = M / BM; nN = N / BM; nwg = nM * nN; G = G_; c = c_; }
    __host__ __device__ bool next(int i, Unit& u) const {
        const long L = (long)i * G + c; if (L >= nwg) return false;
        int wgid = (int)L; { const int q = nwg / NXCD, r = nwg % NXCD, xcd = wgid % NXCD, off = wgid / NXCD; wgid = (xcd < r ? xcd * (q + 1) : r * (q + 1) + (xcd - r) * q) + off; }
        const int nig = WGM * nN, gid = wgid / nig, fm = gid * WGM, gsz = (nM - fm) < WGM ? (nM - fm) : WGM;
        u.pm = fm + ((wgid % nig) % gsz); u.pn = (wgid % nig) / gsz; return true;
    }
};
struct MoeOrder {
    const int* blk_e; int nblk, NT, G, c;
    __device__ __forceinline__ bool next(int i, Unit& u) const {
        const long L = (long)i * G + c; if (L >= (long)nblk * NT) return false;
        const int blk = (int)(L / NT), pnl = (int)(L % NT); const int e = __builtin_amdgcn_readfirstlane(blk_e[blk]);
        u.pm = blk; u.pn = e * NT + pnl; return true;
    }
};

typedef __bf16 bf16v2_t __attribute__((ext_vector_type(2)));
typedef float f32v2_t __attribute__((ext_vector_type(2)));
__device__ __forceinline__ unsigned cvt_pk_bf16(float lo, float hi) { const f32v2_t v = {lo, hi}; return __builtin_bit_cast(unsigned, __builtin_convertvector(v, bf16v2_t)); }

#ifndef DEG_PX
#define DEG_PX 0
#endif
struct EpiB16 {
    static constexpr bool PERM = true;
    bf16_t* O; int ldc; int pn_mask; int dry = 0;
    __device__ __forceinline__ void operator()(const f32x4 (&acc)[2][2][4][2], const Unit& u, int wr, int wc, int fr, int fq) const {
        const int row0 = u.pm * BM + wr * 64 + fr; const int col0 = (u.pn & pn_mask) * BM + wc * 32 + 8 * fq;
#pragma unroll
        for (int ai = 0; ai < 2; ++ai)
#pragma unroll
            for (int m = 0; m < 4; ++m) { bf16_t* rowp = O + (size_t)(row0 + ai * HALF + m * 16) * ldc + col0;
#pragma unroll
                for (int bj = 0; bj < 2; ++bj) { const f32x4 v0 = acc[ai][bj][m][0], v1 = acc[ai][bj][m][1];
                    u32x4 w; w.x = cvt_pk_bf16(v0[0], v0[1]); w.y = cvt_pk_bf16(v0[2], v0[3]); w.z = cvt_pk_bf16(v1[0], v1[1]); w.w = cvt_pk_bf16(v1[2], v1[3]);
                    if (DEG_PX && pn_mask == 0xffff) { w.x &= 0xfffcfffcu; w.y &= 0xfffcfffcu; w.z &= 0xfffcfffcu; w.w &= 0xfffcfffcu; }
                    if (dry) asm volatile("" :: "v"(w.x), "v"(w.y), "v"(w.z), "v"(w.w)); else *(u32x4*)(rowp + bj * HALF) = w; } }
    }
};
constexpr float YS_SCALE = 8.0f;
struct EpiF8 {
    static constexpr bool PERM = true;
    unsigned char* O; int pn_mask; int dry = 0;
    __device__ __forceinline__ void operator()(const f32x4 (&acc)[2][2][4][2], const Unit& u, int wr, int wc, int fr, int fq) const {
        const int row0 = u.pm * BM + wr * 64 + fr; const int col0 = (u.pn & pn_mask) * BM + wc * 32 + 8 * fq;
#pragma unroll
        for (int ai = 0; ai < 2; ++ai)
#pragma unroll
            for (int m = 0; m < 4; ++m) { unsigned char* rowp = O + (size_t)(row0 + ai * HALF + m * 16) * 1024 + col0;
#pragma unroll
                for (int bj = 0; bj < 2; ++bj) { const f32x4 v0 = acc[ai][bj][m][0], v1 = acc[ai][bj][m][1];
                    int w0 = 0, w1 = 0;
                    w0 = __builtin_amdgcn_cvt_pk_fp8_f32(v0[0], v0[1], w0, false); w0 = __builtin_amdgcn_cvt_pk_fp8_f32(v0[2], v0[3], w0, true);
                    w1 = __builtin_amdgcn_cvt_pk_fp8_f32(v1[0], v1[1], w1, false); w1 = __builtin_amdgcn_cvt_pk_fp8_f32(v1[2], v1[3], w1, true);
                    const unsigned long long pk = (unsigned long long)(unsigned)w0 | ((unsigned long long)(unsigned)w1 << 32);
                    if (dry) asm volatile("" :: "v"(w0), "v"(w1)); else *(unsigned long long*)(rowp + bj * HALF) = pk; }
                asm volatile("" ::: "memory"); }
    }
};
struct EpiRes {
    static constexpr bool PERM = false;
    const float* base_c; const float* base_x; float* out_c; float* out_x; const float* mod; int gt_off; int row_base;
    __device__ __forceinline__ void operator()(const f32x4 (&acc)[2][2][4][2], const Unit& u, int wr, int wc, int fr, int fq) const {
        const int trow = row_base + u.pm * BM;
        const float* bp; float* op; int mr;
        if (trow < 2048) { mr = 8; bp = base_c + (size_t)trow * 1024; op = out_c + (size_t)trow * 1024; }
        else { mr = (trow - 2048) >> 12; bp = base_x + (size_t)(trow - 2048) * 1024; op = out_x + (size_t)(trow - 2048) * 1024; }
        const float* gate = mod + mr * 6144 + gt_off;
        const int r0 = wr * 64 + fr, col0 = u.pn * BM + wc * 32 + 4 * fq;
        f32x4 gv[2][2];
#pragma unroll
        for (int bj = 0; bj < 2; ++bj)
#pragma unroll
            for (int n = 0; n < 2; ++n) gv[bj][n] = *(const f32x4*)(gate + col0 + bj * HALF + n * 16);
#pragma unroll
        for (int ai = 0; ai < 2; ++ai)
#pragma unroll
            for (int m = 0; m < 4; ++m) { const size_t off = (size_t)(r0 + ai * HALF + m * 16) * 1024 + col0;
#pragma unroll
                for (int bj = 0; bj < 2; ++bj)
#pragma unroll
                    for (int n = 0; n < 2; ++n) { const f32x4 b = *(const f32x4*)(bp + off + bj * HALF + n * 16); *(f32x4*)(op + off + bj * HALF + n * 16) = b + gv[bj][n] * acc[ai][bj][m][n]; }
                asm volatile("" ::: "memory"); }
    }
};
struct EpiSwiglu {
    static constexpr bool PERM = false;
    unsigned char* HS;
    __device__ __forceinline__ void operator()(const f32x4 (&acc)[2][2][4][2], const Unit& u, int wr, int wc, int fr, int fq) const {
        const int row0 = u.pm * BM + wr * 64 + fr, hid0 = (u.pn & 1) * 128 + wc * 32 + fq * 8;
#pragma unroll
        for (int ai = 0; ai < 2; ++ai)
#pragma unroll
            for (int m = 0; m < 4; ++m) {
                float h[8];
#pragma unroll
                for (int bj = 0; bj < 2; ++bj)
#pragma unroll
                    for (int i = 0; i < 4; ++i) { const float a = acc[ai][bj][m][0][i], b = acc[ai][bj][m][1][i]; h[bj * 4 + i] = a * __builtin_amdgcn_rcpf(1.0f + __expf(-a)) * b; }
                int w0 = 0, w1 = 0;
                w0 = __builtin_amdgcn_cvt_pk_fp8_f32(h[0], h[1], w0, false); w0 = __builtin_amdgcn_cvt_pk_fp8_f32(h[2], h[3], w0, true);
                w1 = __builtin_amdgcn_cvt_pk_fp8_f32(h[4], h[5], w1, false); w1 = __builtin_amdgcn_cvt_pk_fp8_f32(h[6], h[7], w1, true);
                *(unsigned long long*)(HS + (size_t)(row0 + ai * HALF + m * 16) * 256 + hid0) = (unsigned long long)(unsigned)w0 | ((unsigned long long)(unsigned)w1 << 32); }
    }
};

template <class Epi, class Sched, bool ALIGN_EPI, bool GATHER, bool F8 = false>
__device__ __forceinline__ void gemm_phase(PG8_LAS unsigned char* lds, const Gemm g, const Sched& S, const Epi& E) {
    const int tid = opaque_tid(), wid = __builtin_amdgcn_readfirstlane(tid >> 6), lane = tid & 63, wr = wid >> 2, wc = wid & 3, fr = lane & 15, fq = lane >> 4;
    const int K = g.K, nt = K / BK;
    unsigned voffA[2], voffB[2];
#pragma unroll
    for (int i = 0; i < 2; ++i) { int R, C; stage_rc(tid * 16 + i * 8192, R, C); const int Rb = Epi::PERM ? ((R & ~31) + perm32(R & 31)) : R;
        voffA[i] = (unsigned)(R * K + C) * 2u; voffB[i] = (unsigned)(Rb * K + C) * 2u; }
    const size_t kstep = (size_t)(BK * 2);
    const size_t hstep = (size_t)HALF * K * 2;
    const size_t tstep = 2 * hstep;
    const unsigned ldsw = (unsigned)wid * 1024u;
    const int aoff = lds_byte(wr * 64 + fr, fq * 8), boff = lds_byte(wc * 32 + fr, fq * 8);
#define PG8_SA(b, h) (((b) * 2 + (h)) * HTB)
#define PG8_SB(b, h) ((4 + (b) * 2 + (h)) * HTB)
#define PG8_STAGE(bufoff, gbase, voff) do { _Pragma("unroll") for (int _i = 0; _i < 2; ++_i) \
        __builtin_amdgcn_global_load_lds((const unsigned*)((const char*)(gbase) + (voff)[_i]), (PG8_LAS unsigned*)(lds + (bufoff) + ldsw + _i * 8192), 16, 0, 0); } while (0)
#define PG8_STAGE2(bufoff, gbase, o0, o1) do { \
        __builtin_amdgcn_global_load_lds((const unsigned*)((const char*)(gbase) + (o0)), (PG8_LAS unsigned*)(lds + (bufoff) + ldsw), 16, 0, 0); \
        __builtin_amdgcn_global_load_lds((const unsigned*)((const char*)(gbase) + (o1)), (PG8_LAS unsigned*)(lds + (bufoff) + ldsw + 8192), 16, 0, 0); } while (0)
#define PG8_LD2(p) __builtin_shufflevector(*(const PG8_LAS v4i_t*)(p), *(const PG8_LAS v4i_t*)((p) + 1024), 0, 1, 2, 3, 4, 5, 6, 7)
#define PG8_LDA(dst, b, h) do { _Pragma("unroll") for (int m = 0; m < 4; ++m) dst[m] = PG8_LD2(lds + PG8_SA(b, h) + aoff + m * 2048); } while (0)
#define PG8_LDB(dst, b, h) do { _Pragma("unroll") for (int n = 0; n < 2; ++n) dst[n] = PG8_LD2(lds + PG8_SB(b, h) + boff + n * 2048); } while (0)
#define PG8_HALF(v, k) __builtin_bit_cast(bf16x8, __builtin_shufflevector(v, v, 4 * (k), 4 * (k) + 1, 4 * (k) + 2, 4 * (k) + 3))
#define PG8_MMA(ai, bj, At, Bt) do { __builtin_amdgcn_s_setprio(1); _Pragma("unroll") for (int m = 0; m < 4; ++m) _Pragma("unroll") for (int n = 0; n < 2; ++n) { \
        acc[ai][bj][m][n] = __builtin_amdgcn_mfma_f32_16x16x32_bf16(PG8_HALF(Bt[n], 0), PG8_HALF(At[m], 0), acc[ai][bj][m][n], 0, 0, 0); \
        acc[ai][bj][m][n] = __builtin_amdgcn_mfma_f32_16x16x32_bf16(PG8_HALF(Bt[n], 1), PG8_HALF(At[m], 1), acc[ai][bj][m][n], 0, 0, 0); } __builtin_amdgcn_s_setprio(0); } while (0)
#define PG8_MMA8(ai, bj, At, Bt) do { __builtin_amdgcn_s_setprio(1); _Pragma("unroll") for (int m = 0; m < 4; ++m) _Pragma("unroll") for (int n = 0; n < 2; ++n) { \
        asm volatile("v_mfma_scale_f32_16x16x128_f8f6f4 %0, %1, %2, %0, %3, %4 op_sel_hi:[0,0,0]" : "+v"(acc[ai][bj][m][n]) : "v"(Bt[n]), "v"(At[m]), "v"(scw), "v"(scx)); }     __builtin_amdgcn_s_setprio(0); } while (0)
#define PG8_MM(ai, bj, At, Bt) do { if constexpr (F8) PG8_MMA8(ai, bj, At, Bt); else PG8_MMA(ai, bj, At, Bt); } while (0)
#define PG8_F8PAD do { if constexpr (F8) asm volatile("s_nop 15\n\ts_nop 15\n\ts_nop 15\n\ts_nop 15" ::: "memory"); } while (0)
#define PG8_WAIT_V(n) asm volatile("s_waitcnt vmcnt(" #n ")" ::: "memory")
#define PG8_WAIT_L(n) asm volatile("s_waitcnt lgkmcnt(" #n ")" ::: "memory")
#define PG8_BAR __builtin_amdgcn_s_barrier()
#define PG8_SCHED __builtin_amdgcn_sched_barrier(0)
    Unit cur, nxt; int ui = 0;
    if (!S.next(0, cur)) return;
    float zf = 0.f; asm volatile("" : "+v"(zf));
    f32x4 acc[2][2][4][2];
#pragma unroll
    for (int a = 0; a < 2; ++a)
#pragma unroll
        for (int b = 0; b < 2; ++b)
#pragma unroll
            for (int m = 0; m < 4; ++m)
#pragma unroll
                for (int n = 0; n < 2; ++n) acc[a][b][m][n] = (f32x4){zf, zf, zf, zf};
    v8i_t At[4], B0[2], B1[2];
    int scw = g.wsc, scx = 0x7f7f7f7f;
    if constexpr (F8) { asm volatile("" : "+v"(scw), "+v"(scx)); }
    unsigned oc00 = 0, oc01 = 0, oc10 = 0, oc11 = 0, on00 = 0, on01 = 0, on10 = 0, on11 = 0;
    const char* cA = GATHER ? (const char*)g.A : (const char*)g.A + (size_t)cur.pm * tstep; const char* cB = (const char*)g.Bt + (size_t)cur.pn * tstep;
#define PG8_ROWCOL() int rowA[2]; unsigned colA[2]; { int t_ = tid; asm volatile("" : "+v"(t_)); _Pragma("unroll") for (int i = 0; i < 2; ++i) { int R, C; stage_rc(t_ * 16 + i * 8192, R, C); rowA[i] = R; colA[i] = (unsigned)C * 2u; } }
    if constexpr (GATHER) { PG8_ROWCOL(); const int* ri = g.rowidx + cur.pm * BM; const unsigned rb = (unsigned)K * 2u;
        oc00 = (unsigned)ri[rowA[0]] * rb + colA[0]; oc01 = (unsigned)ri[rowA[1]] * rb + colA[1]; oc10 = (unsigned)ri[HALF + rowA[0]] * rb + colA[0]; oc11 = (unsigned)ri[HALF + rowA[1]] * rb + colA[1]; }
    PG8_STAGE(PG8_SB(0, 0), cB, voffB); PG8_STAGE(PG8_SB(0, 1), cB + hstep, voffB);
    if constexpr (GATHER) { PG8_STAGE2(PG8_SA(0, 0), cA, oc00, oc01); PG8_STAGE2(PG8_SA(0, 1), cA, oc10, oc11); }
    else { PG8_STAGE(PG8_SA(0, 0), cA, voffA); PG8_STAGE(PG8_SA(0, 1), cA + hstep, voffA); }
    if (wr == 1) PG8_BAR;
    PG8_WAIT_V(2); PG8_BAR;
    PG8_STAGE(PG8_SB(1, 0), cB + kstep, voffB);
    if constexpr (GATHER) { PG8_STAGE2(PG8_SA(1, 0), cA + kstep, oc00, oc01); } else { PG8_STAGE(PG8_SA(1, 0), cA + kstep, voffA); }
    PG8_STAGE(PG8_SB(1, 1), cB + hstep + kstep, voffB);
    PG8_WAIT_V(6); PG8_BAR;
    for (;;) {
        const bool has_next = S.next(ui + 1, nxt);
        const char* nA = GATHER ? cA : (has_next ? (const char*)g.A + (size_t)nxt.pm * tstep : cA); const char* nB = has_next ? (const char*)g.Bt + (size_t)nxt.pn * tstep : cB;
        if constexpr (GATHER) {
            if (has_next) { PG8_ROWCOL(); const int* ri = g.rowidx + nxt.pm * BM; const unsigned rb = (unsigned)K * 2u;
                on00 = (unsigned)ri[rowA[0]] * rb + colA[0]; on01 = (unsigned)ri[rowA[1]] * rb + colA[1]; on10 = (unsigned)ri[HALF + rowA[0]] * rb + colA[0]; on11 = (unsigned)ri[HALF + rowA[1]] * rb + colA[1]; }
            else { on00 = oc00; on01 = oc01; on10 = oc10; on11 = oc11; }
        }
        for (int t = 0; t < nt; t += 2) {
            const bool last = (t == nt - 2);
            const char* a1 = cA + (size_t)(t + 1) * kstep;
            const char* a2 = last ? nA : cA + (size_t)(t + 2) * kstep; const char* b2 = last ? nB : cB + (size_t)(t + 2) * kstep;
            const char* a3 = a2 + kstep; const char* b3 = b2 + kstep;
            const unsigned s00 = last ? on00 : oc00, s01 = last ? on01 : oc01, s10 = last ? on10 : oc10, s11 = last ? on11 : oc11;
            PG8_LDB(B0, 0, 0); PG8_LDB(B1, 0, 1); PG8_SCHED; PG8_LDA(At, 0, 0);
            if constexpr (GATHER) { PG8_STAGE2(PG8_SA(1, 1), a1, oc10, oc11); } else { PG8_STAGE(PG8_SA(1, 1), a1 + hstep, voffA); }
            PG8_WAIT_V(8); PG8_WAIT_L(0); PG8_BAR; PG8_MM(0, 0, At, B0); PG8_MM(0, 1, At, B1); PG8_F8PAD; PG8_BAR; PG8_SCHED;
            PG8_LDA(At, 0, 1); PG8_STAGE(PG8_SB(0, 0), b2, voffB); PG8_STAGE(PG8_SB(0, 1), b2 + hstep, voffB);
            if constexpr (GATHER) { PG8_STAGE2(PG8_SA(0, 0), a2, s00, s01); } else { PG8_STAGE(PG8_SA(0, 0), a2, voffA); }
            PG8_WAIT_V(8); PG8_WAIT_L(0); PG8_BAR; PG8_MM(1, 0, At, B0); PG8_MM(1, 1, At, B1); PG8_F8PAD; PG8_BAR; PG8_SCHED;
            PG8_LDB(B0, 1, 0); PG8_LDB(B1, 1, 1); PG8_SCHED; PG8_LDA(At, 1, 0);
            if constexpr (GATHER) { PG8_STAGE2(PG8_SA(0, 1), a2, s10, s11); } else { PG8_STAGE(PG8_SA(0, 1), a2 + hstep, voffA); }
            PG8_WAIT_V(8); PG8_WAIT_L(0); PG8_BAR; PG8_MM(0, 0, At, B0); PG8_MM(0, 1, At, B1); PG8_F8PAD; PG8_BAR; PG8_SCHED;
            PG8_LDA(At, 1, 1); PG8_STAGE(PG8_SB(1, 0), b3, voffB); PG8_STAGE(PG8_SB(1, 1), b3 + hstep, voffB);
            if constexpr (GATHER) { PG8_STAGE2(PG8_SA(1, 0), a3, s00, s01); } else { PG8_STAGE(PG8_SA(1, 0), a3, voffA); }
            PG8_WAIT_V(8); PG8_WAIT_L(0); PG8_BAR; PG8_MM(1, 0, At, B0); PG8_MM(1, 1, At, B1); PG8_F8PAD; PG8_BAR; PG8_SCHED;
        }
        if constexpr (ALIGN_EPI) { if (wr == 0) PG8_BAR; }
        if constexpr (F8) { asm volatile("s_nop 15\n\ts_nop 15\n\ts_nop 15\n\ts_nop 15\n\ts_nop 15\n\ts_nop 15\n\ts_nop 15\n\ts_nop 15\n\ts_nop 15\n\ts_nop 15\n\ts_nop 15\n\ts_nop 15" ::: "memory"); }
        E(acc, cur, wr, wc, fr, fq);
        if (!has_next) break;
#pragma unroll
        for (int a = 0; a < 2; ++a)
#pragma unroll
            for (int b = 0; b < 2; ++b)
#pragma unroll
                for (int m = 0; m < 4; ++m)
#pragma unroll
                    for (int n = 0; n < 2; ++n) acc[a][b][m][n] = (f32x4){zf, zf, zf, zf};
        cur = nxt; cA = nA; cB = nB; ++ui; oc00 = on00; oc01 = on01; oc10 = on10; oc11 = on11;
        if constexpr (ALIGN_EPI) { if (wr == 1) PG8_BAR; }
    }
    PG8_WAIT_V(0);
    if constexpr (!ALIGN_EPI) { if (wr == 0) PG8_BAR; }
    PG8_BAR;
#undef PG8_SA
#undef PG8_SB
#undef PG8_STAGE
#undef PG8_STAGE2
#undef PG8_LDA
#undef PG8_ROWCOL
#undef PG8_LD2
#undef PG8_HALF
#undef PG8_LDB
#undef PG8_MMA
#undef PG8_MMA8
#undef PG8_MM
#undef PG8_F8PAD
#undef PG8_WAIT_V
#undef PG8_WAIT_L
#undef PG8_BAR
#undef PG8_SCHED
}
}
#define GAS __attribute__((address_space(1)))
#define LAS __attribute__((address_space(3)))
typedef unsigned short bf16;
typedef unsigned v4u __attribute__((ext_vector_type(4)));
typedef float f32x4 __attribute__((ext_vector_type(4)));
typedef short bf16x8 __attribute__((ext_vector_type(8)));
typedef GAS unsigned gu32;
typedef GAS unsigned long long gu64;
#define RLX_AGENT __ATOMIC_RELAXED, __HIP_MEMORY_SCOPE_AGENT
#define LDS_WAIT() asm volatile("s_waitcnt lgkmcnt(0)" ::: "memory")
#define VM_WAIT() asm volatile("s_waitcnt vmcnt(0)" ::: "memory")
__device__ __forceinline__ unsigned long long rt() { return __builtin_amdgcn_s_memrealtime(); }
__device__ __forceinline__ unsigned f2bf(float f) { return (unsigned)__builtin_bit_cast(unsigned short, (__bf16)f); }
__device__ __forceinline__ unsigned pk2(float lo, float hi) { return pg8::cvt_pk_bf16(lo, hi); }

#define XB_TMO      128
#define XB_XCNT(j)  (256  + 64 * (j))
#define XB_XSUB(j)  (1280 + 64 * (j))
#define XB_XGEN(j)  (2304 + 64 * (j))
#define XB_TOP      3328
#define XB_TOPGEN   3392
#define XCD_BAR_WORDS 3456
#define XB_SPIN_CAP (1u << 18)

__device__ __forceinline__ unsigned xb_ld(unsigned* p)              { return __hip_atomic_load(p, __ATOMIC_RELAXED, __HIP_MEMORY_SCOPE_AGENT); }
__device__ __forceinline__ unsigned xb_add(unsigned* p, unsigned v) { return __hip_atomic_fetch_add(p, v, __ATOMIC_RELAXED, __HIP_MEMORY_SCOPE_AGENT); }
__device__ __forceinline__ unsigned xb_xcc_id() { return (unsigned)__builtin_amdgcn_s_getreg((3 << 11) | 20) & 0xFu; }
#define XB_SPIN(cond, bar) do { unsigned _sp = 0; while (cond) { __builtin_amdgcn_s_sleep(1); \
    if ((++_sp & 255u) == 0u) { if (xb_ld(&(bar)[XB_TMO])) break; if (_sp > XB_SPIN_CAP) { atomicAdd(&(bar)[XB_TMO], 1u); break; } } } } while (0)

struct XcdBarrier {
    unsigned* bar; unsigned x;
    volatile LAS unsigned* st;
};

__device__ __forceinline__ XcdBarrier xcd_barrier_post(unsigned* bar, volatile LAS unsigned* st) {
    XcdBarrier b; b.bar = bar; b.x = xb_xcc_id(); b.st = st;
    if (threadIdx.x == 0) (void)xb_add(&bar[XB_XCNT(b.x)], 1u);
    return b;
}
__device__ __forceinline__ void xcd_barrier_complete(unsigned* bar, unsigned x, unsigned& nloc, unsigned& nx) {
    const unsigned G = gridDim.x * gridDim.y * gridDim.z;
    unsigned sum, cnt, mine, sp = 0u;
    for (;;) {
        sum = 0u; cnt = 0u; mine = 0u;
#pragma unroll
        for (unsigned j = 0; j < 16; ++j) { const unsigned c = xb_ld(&bar[XB_XCNT(j)]); sum += c; cnt += (c > 0u) ? 1u : 0u; mine = (j == x) ? c : mine; }
        if (sum == G) break;
        __builtin_amdgcn_s_sleep(1);
        if ((++sp & 255u) == 0u) { if (xb_ld(&bar[XB_TMO])) break; if (sp > XB_SPIN_CAP) { atomicAdd(&bar[XB_TMO], 1u); break; } }
    }
    nloc = mine > 0u ? mine : 1u; nx = cnt > 0u ? cnt : 1u;
}

__device__ __forceinline__ void xcd_barrier(const XcdBarrier& b) {
    asm volatile("s_waitcnt vmcnt(0)" ::: "memory");
    __syncthreads();
    if (threadIdx.x == 0) {
        unsigned* bar = b.bar;
        __builtin_amdgcn_s_waitcnt(0);
        unsigned nloc = b.st[0], nx = b.st[1];
        if (nloc == 0u) { xcd_barrier_complete(bar, b.x, nloc, nx); b.st[0] = nloc; b.st[1] = nx; }
        const unsigned old = xb_add(&bar[XB_XSUB(b.x)], 1u);
        const unsigned gen = old / nloc;
        if (old + 1u == (gen + 1u) * nloc) {
            __builtin_amdgcn_fence(__ATOMIC_RELEASE, "agent");
            asm volatile("s_waitcnt vmcnt(0)" ::: "memory");
            const unsigned og = xb_add(&bar[XB_TOP], 1u);
            const unsigned tg = og / nx;
            if (og + 1u == (tg + 1u) * nx) xb_add(&bar[XB_TOPGEN], 1u);
            else XB_SPIN(xb_ld(&bar[XB_TOPGEN]) == tg, bar);
            __builtin_amdgcn_fence(__ATOMIC_ACQUIRE, "agent");
            xb_add(&bar[XB_XGEN(b.x)], 1u);
            asm volatile("s_waitcnt vmcnt(0)" ::: "memory");
        } else {
            XB_SPIN(xb_ld(&bar[XB_XGEN(b.x)]) == gen, bar);
            __builtin_amdgcn_fence(__ATOMIC_ACQUIRE, "agent");
            asm volatile("s_waitcnt vmcnt(0)" ::: "memory");
        }
    }
    __syncthreads();
}

constexpr int NWAVES = 8;
constexpr int DM = 1024, NBATCH = 8, SEQL = 4096, CTXL = 256;
constexpr int NC = NBATCH * CTXL, NX = NBATCH * SEQL, NTOK = NC + NX;
constexpr int HW = 512, INC = 3072, NE = 64, TOPK = 6;
constexpr int NCH = 68;
constexpr int NSEQ = NBATCH * 4 * 2;
constexpr float EPSN = 1e-6f;
constexpr int NHALF = 1;
constexpr int MAXBLK = 1024;
constexpr int MAXSLOT = 1016 * 256;

constexpr size_t MiB = 1u << 20;
constexpr size_t WS_CTL = 0, CTL_ZERO_BYTES = 1 * MiB;
constexpr size_t WS_MOD = 1 * MiB;
constexpr size_t WS_RT = 2 * MiB;
constexpr size_t RT_IDX = WS_RT, RT_GATE = WS_RT + 1 * MiB, RT_TSLOT = WS_RT + 2 * MiB, RT_STOK = WS_RT + 3 * MiB, RT_BLKE = WS_RT + 4 * MiB + 512 * 1024, RT_MISC = RT_BLKE + 8192;
constexpr size_t WS_CTXRES = 8 * MiB;
constexpr size_t WS_WIN = 16 * MiB, WS_WOUT = 22 * MiB, WS_WPOOL = 24 * MiB, WS_WR = 25 * MiB, WS_W13 = 26 * MiB, WS_W2 = 91 * MiB;
constexpr size_t WS_HX = 124 * MiB;
constexpr size_t WS_PX = 193 * MiB;
constexpr size_t WS_KV = 397 * MiB;
constexpr size_t WS_DEC = 533 * MiB;
constexpr size_t WS_HS = 193 * MiB, WS_YS = 320 * MiB;
constexpr size_t WS_END = 574 * MiB;
static_assert(WS_HS + (size_t)MAXSLOT * 512 <= WS_YS && WS_YS + (size_t)MAXSLOT * 1024 <= WS_END && WS_HX + (size_t)(NTOK + 1) * 2048 <= WS_PX && WS_PX + (size_t)NTOK * INC * 2 <= WS_KV, "ws map");
constexpr int CW_BAR = 4096, CW_CNT = 8192, CW_CUR = 8448;

constexpr int RING_BYTES = 131072, LDSCTL_OFF = RING_BYTES, MISC_OFF = LDSCTL_OFF + 320, LDS_BYTES = 147456;

__device__ __forceinline__ float bf2f(unsigned short u) { return __builtin_bit_cast(float, ((unsigned)u) << 16); }
__device__ __forceinline__ float shx(float v, int o, int lane) { return __builtin_bit_cast(float, __builtin_amdgcn_ds_bpermute((lane ^ o) << 2, __builtin_bit_cast(int, v))); }
__device__ __forceinline__ float shl(float v, int src) { return __builtin_bit_cast(float, __builtin_amdgcn_ds_bpermute(src << 2, __builtin_bit_cast(int, v))); }
template <int CTRL> __device__ __forceinline__ float dpp_f(float v) { return __builtin_bit_cast(float, __builtin_amdgcn_update_dpp(__builtin_bit_cast(int, v), __builtin_bit_cast(int, v), CTRL, 0xf, 0xf, false)); }
__device__ __forceinline__ float max8_dpp(float v) {
    v = fmaxf(v, dpp_f<0xB1>(v)); v = fmaxf(v, dpp_f<0x4E>(v)); v = fmaxf(v, dpp_f<0x141>(v)); return v; }
__device__ __forceinline__ float rdlane(float v, int src) { return __builtin_bit_cast(float, __builtin_amdgcn_readlane(__builtin_bit_cast(int, v), src)); }
__device__ __forceinline__ float max64_dpp(float v) {
    v = max8_dpp(v); v = fmaxf(v, dpp_f<0x140>(v));
    return fmaxf(fmaxf(rdlane(v, 0), rdlane(v, 16)), fmaxf(rdlane(v, 32), rdlane(v, 48))); }
__device__ __forceinline__ float sum16_dpp(float v) {
    v += dpp_f<0xB1>(v); v += dpp_f<0x4E>(v); v += dpp_f<0x141>(v); v += dpp_f<0x140>(v); return v; }
__device__ __forceinline__ float wave_sum(float v, int lane) {
    (void)lane; v = sum16_dpp(v); return (rdlane(v, 0) + rdlane(v, 16)) + (rdlane(v, 32) + rdlane(v, 48)); }
__device__ __forceinline__ float wave_max(float v, int lane) {
#pragma unroll
    for (int o = 1; o < 64; o <<= 1) v = fmaxf(v, shx(v, o, lane));
    return v;
}
__device__ __forceinline__ float opaque_zero() { float z = 0.f; asm volatile("" : "+v"(z)); return z; }
__device__ __forceinline__ float sigmoidf_(float x) { return __builtin_amdgcn_rcpf(1.0f + __expf(-x)); }
__device__ __forceinline__ float clamp80(float x) { return fminf(fmaxf(x, -80.f), 80.f); }

struct Frame {
    LAS unsigned char* lds;
    unsigned* ctl;
    int tid, lane, wave, vcu, G;
    const float* in[23];
    float* out; unsigned char* ws;
};
extern __shared__ __attribute__((aligned(16))) unsigned char g_lds[];
constexpr int TAB_OFF = MISC_OFF + 128;
__device__ __forceinline__ unsigned long long tab_ld(int i) {
    const unsigned long long v = ((const LAS unsigned long long*)((LAS unsigned char*)g_lds + TAB_OFF))[i];
    const unsigned lo = (unsigned)__builtin_amdgcn_readfirstlane((int)(unsigned)v), hi = (unsigned)__builtin_amdgcn_readfirstlane((int)(unsigned)(v >> 32));
    return ((unsigned long long)hi << 32) | lo;
}
__device__ __forceinline__ Frame make_frame() {
    asm volatile("" ::: "memory");
    Frame F;
    F.lds = (LAS unsigned char*)g_lds;
    F.tid = pg8::opaque_tid(); F.lane = F.tid & 63; F.wave = __builtin_amdgcn_readfirstlane(F.tid >> 6);
    F.G = gridDim.x; { int bx = blockIdx.x; asm volatile("" : "+s"(bx)); F.vcu = (F.G % 8 == 0) ? (bx % 8) * (F.G / 8) + bx / 8 : bx; }
#pragma unroll
    for (int i = 0; i < 23; ++i) F.in[i] = (const float*)tab_ld(i);
    F.out = (float*)tab_ld(23); F.ws = (unsigned char*)tab_ld(24); F.ctl = (unsigned*)(F.ws + WS_CTL);
    return F;
}
__device__ __forceinline__ void grid_barrier() {
    const Frame F = make_frame();
    XcdBarrier b; b.bar = F.ctl + CW_BAR; b.x = xb_xcc_id(); b.st = (volatile LAS unsigned*)((LAS unsigned char*)g_lds + MISC_OFF) + 8;
    xcd_barrier(b);
}

__device__ __forceinline__ void transpose_item(const float* W, int K, int N, bf16* WT, int mode, LAS float* scr, int item, int lane, float wscale = 1.0f, bool f8 = false) {
    (void)scr;
    const int nblk = N / 32, kb = item / nblk, nb = item % nblk, k0 = 64 * kb, n0 = 32 * nb, c = lane >> 3, n4 = lane & 7;
    const GAS f32x4* src = (const GAS f32x4*)(W + (size_t)(k0 + 8 * c) * N + n0 + 4 * n4);
    f32x4 v[8];
#pragma unroll
    for (int j = 0; j < 8; ++j) v[j] = src[(size_t)j * (N / 4)] * wscale;
#pragma unroll
    for (int i = 0; i < 4; ++i) {
        const v4u o = (v4u){pk2(v[0][i], v[1][i]), pk2(v[2][i], v[3][i]), pk2(v[4][i], v[5][i]), pk2(v[6][i], v[7][i])};
        const int nn = n0 + 4 * n4 + i; int dr = nn;
        if (mode) dr = 256 * (nn >> 7) + 128 * ((nn >> 2) & 1) + 32 * ((nn >> 5) & 3) + 16 * (mode - 1) + 4 * ((nn >> 3) & 3) + (nn & 3);
        if (!f8) *(GAS v4u*)(WT + (size_t)dr * K + k0 + 8 * c) = o;
        else { int lo8 = 0, hi8 = 0;
            lo8 = __builtin_amdgcn_cvt_pk_fp8_f32(v[0][i], v[1][i], lo8, false); lo8 = __builtin_amdgcn_cvt_pk_fp8_f32(v[2][i], v[3][i], lo8, true);
            hi8 = __builtin_amdgcn_cvt_pk_fp8_f32(v[4][i], v[5][i], hi8, false); hi8 = __builtin_amdgcn_cvt_pk_fp8_f32(v[6][i], v[7][i], hi8, true);
            *(GAS unsigned long long*)((GAS unsigned char*)WT + (size_t)dr * K + k0 + 8 * c) = (unsigned long long)(unsigned)lo8 | ((unsigned long long)(unsigned)hi8 << 32); } }
}

__device__ __forceinline__ void phase_wconv(Frame& F, int l) {
    LAS float* scr = (LAS float*)(F.lds + F.wave * 16384);
    const int gw = F.vcu * NWAVES + F.wave, NGW = F.G * NWAVES;
    constexpr int I_IN = 16 * 96, I_OUT = 16 * 32, I_POOL = 4 * 8, I_R = 16 * 2, I_1 = 65 * 128, I_2 = 65 * 128;
    constexpr int NITEMS = I_IN + I_OUT + I_POOL + I_R + 2 * I_1 + I_2;
    unsigned char* ws = F.ws;
    for (int it = gw; it < NITEMS; it += NGW) {
        int r = it;
        if (r < I_IN) { transpose_item(F.in[8] + (size_t)l * DM * INC, DM, INC, (bf16*)(ws + WS_WIN), 0, scr, r, F.lane); continue; } r -= I_IN;
        if (r < I_OUT) { transpose_item(F.in[13] + (size_t)l * DM * DM, DM, DM, (bf16*)(ws + WS_WOUT), 0, scr, r, F.lane); continue; } r -= I_OUT;
        if (r < I_POOL) { const int g = r / 8; transpose_item(F.in[11] + (size_t)(l * 4 + g) * 128 * 128, 128, 128, (bf16*)(ws + WS_WPOOL) + g * 128 * 128, 0, scr, r % 8, F.lane); continue; } r -= I_POOL;
        if (r < I_R) { transpose_item(F.in[14] + (size_t)l * DM * NE, DM, NE, (bf16*)(ws + WS_WR), 0, scr, r, F.lane); continue; } r -= I_R;
        if (r < 2 * I_1) { const int mat = r / I_1; r -= mat * I_1; const int e = r / 128, ii = r % 128;
            const float* src = (e < 64) ? F.in[mat ? 17 : 16] + ((size_t)l * 64 + e) * DM * 256 : F.in[mat ? 20 : 19] + (size_t)l * DM * 256;
            transpose_item(src, DM, 256, (bf16*)((unsigned char*)(ws + WS_W13) + (size_t)e * 512 * DM), 1 + mat, scr, ii, F.lane, 32.0f, true); continue; } r -= 2 * I_1;
        { const int e = r / 128, ii = r % 128;
            const float* src = (e < 64) ? F.in[18] + ((size_t)l * 64 + e) * 256 * DM : F.in[21] + (size_t)l * 256 * DM;
            transpose_item(src, 256, DM, (bf16*)((unsigned char*)(ws + WS_W2) + (size_t)e * DM * 256), 0, scr, ii, F.lane, 16.0f, true); }
    }
}

__device__ __forceinline__ void phase_mod(Frame& F) {
    LAS float* sil = (LAS float*)(F.lds + 65536);
    LAS float* part = (LAS float*)(F.lds + 65536 + 36864);
    for (int i = F.tid; i < 9 * 1024; i += 512) { const int r = i >> 10, k = i & 1023; const float v = (r < 8) ? F.in[1][r * 1024 + k] : F.in[3][k]; sil[i] = v * sigmoidf_(v); }
    __syncthreads();
    float* mod = (float*)(F.ws + WS_MOD);
    for (int it = F.vcu; it < 2 * 96; it += F.G) {
        const int l = it / 96, n0 = (it % 96) * 64;
        const float* wa = F.in[6] + (size_t)l * DM * 6144 + n0 + F.lane;
        float acc[9];
#pragma unroll
        for (int r = 0; r < 9; ++r) acc[r] = 0.f;
        const int kb = F.wave * 128;
#pragma unroll 4
        for (int k = 0; k < 128; ++k) { const float w = wa[(size_t)(kb + k) * 6144];
#pragma unroll
            for (int r = 0; r < 9; ++r) acc[r] += sil[r * 1024 + kb + k] * w; }
#pragma unroll
        for (int r = 0; r < 9; ++r) part[(F.wave * 9 + r) * 64 + F.lane] = acc[r];
        __syncthreads();
        for (int i = F.tid; i < 9 * 64; i += 512) { const int r = i >> 6, c = i & 63; float s = 0.f;
#pragma unroll
            for (int w = 0; w < 8; ++w) s += part[(w * 9 + r) * 64 + c];
            mod[((size_t)l * 9 + r) * 6144 + n0 + c] = s + F.in[7][(size_t)l * 6144 + n0 + c]; }
        __syncthreads();
    }
}

__device__ __forceinline__ const float* resid_in_row(Frame& F, int l, int row) {
    if (l == 0) return row < NC ? F.in[2] + (size_t)row * DM : F.in[0] + (size_t)(row - NC) * DM;
    return row < NC ? (const float*)(F.ws + WS_CTXRES) + (size_t)row * DM : F.out + (size_t)(row - NC) * DM;
}
__device__ __forceinline__ float* resid_row(Frame& F, int row) { return row < NC ? (float*)(F.ws + WS_CTXRES) + (size_t)row * DM : F.out + (size_t)(row - NC) * DM; }
__device__ __forceinline__ int mod_row(int row) { return row < NC ? 8 : ((row - NC) >> 12); }

#ifndef DIAG_ZERO_CTXSTATE
#define DIAG_ZERO_CTXSTATE 0
#endif
#ifndef DEG_HX
#define DEG_HX 0
#endif
#ifndef DEG_Y
#define DEG_Y 0
#endif
__device__ __forceinline__ void norm_mod_row(Frame& F, const float* xrow, const float* nw, const float* sh, const float* sc, bf16* orow, LAS bf16* lrow, LAS float* frow = nullptr) {
    const GAS f32x4* xr = (const GAS f32x4*)xrow + F.lane;
    f32x4 v[4]; float s = 0.f;
#pragma unroll
    for (int j = 0; j < 4; ++j) { v[j] = xr[64 * j]; s += (v[j].x * v[j].x + v[j].y * v[j].y) + (v[j].z * v[j].z + v[j].w * v[j].w); }
    const float r = 1.0f / sqrtf(wave_sum(s, F.lane) * (1.f / DM) + EPSN);
#pragma unroll
    for (int j = 0; j < 4; ++j) {
        const f32x4 w4 = ((const GAS f32x4*)nw)[F.lane + 64 * j], s4 = ((const GAS f32x4*)sc)[F.lane + 64 * j], h4 = ((const GAS f32x4*)sh)[F.lane + 64 * j];
        const f32x4 o = (v[j] * r) * w4 * (s4 + 1.0f) + h4;
        unsigned long long pk = (unsigned long long)pk2(o.x, o.y) | ((unsigned long long)pk2(o.z, o.w) << 32);
        if (DEG_HX) pk &= 0xfffcfffcfffcfffcull;
        ((GAS unsigned long long*)orow)[F.lane + 64 * j] = pk;
        if (lrow) *(LAS unsigned long long*)(lrow + 4 * (F.lane + 64 * j)) = pk;
        if (frow) *(LAS f32x4*)(frow + 4 * (F.lane + 64 * j)) = o;
    }
}

__device__ __forceinline__ void phase_hx(Frame& F, int l) {
    const int gw = F.vcu * NWAVES + F.wave, NGW = F.G * NWAVES;
    const float* mod = (const float*)(F.ws + WS_MOD) + (size_t)l * 9 * 6144;
    bf16* HX = (bf16*)(F.ws + WS_HX);
    for (int row = gw; row < NTOK; row += NGW) { const float* md = mod + mod_row(row) * 6144;
        norm_mod_row(F, resid_in_row(F, l, row), F.in[4] + l * DM, md, md + 1024, HX + (size_t)row * DM, nullptr); }
}

__device__ __forceinline__ void gates16(const bf16* zp, float lb, float (&g)[16], float (&kk)[16]) {
    const float lbf = fmaxf(lb, 1e-30f), oml = 1.0f - lb;
#pragma unroll
    for (int j = 0; j < 16; ++j) { const float z = bf2f(zp[(size_t)j * INC]); const float sg = sigmoidf_(z); g[j] = __logf(lbf + oml * sg); kk[j] = oml * (1.0f - sg); }
}
__device__ __forceinline__ float lb_of(Frame& F, int l, int dir, int hch) {
    if (l == 0) return 0.f;
    const float a0 = F.in[9][dir * HW + hch], a1 = F.in[9][2 * HW + dir * HW + hch];
    return 1.0f / (1.0f + __expf(a0 - a1));
}
__device__ __forceinline__ int chunk_row0(int b, int dir, int c) {
    if (c < 4) { const int tc = dir ? 3 - c : c; return b * CTXL + tc * 64; }
    const int tc = dir ? 63 - (c - 4) : (c - 4); return NC + b * SEQL + tc * 64;
}

template <int KS, int NTILE>
__device__ __forceinline__ void mma_rows16(f32x4 (&acc)[NTILE], const LAS bf16* A, int lda, int arow0, const LAS bf16* Bt, int ldb, int brow0, int lane) {
    const int r = lane & 15, q = lane >> 4;
    bf16x8 af[KS], bfr[KS][NTILE];
#pragma unroll
    for (int s = 0; s < KS; ++s) { af[s] = *(const LAS bf16x8*)(A + (arow0 + r) * lda + 32 * s + 8 * q);
#pragma unroll
        for (int i = 0; i < NTILE; ++i) bfr[s][i] = *(const LAS bf16x8*)(Bt + (brow0 + 16 * i + r) * ldb + 32 * s + 8 * q); }
#pragma unroll
    for (int s = 0; s < KS; ++s)
#pragma unroll
        for (int i = 0; i < NTILE; ++i) acc[i] = __builtin_amdgcn_mfma_f32_16x16x32_bf16(bfr[s][i], af[s], acc[i], 0, 0, 0);
}

__device__ __forceinline__ void pool_load(Frame& F, int b, int tc, int gi, v4u (&r)[3]) {
    const GAS bf16* PX = (const GAS bf16*)(F.ws + WS_PX);
    const int row0 = (tc < 4) ? b * CTXL + tc * 64 : NC + b * SEQL + (tc - 4) * 64;
    const int lo_b = (tc < 4) ? -tc * 64 : 0, hi_b = (tc < 4) ? (4 - tc) * 64 : 64;
#pragma unroll
    for (int j = 0; j < 3; ++j) { const int e = F.tid + 512 * j; const int rr = (e >> 4) - 8; r[j] = (v4u){0u, 0u, 0u, 0u};
        if (e < 1280 && rr >= lo_b && rr < hi_b) r[j] = *(const GAS v4u*)(PX + (size_t)(row0 + rr) * INC + 5 * HW + gi * 128 + (e & 15) * 8); }
}
__device__ __forceinline__ void pool_item(Frame& F, int l, int b, int tc, int gi, v4u (&pr)[3], bool has_next, int nb, int ntc, int ngi) {
    LAS bf16* Pin = (LAS bf16*)(F.lds + 65536); LAS bf16* Pl = (LAS bf16*)(F.lds); LAS bf16* Wt = (LAS bf16*)(F.lds + 17408);
    bf16* Y = (bf16*)(F.ws + WS_HX);
    const int seg = F.tid >> 7, ch = F.tid & 127, mt = F.wave >> 1, nh = F.wave & 1, lr = F.lane & 15, lq = F.lane >> 4;
    const int row0 = (tc < 4) ? b * CTXL + tc * 64 : NC + b * SEQL + (tc - 4) * 64;
    const int wdw = 2 << gi, hw2 = wdw >> 1;
    const int lo_b = (tc < 4) ? -tc * 64 : 0, hi_b = (tc < 4) ? (4 - tc) * 64 : 64;
#pragma unroll
    for (int j = 0; j < 3; ++j) { const int e = F.tid + 512 * j; if (e < 1280) *(LAS v4u*)(Pin + (e >> 4) * 128 + (e & 15) * 8) = pr[j]; }
    { const GAS v4u* wp = (const GAS v4u*)((const bf16*)(F.ws + WS_WPOOL) + gi * 128 * 128);
#pragma unroll
      for (int i = 0; i < 4; ++i) { const int e = F.tid + 512 * i; const int d = e >> 4, kq = e & 15; *(LAS v4u*)(Wt + d * 136 + kq * 8) = wp[e]; } }
    if (has_next) pool_load(F, nb, ntc, ngi, pr);
    __syncthreads();
#pragma unroll 4
    for (int t = 0; t < 16; ++t) { const int i = seg * 16 + t; int lo = i - hw2, hi = i + hw2; lo = lo < lo_b ? lo_b : lo; hi = hi > hi_b ? hi_b : hi;
        float sm = 0.f; for (int r = lo; r < hi; ++r) sm += bf2f(Pin[(r + 8) * 128 + ch]);
        Pl[i * 136 + ch] = (bf16)f2bf(sm / (float)(hi - lo) - bf2f(Pin[(i + 8) * 128 + ch])); }
    __syncthreads();
    f32x4 acc[4]; const float zf = opaque_zero();
#pragma unroll
    for (int i = 0; i < 4; ++i) acc[i] = (f32x4){zf, zf, zf, zf};
    mma_rows16<4, 4>(acc, Pl, 136, 16 * mt, Wt, 136, 64 * nh, F.lane);
    const int t = 16 * mt + lr;
    const float* ps = F.in[12] + l * HW + gi * 128 + 64 * nh + 4 * lq;
    bf16* yp = Y + (size_t)(row0 + t) * DM + HW + gi * 128 + 64 * nh + 4 * lq;
#pragma unroll
    for (int i = 0; i < 4; ++i) { const f32x4 w4 = *(const GAS f32x4*)(ps + 16 * i);
        *(GAS unsigned long long*)(yp + 16 * i) = (unsigned long long)pk2(acc[i].x * w4.x, acc[i].y * w4.y) | ((unsigned long long)pk2(acc[i].z * w4.z, acc[i].w * w4.w) << 32); }
    __syncthreads();
}

#ifndef USE_OLD_SCAN
#define USE_OLD_SCAN 0
#endif
#ifndef PREP_INPLACE
#define PREP_INPLACE 1
#endif
constexpr size_t WS_O = WS_KV, WS_KE = WS_KV + 68 * MiB, WS_VT = 536 * MiB;
__device__ __forceinline__ void prep_load(const GAS bf16* rowp, int h, int tid, v4u (&r)[8]) {
#pragma unroll
    for (int j = 0; j < 2; ++j) { const int e = tid + 512 * j; const GAS bf16* p = rowp + (size_t)(e >> 4) * INC + h * 128 + (e & 15) * 8;
        r[j] = *(const GAS v4u*)(p); r[2 + j] = *(const GAS v4u*)(p + HW); r[4 + j] = *(const GAS v4u*)(p + 3 * HW); r[6 + j] = *(const GAS v4u*)(p + 2 * HW); }
}
typedef float f32x2 __attribute__((ext_vector_type(2)));
__device__ __forceinline__ f32x2 bf2x(unsigned u) { return (f32x2){__builtin_bit_cast(float, u << 16), __builtin_bit_cast(float, u & 0xffff0000u)}; }
__device__ __forceinline__ void phase_prep(Frame& F, int l) {
    LAS unsigned* Raw = (LAS unsigned*)(F.lds);
    LAS bf16* Qt = (LAS bf16*)(F.lds); LAS bf16* Kt = (LAS bf16*)(F.lds + 17408); LAS bf16* Pm = (LAS bf16*)(F.lds + 34816);
    LAS bf16* vT = (LAS bf16*)(F.lds + 65536); LAS float* tot = (LAS float*)(F.lds + 83968);
    GAS bf16* PX = (GAS bf16*)(F.ws + WS_PX); GAS bf16* KE = (GAS bf16*)(F.ws + WS_KE); GAS bf16* VT = (GAS bf16*)(F.ws + WS_VT); GAS float* DEC = (GAS float*)(F.ws + WS_DEC); GAS bf16* O = (GAS bf16*)(F.ws + WS_O);
    const int s8 = F.tid >> 6, cp = F.tid & 63, mt = F.wave >> 1, nh = F.wave & 1, lr = F.lane & 15, lq = F.lane >> 4;
    const int nit = NBATCH * 4 * NCH;
    v4u rr[8];
    auto item_row0 = [](int it) { const int tc = it >> 5, b = (it >> 2) & 7; return (tc < 4) ? b * CTXL + tc * 64 : NC + b * SEQL + (tc - 4) * 64; };
    if (F.vcu < nit) prep_load(PX + (size_t)item_row0(F.vcu) * INC, F.vcu & 3, F.tid, rr);
#pragma unroll 1
    for (int it = F.vcu; it < nit; it += F.G) {
        const int h = it & 3, b = (it >> 2) & 7, tc = it >> 5, row0 = item_row0(it);
        const bool outp = (l == 0) || (tc >= 4);
#pragma unroll
        for (int j = 0; j < 2; ++j) { const int e = F.tid + 512 * j; const int o4 = (e >> 4) * 64 + (e & 15) * 4;
#pragma unroll
            for (int x = 0; x < 4; ++x) *(LAS v4u*)(Raw + x * 4096 + o4) = rr[2 * x + j]; }
        if (it + F.G < nit) prep_load(PX + (size_t)item_row0(it + F.G) * INC, (it + F.G) & 3, F.tid, rr);
        __syncthreads();
        unsigned zf[8], zb[8], qv[8], vv[8];
#pragma unroll
        for (int t = 0; t < 8; ++t) { const int o = (s8 * 8 + t) * 64 + cp; zf[t] = Raw[o]; zb[t] = Raw[4096 + o]; qv[t] = Raw[8192 + o]; vv[t] = Raw[12288 + o]; }
        __syncthreads();
        { v4u lo, hi;
          lo.x = (vv[0] & 0xffffu) | (vv[1] << 16); lo.y = (vv[2] & 0xffffu) | (vv[3] << 16); lo.z = (vv[4] & 0xffffu) | (vv[5] << 16); lo.w = (vv[6] & 0xffffu) | (vv[7] << 16);
          hi.x = (vv[0] >> 16) | (vv[1] & 0xffff0000u); hi.y = (vv[2] >> 16) | (vv[3] & 0xffff0000u); hi.z = (vv[4] >> 16) | (vv[5] & 0xffff0000u); hi.w = (vv[6] >> 16) | (vv[7] & 0xffff0000u);
          *(LAS v4u*)(vT + (2 * cp) * 72 + s8 * 8) = lo; *(LAS v4u*)(vT + (2 * cp + 1) * 72 + s8 * 8) = hi;
          GAS bf16* vt = VT + (size_t)((b * 4 + h) * NCH + tc) * 8192;
          *(GAS v4u*)(vt + (2 * cp) * 64 + s8 * 8) = lo; *(GAS v4u*)(vt + (2 * cp + 1) * 64 + s8 * 8) = hi; }
        float qs0[8], qs1[8];
#pragma unroll
        for (int t = 0; t < 8; ++t) { const f32x2 q = bf2x(qv[t]); qs0[t] = q.x * sigmoidf_(q.x) * 0.08838834764831845f; qs1[t] = q.y * sigmoidf_(q.y) * 0.08838834764831845f; }
#pragma unroll 1
        for (int dir = 0; dir < 2; ++dir) {
            const int seq = (b * 4 + h) * 2 + dir, c = (tc < 4) ? (dir ? 3 - tc : tc) : (dir ? 71 - tc : tc);
            const float lb0 = lb_of(F, l, dir, h * 128 + 2 * cp), lb1 = lb_of(F, l, dir, h * 128 + 2 * cp + 1);
            const float lbf0 = fmaxf(lb0, 1e-30f), oml0 = 1.0f - lb0, lbf1 = fmaxf(lb1, 1e-30f), oml1 = 1.0f - lb1;
            float g0[8], g1[8], k0[8], k1[8];
#pragma unroll
            for (int t = 0; t < 8; ++t) { const f32x2 z = bf2x(dir ? zb[t] : zf[t]); const float a0 = sigmoidf_(z.x), a1 = sigmoidf_(z.y);
                g0[t] = __logf(lbf0 + oml0 * a0); k0[t] = oml0 * (1.0f - a0); g1[t] = __logf(lbf1 + oml1 * a1); k1[t] = oml1 * (1.0f - a1); }
            if (dir == 0) {
#pragma unroll
                for (int t = 1; t < 8; ++t) { g0[t] += g0[t - 1]; g1[t] += g1[t - 1]; }
                *(LAS f32x2*)(tot + s8 * 128 + 2 * cp) = (f32x2){g0[7], g1[7]};
            } else {
#pragma unroll
                for (int t = 6; t >= 0; --t) { g0[t] += g0[t + 1]; g1[t] += g1[t + 1]; }
                *(LAS f32x2*)(tot + s8 * 128 + 2 * cp) = (f32x2){g0[0], g1[0]};
            }
            __syncthreads();
            float off0 = 0.f, off1 = 0.f, m0 = 0.f, m1 = 0.f, bt0 = 0.f, bt1 = 0.f;
#pragma unroll
            for (int sg = 0; sg < 8; ++sg) { const f32x2 tv = *(const LAS f32x2*)(tot + sg * 128 + 2 * cp);
                const bool before = dir ? (sg > s8) : (sg < s8), firsthalf = dir ? (sg >= 4) : (sg < 4);
                if (before) { off0 += tv.x; off1 += tv.y; } if (firsthalf) { m0 += tv.x; m1 += tv.y; } bt0 += tv.x; bt1 += tv.y; }
            GAS bf16* ke = KE + (size_t)(seq * NCH + c) * 8192;
            if (s8 == 0) *(GAS f32x2*)(DEC + (size_t)(seq * NCH + c) * 128 + 2 * cp) = (f32x2){__expf(bt0), __expf(bt1)};
            if (__ballot(!(bt0 > -80.f && bt1 > -80.f)) == 0ull) {
                const float em0 = __expf(m0), em1 = __expf(m1), eb0 = __expf(bt0 - m0), eb1 = __expf(bt1 - m1);
                unsigned ka[4], kb[4]; float kt0[8], kt1[8];
#pragma unroll
                for (int t = 0; t < 8; ++t) { const int tok = s8 * 8 + t; const float b0 = g0[t] + off0, b1 = g1[t] + off1;
                    const float E0 = __expf(b0 - m0), E1 = __expf(b1 - m1); const float qt0 = qs0[t] * E0, qt1 = qs1[t] * E1;
                    kt0[t] = k0[t] * __builtin_amdgcn_rcpf(E0); kt1[t] = k1[t] * __builtin_amdgcn_rcpf(E1);
                    if (outp) {
                        *(GAS unsigned*)(PX + (size_t)(row0 + tok) * INC + dir * HW + h * 128 + 2 * cp) = pg8::cvt_pk_bf16(qt0 * em0, qt1 * em1);
                        *(LAS unsigned*)(Qt + tok * 136 + 2 * cp) = pg8::cvt_pk_bf16(qt0, qt1);
                        *(LAS unsigned*)(Kt + tok * 136 + 2 * cp) = pg8::cvt_pk_bf16(kt0[t], kt1[t]); } }
#pragma unroll
                for (int t = 0; t < 8; t += 2) { ka[t >> 1] = pg8::cvt_pk_bf16(kt0[t] * eb0, kt0[t + 1] * eb0); kb[t >> 1] = pg8::cvt_pk_bf16(kt1[t] * eb1, kt1[t + 1] * eb1); }
                *(GAS v4u*)(ke + (2 * cp) * 64 + s8 * 8) = (v4u){ka[0], ka[1], ka[2], ka[3]}; *(GAS v4u*)(ke + (2 * cp + 1) * 64 + s8 * 8) = (v4u){kb[0], kb[1], kb[2], kb[3]};
            } else {
                { unsigned ka[4], kb[4];
#pragma unroll
                  for (int t = 0; t < 8; t += 2) { ka[t >> 1] = pg8::cvt_pk_bf16(k0[t] * __expf(bt0 - (g0[t] + off0)), k0[t + 1] * __expf(bt0 - (g0[t + 1] + off0)));
                      kb[t >> 1] = pg8::cvt_pk_bf16(k1[t] * __expf(bt1 - (g1[t] + off1)), k1[t + 1] * __expf(bt1 - (g1[t + 1] + off1))); }
                  *(GAS v4u*)(ke + (2 * cp) * 64 + s8 * 8) = (v4u){ka[0], ka[1], ka[2], ka[3]}; *(GAS v4u*)(ke + (2 * cp + 1) * 64 + s8 * 8) = (v4u){kb[0], kb[1], kb[2], kb[3]}; }
                if (outp) {
#pragma unroll
                    for (int t = 0; t < 8; ++t) { const int tok = s8 * 8 + t; const float b0 = g0[t] + off0, b1 = g1[t] + off1;
                        *(GAS unsigned*)(PX + (size_t)(row0 + tok) * INC + dir * HW + h * 128 + 2 * cp) = pg8::cvt_pk_bf16(qs0[t] * __expf(fmaxf(b0, -80.f)), qs1[t] * __expf(fmaxf(b1, -80.f)));
                        *(LAS unsigned*)(Qt + tok * 136 + 2 * cp) = pg8::cvt_pk_bf16(qs0[t] * __expf(clamp80(b0 - m0)), qs1[t] * __expf(clamp80(b1 - m1)));
                        *(LAS unsigned*)(Kt + tok * 136 + 2 * cp) = pg8::cvt_pk_bf16(k0[t] * __expf(clamp80(m0 - b0)), k1[t] * __expf(clamp80(m1 - b1))); }
                }
            }
            __syncthreads();
            if (outp) {
                const float zf0 = opaque_zero();
                f32x4 pa[2] = {(f32x4){zf0, zf0, zf0, zf0}, (f32x4){zf0, zf0, zf0, zf0}};
                mma_rows16<4, 2>(pa, Qt, 136, 16 * mt, Kt, 136, 32 * nh, F.lane);
                const int t = 16 * mt + lr;
#pragma unroll
                for (int i = 0; i < 2; ++i) { const int s0 = 32 * nh + 16 * i + 4 * lq; float p[4];
#pragma unroll
                    for (int x = 0; x < 4; ++x) { const int s = s0 + x; const bool keep = dir ? (s >= t) : (s <= t); p[x] = keep ? pa[i][x] : 0.f; }
                    *(LAS unsigned long long*)(Pm + t * 72 + s0) = (unsigned long long)pg8::cvt_pk_bf16(p[0], p[1]) | ((unsigned long long)pg8::cvt_pk_bf16(p[2], p[3]) << 32); }
            }
            __syncthreads();
            if (outp) {
                const float zf0 = opaque_zero();
                f32x4 oa[4];
#pragma unroll
                for (int i = 0; i < 4; ++i) oa[i] = (f32x4){zf0, zf0, zf0, zf0};
                mma_rows16<2, 4>(oa, Pm, 72, 16 * mt, vT, 72, 64 * nh, F.lane);
                GAS bf16* op = O + ((size_t)dir * NTOK + row0 + 16 * mt + lr) * HW + h * 128 + 64 * nh + 4 * lq;
#pragma unroll
                for (int i = 0; i < 4; ++i) *(GAS unsigned long long*)(op + 16 * i) = (unsigned long long)pg8::cvt_pk_bf16(oa[i].x, oa[i].y) | ((unsigned long long)pg8::cvt_pk_bf16(oa[i].z, oa[i].w) << 32);
            }
            __syncthreads();
        }
    }
}

__device__ __forceinline__ void scan2_load(const GAS bf16* qrow, const GAS bf16* ke, const GAS bf16* vt, int tid, v4u (&r)[6]) {
#pragma unroll
    for (int j = 0; j < 2; ++j) { const int e = tid + 512 * j; r[j] = *(const GAS v4u*)(qrow + (size_t)(e >> 4) * INC + (e & 15) * 8); r[2 + j] = ((const GAS v4u*)ke)[e]; r[4 + j] = ((const GAS v4u*)vt)[e]; }
}
__device__ __forceinline__ void scan_unit(Frame& F, int l, int u, bool dry = false) {
    constexpr int SETB = 54784;
    const GAS bf16* PX = (const GAS bf16*)(F.ws + WS_PX); const GAS bf16* KE = (const GAS bf16*)(F.ws + WS_KE); const GAS bf16* VT = (const GAS bf16*)(F.ws + WS_VT); const GAS float* DEC = (const GAS float*)(F.ws + WS_DEC);
    const int w = F.wave, lr = F.lane & 15, lq = F.lane >> 4;
    const int dir = u & 1, h = (u >> 1) & 3, b = u >> 3;
    GAS bf16* O = (GAS bf16*)(F.ws + WS_O) + (size_t)dir * NTOK * HW;
    const float zf = opaque_zero();
    f32x4 st[8];
#pragma unroll
    for (int i = 0; i < 8; ++i) st[i] = (f32x4){zf, zf, zf, zf};
    v4u ra[6], rb[6]; float da = 0.f, db = 0.f; unsigned long long oa[4] = {0ull, 0ull, 0ull, 0ull}, ob[4] = {0ull, 0ull, 0ull, 0ull};
#define SCAN_TC(c) (((c) < 4) ? (dir ? 3 - (c) : (c)) : (dir ? 71 - (c) : (c)))
#define SCAN_LOAD(R, D, OO, c) do { scan2_load(PX + (size_t)chunk_row0(b, dir, (c)) * INC + dir * HW + h * 128, KE + (size_t)(u * NCH + (c)) * 8192, VT + (size_t)((b * 4 + h) * NCH + SCAN_TC(c)) * 8192, F.tid, R); \
        if (F.tid < 128) D = DEC[(size_t)(u * NCH + (c)) * 128 + F.tid]; \
        if (l == 0 || (c) >= 4) { _Pragma("unroll") for (int m2 = 0; m2 < 4; ++m2) OO[m2] = *(const GAS unsigned long long*)(O + (size_t)(chunk_row0(b, dir, (c)) + 16 * m2 + lr) * HW + h * 128 + 16 * w + 4 * lq); } } while (0)
#define SCAN_STAGE(R, D, set) do { LAS bf16* q_ = (LAS bf16*)(F.lds + (set) * SETB); LAS bf16* k_ = (LAS bf16*)(F.lds + (set) * SETB + 17408); LAS bf16* v_ = (LAS bf16*)(F.lds + (set) * SETB + 35840); \
        _Pragma("unroll") for (int j = 0; j < 2; ++j) { const int e = F.tid + 512 * j; \
            *(LAS v4u*)(q_ + (e >> 4) * 136 + (e & 15) * 8) = R[j]; *(LAS v4u*)(k_ + (e >> 3) * 72 + (e & 7) * 8) = R[2 + j]; *(LAS v4u*)(v_ + (e >> 3) * 72 + (e & 7) * 8) = R[4 + j]; } \
        if (F.tid < 128) ((LAS float*)(F.lds + (set) * SETB + 54272))[F.tid] = D; } while (0)
#define SCAN_STEP(c, RN, DN, ON) do { \
        const int row0 = chunk_row0(b, dir, (c)), set = (c) & 1; const bool outp = (l == 0) || ((c) >= 4); \
        const LAS bf16* Qb = (const LAS bf16*)(F.lds + set * SETB); const LAS bf16* keT = (const LAS bf16*)(F.lds + set * SETB + 17408); const LAS bf16* vT = (const LAS bf16*)(F.lds + set * SETB + 35840); \
        const LAS float* decv = (const LAS float*)(F.lds + set * SETB + 54272); \
        unsigned long long oc_[4], onx_[4]; _Pragma("unroll") for (int m2 = 0; m2 < 4; ++m2) { oc_[m2] = ocur[m2]; onx_[m2] = ON[m2]; } \
        if ((c) + 1 < NCH) SCAN_STAGE(RN, DN, set ^ 1); \
        if ((c) + 3 < NCH) SCAN_LOAD(RN, DN, ON, (c) + 3); \
        if (outp) { \
            bf16x8 sf[4]; \
            _Pragma("unroll") for (int s = 0; s < 4; ++s) { const v4u x = (v4u){pk2(st[2 * s].x, st[2 * s].y), pk2(st[2 * s].z, st[2 * s].w), pk2(st[2 * s + 1].x, st[2 * s + 1].y), pk2(st[2 * s + 1].z, st[2 * s + 1].w)}; sf[s] = __builtin_bit_cast(bf16x8, x); } \
            _Pragma("unroll") for (int mp = 0; mp < 2; ++mp) {          \
                bf16x8 qa_[2][4]; f32x4 o_[2]; \
                _Pragma("unroll") for (int mm = 0; mm < 2; ++mm) { const int m2 = 2 * mp + mm; const LAS bf16* qrow = Qb + (16 * m2 + lr) * 136 + 4 * lq; \
                    _Pragma("unroll") for (int s = 0; s < 4; ++s) { const unsigned long long a0 = *(const LAS unsigned long long*)(qrow + 32 * s), a1 = *(const LAS unsigned long long*)(qrow + 32 * s + 16); \
                        const v4u ax = (v4u){(unsigned)a0, (unsigned)(a0 >> 32), (unsigned)a1, (unsigned)(a1 >> 32)}; qa_[mm][s] = __builtin_bit_cast(bf16x8, ax); } \
                    const unsigned long long ov = oc_[m2]; \
                    o_[mm] = (f32x4){bf2f((unsigned short)(ov & 0xffff)), bf2f((unsigned short)((ov >> 16) & 0xffff)), bf2f((unsigned short)((ov >> 32) & 0xffff)), bf2f((unsigned short)(ov >> 48))}; } \
                _Pragma("unroll") for (int s = 0; s < 4; ++s) \
                    _Pragma("unroll") for (int mm = 0; mm < 2; ++mm) o_[mm] = __builtin_amdgcn_mfma_f32_16x16x32_bf16(sf[s], qa_[mm][s], o_[mm], 0, 0, 0); \
                _Pragma("unroll") for (int mm = 0; mm < 2; ++mm) { const int m2 = 2 * mp + mm; \
                    GAS unsigned long long* op = (GAS unsigned long long*)(O + (size_t)(row0 + 16 * m2 + lr) * HW + h * 128 + 16 * w + 4 * lq); \
                    if (!dry) *op = (unsigned long long)pk2(o_[mm].x, o_[mm].y) | ((unsigned long long)pk2(o_[mm].z, o_[mm].w) << 32); else asm volatile("" :: "v"(o_[mm].x), "v"(o_[mm].y), "v"(o_[mm].z), "v"(o_[mm].w)); } \
            } \
        } \
        { _Pragma("unroll") for (int i = 0; i < 8; ++i) { const f32x4 d4 = *(const LAS f32x4*)(decv + 16 * i + 4 * lq); st[i] = st[i] * d4; } \
          _Pragma("unroll") for (int s2 = 0; s2 < 2; ++s2) { bf16x8 kb_[8];         \
              const bf16x8 va_ = *(const LAS bf16x8*)(vT + (16 * w + lr) * 72 + 32 * s2 + 8 * lq); \
              _Pragma("unroll") for (int i = 0; i < 8; ++i) kb_[i] = *(const LAS bf16x8*)(keT + (16 * i + lr) * 72 + 32 * s2 + 8 * lq); \
              _Pragma("unroll") for (int i = 0; i < 8; ++i) st[i] = __builtin_amdgcn_mfma_f32_16x16x32_bf16(kb_[i], va_, st[i], 0, 0, 0); } } \
        _Pragma("unroll") for (int m2 = 0; m2 < 4; ++m2) ocur[m2] = onx_[m2]; \
        __syncthreads(); } while (0)
    unsigned long long ocur[4];
    SCAN_LOAD(rb, db, ob, 0); SCAN_STAGE(rb, db, 0);
#pragma unroll
    for (int m2 = 0; m2 < 4; ++m2) ocur[m2] = ob[m2];
    SCAN_LOAD(ra, da, oa, 1); SCAN_LOAD(rb, db, ob, 2);
    __syncthreads();
    SCAN_STEP(0, ra, da, oa);
#pragma unroll 1
    for (int c = 1; c + 1 < NCH; c += 2) { SCAN_STEP(c, rb, db, ob); SCAN_STEP(c + 1, ra, da, oa); }
    SCAN_STEP(NCH - 1, rb, db, ob);
#undef SCAN_TC
#undef SCAN_LOAD
#undef SCAN_STAGE
#undef SCAN_STEP
}

#ifndef DIAG_CHECK_PREP
#define DIAG_CHECK_PREP 0
#endif
__device__ __forceinline__ void diag_check_prep(Frame& F, int l) {
    const GAS bf16* KE = (const GAS bf16*)(F.ws + WS_KE); const GAS bf16* VT = (const GAS bf16*)(F.ws + WS_VT); const GAS float* DEC = (const GAS float*)(F.ws + WS_DEC);
    bool bad = false;
    const size_t gt = (size_t)F.vcu * 512 + F.tid, gs = (size_t)F.G * 512;
    for (size_t i = gt; i < (size_t)NSEQ * NCH * 128; i += gs) { const float d = DEC[i]; if (!(d >= 0.f && d <= 1.0001f)) bad = true; }
    for (size_t i = gt; i < (size_t)NSEQ * NCH * 8192; i += gs) { const float k = bf2f(KE[i]); if (!(k >= 0.f && k <= 1.01f)) bad = true; }
    for (size_t i = gt; i < (size_t)NBATCH * 4 * NCH * 8192; i += gs) { const float v = bf2f(VT[i]); if (!(fabsf(v) < 100.f)) bad = true; }
    if (bad) ((float*)(F.ws + WS_MOD))[(size_t)9 * 6144 + 5120] = __builtin_nanf("");
}
#ifndef REP_SCAN
#define REP_SCAN 0
#endif
#ifndef REP_POOL
#define REP_POOL 0
#endif
__device__ __forceinline__ void phase_scan_pool(Frame& F, int l) {
    const bool split = F.G > NSEQ;
    if (!split || F.vcu < NSEQ) { for (int rep = 0; rep < 1 + REP_SCAN; ++rep) for (int u = F.vcu; u < NSEQ; u += F.G) scan_unit(F, l, u, rep < REP_SCAN); }
    if (!split || F.vcu >= NSEQ) {
        const int tc_lo = (l == 0) ? 0 : 4, nit = (NCH - tc_lo) * NBATCH * 4;
        const int start = split ? F.vcu - NSEQ : F.vcu, stride = split ? F.G - NSEQ : F.G;
        for (int rep = 0; rep < 1 + REP_POOL; ++rep) { v4u pr[3];
            if (start < nit) pool_load(F, (start >> 2) & 7, tc_lo + (start >> 5), start & 3, pr);
            for (int it = start; it < nit; it += stride) { const int nx = it + stride; pool_item(F, l, (it >> 2) & 7, tc_lo + (it >> 5), it & 3, pr, nx < nit, (nx >> 2) & 7, tc_lo + (nx >> 5), nx & 3); } }
    }
}
__device__ __forceinline__ void phase_hnorm(Frame& F, int l) {
    const bf16* PX = (const bf16*)(F.ws + WS_PX); const bf16* O = (const bf16*)(F.ws + WS_KV); bf16* Y = (bf16*)(F.ws + WS_HX);
    const int gw = F.vcu * NWAVES + F.wave, NGW = F.G * NWAVES, r_lo = (l == 0) ? 0 : NC;
    const f32x4 w0 = *(const GAS f32x4*)(F.in[10] + l * 128 + (F.lane & 15) * 8), w1 = *(const GAS f32x4*)(F.in[10] + l * 128 + (F.lane & 15) * 8 + 4);
    for (int row = r_lo + gw; row < NTOK; row += NGW) {
        const v4u a = *(const GAS v4u*)(O + (size_t)row * HW + F.lane * 8), bb = *(const GAS v4u*)(O + ((size_t)NTOK + row) * HW + F.lane * 8), gg = *(const GAS v4u*)(PX + (size_t)row * INC + 4 * HW + F.lane * 8);
        float o[8], gt[8];
        o[0] = bf2f((unsigned short)(a.x & 0xffff)) + bf2f((unsigned short)(bb.x & 0xffff)); o[1] = bf2f((unsigned short)(a.x >> 16)) + bf2f((unsigned short)(bb.x >> 16));
        o[2] = bf2f((unsigned short)(a.y & 0xffff)) + bf2f((unsigned short)(bb.y & 0xffff)); o[3] = bf2f((unsigned short)(a.y >> 16)) + bf2f((unsigned short)(bb.y >> 16));
        o[4] = bf2f((unsigned short)(a.z & 0xffff)) + bf2f((unsigned short)(bb.z & 0xffff)); o[5] = bf2f((unsigned short)(a.z >> 16)) + bf2f((unsigned short)(bb.z >> 16));
        o[6] = bf2f((unsigned short)(a.w & 0xffff)) + bf2f((unsigned short)(bb.w & 0xffff)); o[7] = bf2f((unsigned short)(a.w >> 16)) + bf2f((unsigned short)(bb.w >> 16));
        gt[0] = bf2f((unsigned short)(gg.x & 0xffff)); gt[1] = bf2f((unsigned short)(gg.x >> 16)); gt[2] = bf2f((unsigned short)(gg.y & 0xffff)); gt[3] = bf2f((unsigned short)(gg.y >> 16));
        gt[4] = bf2f((unsigned short)(gg.z & 0xffff)); gt[5] = bf2f((unsigned short)(gg.z >> 16)); gt[6] = bf2f((unsigned short)(gg.w & 0xffff)); gt[7] = bf2f((unsigned short)(gg.w >> 16));
        float s = 0.f;
#pragma unroll
        for (int i = 0; i < 8; ++i) s += o[i] * o[i];
        s = sum16_dpp(s);
        const float rn = 1.0f / sqrtf(s * (1.f / 128.f) + EPSN);
        const float wv[8] = {w0.x, w0.y, w0.z, w0.w, w1.x, w1.y, w1.z, w1.w}; float y[8];
#pragma unroll
        for (int i = 0; i < 8; ++i) y[i] = o[i] * rn * wv[i] * (gt[i] * sigmoidf_(gt[i]));
        *(GAS v4u*)(Y + (size_t)row * DM + F.lane * 8) = (v4u){pk2(y[0], y[1]), pk2(y[2], y[3]), pk2(y[4], y[5]), pk2(y[6], y[7])};
    }
}
__device__ __forceinline__ int moe_row_base(int l) { return l == 0 ? 0 : NC; }
__device__ __forceinline__ int moe_half_rows(int l) { return (l == 0 ? NTOK : NX) / NHALF; }


#ifndef DIAG_NAIVE_HGRN
#define DIAG_NAIVE_HGRN 0
#endif
#ifndef DIAG_ROUTER_F32
#define DIAG_ROUTER_F32 0
#endif
#ifndef DIAG_NAIVE_MOE
#define DIAG_NAIVE_MOE 0
#endif
#ifndef DIAG_NAIVE_ROUTE
#define DIAG_NAIVE_ROUTE 0
#endif
#ifndef DIAG_NAIVE_INPROJ
#define DIAG_NAIVE_INPROJ 0
#endif
#ifndef DIAG_NAIVE_OUTPROJ
#define DIAG_NAIVE_OUTPROJ 0
#endif
#ifndef DIAG_CHECK_SLOTS
#define DIAG_CHECK_SLOTS 0
#endif
#ifndef DIAG_NAIVE_MOD
#define DIAG_NAIVE_MOD 0
#endif
#ifndef DIAG_NAIVE_POOL
#define DIAG_NAIVE_POOL 0
#endif
__device__ __forceinline__ void diag_hgrn_scan(Frame& F, int l) {
    LAS float* fz = (LAS float*)(F.lds); LAS float* fk = fz + 128; LAS float* fq = fk + 128; LAS float* fv = fq + 128; LAS float* po = fv + 128;
    const bf16* PX = (const bf16*)(F.ws + WS_PX); float* OBUF = (float*)(F.ws + WS_KV);
    const int v = F.tid & 127, kq = F.tid >> 7;
    for (int it = F.vcu; it < NSEQ; it += F.G) {
        const int dir = it & 1, h = (it >> 1) & 3, b = it >> 3;
        float S[32];
#pragma unroll
        for (int i = 0; i < 32; ++i) S[i] = 0.f;
        const float lb = lb_of(F, l, dir, h * 128 + v), lbf = fmaxf(lb, 1e-30f), oml = 1.0f - lb;
        for (int step = 0; step < CTXL + SEQL; ++step) {
            int row;
            if (step < CTXL) row = b * CTXL + (dir ? CTXL - 1 - step : step);
            else { const int t = step - CTXL; row = NC + b * SEQL + (dir ? SEQL - 1 - t : t); }
            const bf16* pr = PX + (size_t)row * INC;
            if (kq == 0) { const float z = bf2f(pr[dir * HW + h * 128 + v]); const float sg = sigmoidf_(z); fz[v] = lbf + oml * sg; fk[v] = oml * (1.0f - sg); }
            if (kq == 1) { const float q = bf2f(pr[3 * HW + h * 128 + v]); fq[v] = q * sigmoidf_(q) * 0.08838834764831845f; }
            if (kq == 2) fv[v] = bf2f(pr[2 * HW + h * 128 + v]);
            __syncthreads();
            const float vv = fv[v]; float o = 0.f;
#pragma unroll
            for (int i = 0; i < 32; ++i) { const int k = kq * 32 + i; S[i] = fz[k] * S[i] + fk[k] * vv; o += S[i] * fq[k]; }
            po[kq * 128 + v] = o;
            __syncthreads();
            if (kq == 0) OBUF[((size_t)dir * NTOK + row) * HW + h * 128 + v] = (po[v] + po[128 + v]) + (po[256 + v] + po[384 + v]);
        }
        __syncthreads();
    }
}
__device__ __forceinline__ void diag_hgrn_norm(Frame& F, int l) {
    const bf16* PX = (const bf16*)(F.ws + WS_PX); const float* OBUF = (const float*)(F.ws + WS_KV); bf16* Y = (bf16*)(F.ws + WS_HX);
    const int gw = F.vcu * NWAVES + F.wave, NGW = F.G * NWAVES;
    const int r_lo = (l == 0) ? 0 : NC;
    for (int i = gw; i < (NTOK - r_lo) * 4; i += NGW) {
        const int row = r_lo + (i >> 2), h = i & 3;
        const float o0 = OBUF[(size_t)row * HW + h * 128 + F.lane] + OBUF[((size_t)NTOK + row) * HW + h * 128 + F.lane];
        const float o1 = OBUF[(size_t)row * HW + h * 128 + 64 + F.lane] + OBUF[((size_t)NTOK + row) * HW + h * 128 + 64 + F.lane];
        const float rn = 1.0f / sqrtf(wave_sum(o0 * o0 + o1 * o1, F.lane) * (1.f / 128.f) + EPSN);
        const float g0 = bf2f(PX[(size_t)row * INC + 4 * HW + h * 128 + F.lane]), g1 = bf2f(PX[(size_t)row * INC + 4 * HW + h * 128 + 64 + F.lane]);
        Y[(size_t)row * DM + h * 128 + F.lane] = (bf16)f2bf(o0 * rn * F.in[10][l * 128 + F.lane] * (g0 * sigmoidf_(g0)));
        Y[(size_t)row * DM + h * 128 + 64 + F.lane] = (bf16)f2bf(o1 * rn * F.in[10][l * 128 + 64 + F.lane] * (g1 * sigmoidf_(g1)));
    }
}
__device__ __forceinline__ void diag_pool(Frame& F, int l) {
    LAS float* pl = (LAS float*)(F.lds);
    const bf16* PX = (const bf16*)(F.ws + WS_PX); bf16* Y = (bf16*)(F.ws + WS_HX);
    const int sub = F.tid >> 7, d = F.tid & 127;
    const int r_lo = (l == 0) ? 0 : NC;
    for (int it = F.vcu; it < (NTOK - r_lo); it += F.G) {
        const int row = r_lo + it, gi = sub, wdw = 2 << gi, hw2 = wdw >> 1;
        int pos, n, srow;
        if (row < NC) { pos = row % CTXL; n = CTXL; srow = row - pos; } else { pos = (row - NC) % 64; n = 64; srow = row - pos; }
        int lo = pos - hw2, hi = pos + hw2; lo = lo < 0 ? 0 : lo; hi = hi > n ? n : hi;
        float sm = 0.f; for (int r = lo; r < hi; ++r) sm += bf2f(PX[(size_t)(srow + r) * INC + 5 * HW + gi * 128 + d]);
        pl[sub * 128 + d] = sm / (float)(hi - lo) - bf2f(PX[(size_t)row * INC + 5 * HW + gi * 128 + d]);
        __syncthreads();
        const float* wp = F.in[11] + (size_t)(l * 4 + gi) * 128 * 128;
        float o = 0.f; for (int c = 0; c < 128; ++c) o += pl[sub * 128 + c] * wp[c * 128 + d];
        Y[(size_t)row * DM + HW + gi * 128 + d] = (bf16)f2bf(o * F.in[12][l * HW + gi * 128 + d]);
        __syncthreads();
    }
}

__device__ __forceinline__ void diag_moe(Frame& F, int l, int half) {
    LAS float* xs = (LAS float*)(F.lds + F.wave * 16384);
    const bf16* HX = (const bf16*)(F.ws + WS_HX); bf16* YS = (bf16*)(F.ws + WS_YS);
    const int* blke = (const int*)(F.ws + RT_BLKE) + half * MAXBLK; const int* stok = (const int*)(F.ws + RT_STOK) + half * MAXSLOT;
    const int nblk = ((const int*)(F.ws + RT_MISC))[half];
    const int gw = F.vcu * NWAVES + F.wave, NGW = F.G * NWAVES;
    for (int it = gw; it < nblk * 64; it += NGW) {
        const int slot0 = it * 4, e = blke[slot0 >> 8];
        const float* w1 = (e < 64) ? F.in[16] + ((size_t)l * 64 + e) * DM * 256 : F.in[19] + (size_t)l * DM * 256;
        const float* w3 = (e < 64) ? F.in[17] + ((size_t)l * 64 + e) * DM * 256 : F.in[20] + (size_t)l * DM * 256;
        const float* w2 = (e < 64) ? F.in[18] + ((size_t)l * 64 + e) * 256 * DM : F.in[21] + (size_t)l * 256 * DM;
#pragma unroll
        for (int r = 0; r < 4; ++r) { const bf16* xr = HX + (size_t)stok[slot0 + r] * DM;
            for (int k = F.lane; k < DM; k += 64) xs[r * 1024 + k] = bf2f(xr[k]); }
        LDS_WAIT(); asm volatile("" ::: "memory");
        float a1[4][4], a3[4][4];
#pragma unroll
        for (int r = 0; r < 4; ++r)
#pragma unroll
            for (int i = 0; i < 4; ++i) { a1[r][i] = 0.f; a3[r][i] = 0.f; }
        for (int k = 0; k < DM; ++k) {
            float x4[4];
#pragma unroll
            for (int r = 0; r < 4; ++r) x4[r] = xs[r * 1024 + k];
#pragma unroll
            for (int i = 0; i < 4; ++i) { const float u1 = w1[(size_t)k * 256 + F.lane + 64 * i], u3 = w3[(size_t)k * 256 + F.lane + 64 * i];
#pragma unroll
                for (int r = 0; r < 4; ++r) { a1[r][i] += x4[r] * u1; a3[r][i] += x4[r] * u3; } }
        }
        LDS_WAIT(); asm volatile("" ::: "memory");
#pragma unroll
        for (int r = 0; r < 4; ++r)
#pragma unroll
            for (int i = 0; i < 4; ++i) xs[r * 256 + F.lane + 64 * i] = a1[r][i] * sigmoidf_(a1[r][i]) * a3[r][i];
        LDS_WAIT(); asm volatile("" ::: "memory");
#pragma unroll 1
        for (int dh = 0; dh < 4; ++dh) {
            float y[4][4];
#pragma unroll
            for (int r = 0; r < 4; ++r)
#pragma unroll
                for (int i = 0; i < 4; ++i) y[r][i] = 0.f;
            for (int n = 0; n < 256; ++n) {
                float h4[4];
#pragma unroll
                for (int r = 0; r < 4; ++r) h4[r] = xs[r * 256 + n];
#pragma unroll
                for (int i = 0; i < 4; ++i) { const float u = w2[(size_t)n * DM + dh * 256 + F.lane + 64 * i];
#pragma unroll
                    for (int r = 0; r < 4; ++r) y[r][i] += h4[r] * u; }
            }
#pragma unroll
            for (int r = 0; r < 4; ++r)
#pragma unroll
                for (int i = 0; i < 4; ++i) YS[(size_t)(slot0 + r) * DM + dh * 256 + F.lane + 64 * i] = (bf16)f2bf(y[r][i]);
        }
        LDS_WAIT(); asm volatile("" ::: "memory");
    }
}

__device__ __forceinline__ void diag_gemm(Frame& F, int l, int mode) {
    LAS float* As = (LAS float*)(F.lds); LAS float* Bs = As + 16 * 65;
    const int N = mode ? DM : INC, rbase = (mode && l == 1) ? NC : 0, M = NTOK - rbase;
    const bf16* A = (const bf16*)(F.ws + WS_HX) + (size_t)rbase * DM;
    const float* W = mode ? F.in[13] + (size_t)l * DM * DM : F.in[8] + (size_t)l * DM * INC;
    const int ty = F.tid >> 5, tx = F.tid & 31, ntn = N / 128;
    for (int it = F.vcu; it < (M / 64) * ntn; it += F.G) {
        const int m0 = (it / ntn) * 64, n0 = (it % ntn) * 128;
        float acc[4][4];
#pragma unroll
        for (int i = 0; i < 4; ++i)
#pragma unroll
            for (int j = 0; j < 4; ++j) acc[i][j] = 0.f;
        for (int k0 = 0; k0 < DM; k0 += 16) {
            { const int idx = F.tid * 2, r = idx >> 4, kk = idx & 15; const unsigned u = *(const unsigned*)(A + (size_t)(m0 + r) * DM + k0 + kk);
              As[kk * 65 + r] = bf2f((unsigned short)(u & 0xffff)); As[(kk + 1) * 65 + r] = bf2f((unsigned short)(u >> 16)); }
            { const int r = F.tid >> 5, c4 = (F.tid & 31) * 4; *(LAS f32x4*)(Bs + r * 128 + c4) = *(const GAS f32x4*)(W + (size_t)(k0 + r) * N + n0 + c4); }
            __syncthreads();
#pragma unroll
            for (int kk = 0; kk < 16; ++kk) { float a[4]; f32x4 b = *(const LAS f32x4*)(Bs + kk * 128 + tx * 4);
#pragma unroll
                for (int i = 0; i < 4; ++i) a[i] = As[kk * 65 + ty * 4 + i];
#pragma unroll
                for (int i = 0; i < 4; ++i) { acc[i][0] += a[i] * b.x; acc[i][1] += a[i] * b.y; acc[i][2] += a[i] * b.z; acc[i][3] += a[i] * b.w; } }
            __syncthreads();
        }
#pragma unroll
        for (int i = 0; i < 4; ++i) { const int row = rbase + m0 + ty * 4 + i, col = n0 + tx * 4;
            if (mode == 0) { bf16* px = (bf16*)(F.ws + WS_PX) + (size_t)row * INC + col;
                *(unsigned long long*)px = (unsigned long long)pk2(acc[i][0], acc[i][1]) | ((unsigned long long)pk2(acc[i][2], acc[i][3]) << 32); }
            else { const float* bp = resid_in_row(F, l, row) + col; float* op = resid_row(F, row) + col; const float* gt = (const float*)(F.ws + WS_MOD) + ((size_t)l * 9 + mod_row(row)) * 6144 + 2048 + col;
                const f32x4 b = *(const GAS f32x4*)bp, g = *(const GAS f32x4*)gt; *(GAS f32x4*)op = (f32x4){b.x + g.x * acc[i][0], b.y + g.y * acc[i][1], b.z + g.z * acc[i][2], b.w + g.w * acc[i][3]}; } }
    }
}

__device__ __forceinline__ void diag_check_slots(Frame& F, int l) {
    const int rb = moe_row_base(l), nhalf = moe_half_rows(l);
    const int* IDX = (const int*)(F.ws + RT_IDX); const int* TSLOT = (const int*)(F.ws + RT_TSLOT); const int* STOK = (const int*)(F.ws + RT_STOK); const int* BLKE = (const int*)(F.ws + RT_BLKE); const int* MISCT = (const int*)(F.ws + RT_MISC);
    bool bad = false;
    for (int a = F.vcu * 512 + F.tid; a < 2 * nhalf * 6; a += F.G * 512) {
        const int row = rb + a / 6, half = (a / 6) >= nhalf ? 1 : 0; const int slot = TSLOT[(size_t)rb * 6 + a], e = IDX[(size_t)rb * 6 + a];
        if (slot < 0 || slot >= MISCT[half] * 256) bad = true;
        else { if (STOK[half * MAXSLOT + slot] != row) bad = true; if (BLKE[half * MAXBLK + (slot >> 8)] != e) bad = true; }
    }
    for (int i = F.vcu * 512 + F.tid; i < 2 * nhalf; i += F.G * 512) { const int half = i >= nhalf ? 1 : 0, ii = i - half * nhalf; const int slot = MISCT[2 + half] + ii;
        if (STOK[half * MAXSLOT + slot] != rb + i) bad = true; if (BLKE[half * MAXBLK + (slot >> 8)] != 64) bad = true; }
    if (bad) F.out[0] = __builtin_nanf("");
    if (bad) ((float*)(F.ws + WS_MOD))[5120] = __builtin_nanf("");
}

__device__ __forceinline__ void diag_mod(Frame& F) {
    float* mod = (float*)(F.ws + WS_MOD);
    for (int i = F.vcu * 512 + F.tid; i < 2 * 6144; i += F.G * 512) {
        const int l = i / 6144, n = i % 6144; float acc[9];
        for (int r = 0; r < 9; ++r) acc[r] = 0.f;
        for (int k = 0; k < DM; ++k) { const float w = F.in[6][((size_t)l * DM + k) * 6144 + n];
            for (int r = 0; r < 9; ++r) { const float c = (r < 8) ? F.in[1][r * DM + k] : F.in[3][k]; acc[r] += (c / (1.0f + expf(-c))) * w; } }
        for (int r = 0; r < 9; ++r) mod[((size_t)l * 9 + r) * 6144 + n] = acc[r] + F.in[7][(size_t)l * 6144 + n];
    }
}

__device__ __forceinline__ void phase_route(Frame& F, int l, bool dry = false) {
    LAS bf16* Xt = (LAS bf16*)(F.lds);
    LAS float* Lg = (LAS float*)(F.lds + 32 * 2064);
    LAS unsigned* lcnt = (LAS unsigned*)(F.lds + 32 * 2064 + 8192);
    const GAS float* mod = (const GAS float*)(F.ws + WS_MOD) + (size_t)l * 9 * 6144;
    GAS bf16* HX = (GAS bf16*)(F.ws + WS_HX); const GAS bf16* WrT = (const GAS bf16*)(F.ws + WS_WR);
    GAS int* IDX = (GAS int*)(F.ws + RT_IDX); GAS float* GATE = (GAS float*)(F.ws + RT_GATE);
    const int rb = moe_row_base(l), nhalf = moe_half_rows(l), ntiles = NHALF * nhalf / 32;
    const int lr = F.lane & 15, lq = F.lane >> 4, w = F.wave;
    if (F.tid < 128) lcnt[F.tid] = 0u;
    if (F.vcu == 0) { unsigned z0 = 0u; asm volatile("" : "+v"(z0)); for (int i = F.tid; i < DM / 16; i += 512) ((GAS v4u*)((GAS unsigned char*)HX + (size_t)NTOK * DM))[i] = (v4u){z0, z0, z0, z0}; }
    const int mt = w >> 2, nt = w & 3;
    bf16x8 wf[32];
#pragma unroll
    for (int s2 = 0; s2 < 32; ++s2) wf[s2] = *(const GAS bf16x8*)(WrT + (size_t)(16 * nt + lr) * DM + 32 * s2 + 8 * lq);
    const float rbias = ((const GAS float*)F.in[15])[l * NE + F.lane];
    const GAS f32x4* nw = (const GAS f32x4*)(F.in[5] + l * DM);
    __syncthreads();
    for (int it = F.vcu; it < ntiles; it += F.G) {
        const int row0 = rb + it * 32;
        {
#pragma unroll
          for (int ip = 0; ip < 2; ++ip) { f32x4 xv[2][4];
#pragma unroll
          for (int i = 0; i < 2; ++i) { const GAS f32x4* xr = (const GAS f32x4*)resid_row(F, row0 + w * 4 + 2 * ip + i) + F.lane;
#pragma unroll
              for (int j = 0; j < 4; ++j) xv[i][j] = xr[64 * j]; }
#pragma unroll
          for (int i = 0; i < 2; ++i) { const int lrow = w * 4 + 2 * ip + i, row = row0 + lrow; const GAS float* md = mod + mod_row(row) * 6144;
              float ss = 0.f;
#pragma unroll
              for (int j = 0; j < 4; ++j) ss += (xv[i][j].x * xv[i][j].x + xv[i][j].y * xv[i][j].y) + (xv[i][j].z * xv[i][j].z + xv[i][j].w * xv[i][j].w);
              const float r = 1.0f / sqrtf(wave_sum(ss, F.lane) * (1.f / DM) + EPSN);
#pragma unroll
              for (int j = 0; j < 4; ++j) { const f32x4 w4 = nw[F.lane + 64 * j], s4 = ((const GAS f32x4*)(md + 4096))[F.lane + 64 * j], h4 = ((const GAS f32x4*)(md + 3072))[F.lane + 64 * j];
                  const f32x4 o = (xv[i][j] * r) * w4 * (s4 + 1.0f) + h4;
                  const unsigned long long pk = (unsigned long long)pk2(o.x, o.y) | ((unsigned long long)pk2(o.z, o.w) << 32);
                  int w8 = 0; w8 = __builtin_amdgcn_cvt_pk_fp8_f32(o.x, o.y, w8, false); w8 = __builtin_amdgcn_cvt_pk_fp8_f32(o.z, o.w, w8, true);
                  ((GAS unsigned*)((GAS unsigned char*)HX + (size_t)row * DM))[F.lane + 64 * j] = (unsigned)w8;
                  *(LAS unsigned long long*)(Xt + lrow * 1032 + 4 * (F.lane + 64 * j)) = pk; } } } }
        __syncthreads();
        { const float zf = opaque_zero(); f32x4 a4 = (f32x4){zf, zf, zf, zf};
#pragma unroll
          for (int s2 = 0; s2 < 32; ++s2) { const bf16x8 a = *(const LAS bf16x8*)(Xt + (16 * mt + lr) * 1032 + 32 * s2 + 8 * lq); a4 = __builtin_amdgcn_mfma_f32_16x16x32_bf16(wf[s2], a, a4, 0, 0, 0); }
          *(LAS f32x4*)(Lg + (16 * mt + lr) * 64 + 16 * nt + 4 * lq) = a4; }
        __syncthreads();
        { float sc[4], bs[4], gs[4], msk[4], ssum[4], myg2[4]; int myi[4], sel[4];
#pragma unroll
          for (int i = 0; i < 4; ++i) { sc[i] = sigmoidf_(Lg[(w * 4 + i) * 64 + F.lane]); bs[i] = sc[i] + rbias; ssum[i] = 0.f; sel[i] = 0; myi[i] = 0; myg2[i] = 0.f; }
          { float m1[4], m2[4];
#pragma unroll
            for (int i = 0; i < 4; ++i) m1[i] = bs[i];
#pragma unroll
            for (int i = 0; i < 4; ++i) m1[i] = max8_dpp(m1[i]);
            const int gb = F.lane & ~7;
#pragma unroll
            for (int i = 0; i < 4; ++i) { const unsigned long long bal = __ballot(bs[i] == m1[i]); const unsigned gm = (unsigned)((bal >> gb) & 0xffull); const int first = gb + __ffs((int)gm) - 1; m2[i] = (F.lane == first) ? -3.0e38f : bs[i]; }
#pragma unroll
            for (int i = 0; i < 4; ++i) m2[i] = max8_dpp(m2[i]);
#pragma unroll
            for (int i = 0; i < 4; ++i) gs[i] = m1[i] + m2[i]; }
          { const int myg = F.lane >> 3; int rank[4] = {0, 0, 0, 0};
#pragma unroll
            for (int g2 = 0; g2 < 8; ++g2)
#pragma unroll
                for (int i = 0; i < 4; ++i) { const float og = rdlane(gs[i], g2 * 8); rank[i] += ((og > gs[i]) || (og == gs[i] && g2 < myg)) ? 1 : 0; }
#pragma unroll
            for (int i = 0; i < 4; ++i) msk[i] = (rank[i] < 4) ? bs[i] : -1.0e4f; }
#pragma unroll
          for (int jj = 0; jj < 6; ++jj) { float mx[4];
#pragma unroll
              for (int i = 0; i < 4; ++i) mx[i] = max64_dpp(msk[i]);
#pragma unroll
              for (int i = 0; i < 4; ++i) { const unsigned long long b2 = __ballot(msk[i] == mx[i]); const int win = __ffsll((long long)b2) - 1;
                  const float wv = rdlane(sc[i], win); ssum[i] += wv; if (F.lane == jj) { myi[i] = win; myg2[i] = wv; } if (F.lane == win) { msk[i] = -3.0e38f; sel[i] = 1; } } }
#pragma unroll
          for (int i = 0; i < 4; ++i) { const int row = row0 + w * 4 + i; const float inv = 2.5f / ssum[i];
              if (F.lane < 6) { IDX[(size_t)row * 6 + F.lane] = myi[i]; GATE[(size_t)row * 6 + F.lane] = myg2[i] * inv; }
              const int half = (row - rb) >= nhalf ? 1 : 0;
              if (sel[i] && !dry) __hip_atomic_fetch_add(&lcnt[half * 64 + F.lane], 1u, __ATOMIC_RELAXED, __HIP_MEMORY_SCOPE_WORKGROUP); } }
        __syncthreads();
    }
    __syncthreads();
    if (F.tid < 128) { const unsigned v = lcnt[F.tid]; if (v) atomicAdd(F.ctl + CW_CNT + l * 128 + F.tid, v); }
}

__device__ __forceinline__ void phase_slots(Frame& F, int l) {
    LAS int* pstart = (LAS int*)(F.lds);
    LAS int* cntl = (LAS int*)(F.lds + 1024);
    LAS unsigned* lc = (LAS unsigned*)(F.lds + 2048);
    LAS unsigned* lbase = (LAS unsigned*)(F.lds + 2560);
    const int rb = moe_row_base(l), nhalf = moe_half_rows(l);
    const int* IDX = (const int*)(F.ws + RT_IDX); int* TSLOT = (int*)(F.ws + RT_TSLOT); int* STOK = (int*)(F.ws + RT_STOK); int* BLKE = (int*)(F.ws + RT_BLKE); int* MISC = (int*)(F.ws + RT_MISC);
    if (F.tid < 128) cntl[F.tid] = (int)__hip_atomic_load(F.ctl + CW_CNT + l * 128 + F.tid, __ATOMIC_RELAXED, __HIP_MEMORY_SCOPE_AGENT);
    __syncthreads();
    if (F.tid < NHALF) { int s = 0; for (int e = 0; e < 64; ++e) { pstart[F.tid * 66 + e] = s; s += (cntl[F.tid * 64 + e] + 255) & ~255; } pstart[F.tid * 66 + 64] = s; pstart[F.tid * 66 + 65] = s + nhalf; }
    __syncthreads();
    for (int w = F.vcu; w < NHALF * 65; w += F.G) {
        const int half = w / 65, e = w % 65; int* stok = STOK + half * MAXSLOT; int* blke = BLKE + half * MAXBLK;
        const int ps = pstart[half * 66 + e], pe = pstart[half * 66 + e + 1];
        for (int b = ps / 256 + F.tid; b < pe / 256; b += 512) blke[b] = e;
        if (e < 64) { for (int s = ps + cntl[half * 64 + e] + F.tid; s < pe; s += 512) stok[s] = NTOK; }
        else { for (int i = F.tid; i < nhalf; i += 512) stok[ps + i] = rb + half * nhalf + i;
               if (F.tid == 0) { MISC[half] = pe / 256; MISC[2 + half] = ps; } }
    }
    const int tpc = NHALF * nhalf / 256;
    for (int ck = F.vcu; ck < 256; ck += F.G) {
        const int half = (ck * tpc) / nhalf, tok0 = rb + ck * tpc; int* stok = STOK + half * MAXSLOT;
        if (F.tid < 64) lc[F.tid] = 0u;
        __syncthreads();
        int e0 = -1, e1 = -1; unsigned p0 = 0, p1 = 0; const int a0 = F.tid, a1 = F.tid + 512;
        if (a0 < tpc * 6) { e0 = IDX[(size_t)tok0 * 6 + a0]; p0 = __hip_atomic_fetch_add(&lc[e0], 1u, __ATOMIC_RELAXED, __HIP_MEMORY_SCOPE_WORKGROUP); }
        if (a1 < tpc * 6) { e1 = IDX[(size_t)tok0 * 6 + a1]; p1 = __hip_atomic_fetch_add(&lc[e1], 1u, __ATOMIC_RELAXED, __HIP_MEMORY_SCOPE_WORKGROUP); }
        __syncthreads();
        if (F.tid < 64) { const unsigned n = lc[F.tid]; lbase[F.tid] = n ? atomicAdd(F.ctl + CW_CUR + l * 128 + half * 64 + F.tid, n) : 0u; }
        __syncthreads();
        if (e0 >= 0) { const int slot = pstart[half * 66 + e0] + (int)(lbase[e0] + p0); stok[slot] = tok0 + a0 / 6; TSLOT[(size_t)tok0 * 6 + a0] = slot; }
        if (e1 >= 0) { const int slot = pstart[half * 66 + e1] + (int)(lbase[e1] + p1); stok[slot] = tok0 + a1 / 6; TSLOT[(size_t)tok0 * 6 + a1] = slot; }
        __syncthreads();
    }
}

__device__ __forceinline__ void phase_combine(Frame& F, int l, int half) {
    const int gw = F.vcu * NWAVES + F.wave, NGW = F.G * NWAVES;
    const int rb = moe_row_base(l), nhalf = moe_half_rows(l);
    const GAS float* mod = (const GAS float*)(F.ws + WS_MOD) + (size_t)l * 9 * 6144;
    const GAS int* TSLOT = (const GAS int*)(F.ws + RT_TSLOT); const GAS float* GATE = (const GAS float*)(F.ws + RT_GATE); const int* MISC = (const int*)(F.ws + RT_MISC);
    const GAS unsigned char* YS = (const GAS unsigned char*)(F.ws + WS_YS); GAS bf16* HX = (GAS bf16*)(F.ws + WS_HX);
    const int shs = MISC[2 + half], c0 = 8 * F.lane;
    int sl[6]; float gj[6];
    if (gw < nhalf) { const size_t a = (size_t)(rb + half * nhalf + gw) * 6;
#pragma unroll
        for (int j = 0; j < 6; ++j) { sl[j] = TSLOT[a + j]; gj[j] = GATE[a + j]; } }
    for (int i = gw; i < nhalf; i += NGW) {
        const int row = rb + half * nhalf + i;
        GAS float* xr = (GAS float*)resid_row(F, row); const GAS float* gt = mod + mod_row(row) * 6144 + 5120;
        unsigned long long ya[7][2];
#pragma unroll
        for (int j = 0; j < 6; ++j) { const GAS unsigned char* yp = YS + (size_t)sl[j] * DM + c0; ya[j][0] = *(const GAS unsigned long long*)yp; ya[j][1] = *(const GAS unsigned long long*)(yp + 512); }
        { const GAS unsigned char* yp = YS + (size_t)(shs + i) * DM + c0; ya[6][0] = *(const GAS unsigned long long*)yp; ya[6][1] = *(const GAS unsigned long long*)(yp + 512); }
        f32x4 xv[4], g4[4];
#pragma unroll
        for (int q = 0; q < 4; ++q) { const int co = c0 + (q >> 1) * 512 + (q & 1) * 4; xv[q] = *(const GAS f32x4*)(xr + co); g4[q] = *(const GAS f32x4*)(gt + co); }
        float gc[7];
#pragma unroll
        for (int j = 0; j < 6; ++j) gc[j] = gj[j] * (1.0f / pg8::YS_SCALE);
        gc[6] = 1.0f / pg8::YS_SCALE;
        if (i + NGW < nhalf) { const size_t a = (size_t)(row + NGW) * 6;
#pragma unroll
            for (int j = 0; j < 6; ++j) { sl[j] = TSLOT[a + j]; gj[j] = GATE[a + j]; } }
        float y[16]; const float zf = opaque_zero();
#pragma unroll
        for (int k = 0; k < 16; ++k) y[k] = zf;
#pragma unroll
        for (int j = 0; j < 7; ++j)
#pragma unroll
            for (int hh = 0; hh < 2; ++hh) { const int lo = (int)(unsigned)ya[j][hh], hi = (int)(unsigned)(ya[j][hh] >> 32);
                const pg8::f32v2_t a0 = __builtin_amdgcn_cvt_pk_f32_fp8(lo, false), a1 = __builtin_amdgcn_cvt_pk_f32_fp8(lo, true), a2 = __builtin_amdgcn_cvt_pk_f32_fp8(hi, false), a3 = __builtin_amdgcn_cvt_pk_f32_fp8(hi, true);
                y[8 * hh + 0] += gc[j] * a0.x; y[8 * hh + 1] += gc[j] * a0.y; y[8 * hh + 2] += gc[j] * a1.x; y[8 * hh + 3] += gc[j] * a1.y;
                y[8 * hh + 4] += gc[j] * a2.x; y[8 * hh + 5] += gc[j] * a2.y; y[8 * hh + 6] += gc[j] * a3.x; y[8 * hh + 7] += gc[j] * a3.y; }
        float ss = 0.f;
#pragma unroll
        for (int q = 0; q < 4; ++q) { xv[q] = xv[q] + g4[q] * (f32x4){y[4 * q], y[4 * q + 1], y[4 * q + 2], y[4 * q + 3]};
            ss += (xv[q].x * xv[q].x + xv[q].y * xv[q].y) + (xv[q].z * xv[q].z + xv[q].w * xv[q].w); }
        const float r = 1.0f / sqrtf(wave_sum(ss, F.lane) * (1.f / DM) + EPSN);
        if (l == 1) {
#pragma unroll
            for (int q = 0; q < 4; ++q) { const int co = c0 + (q >> 1) * 512 + (q & 1) * 4; const f32x4 w4 = *(const GAS f32x4*)((const GAS float*)F.in[22] + co); *(GAS f32x4*)(xr + co) = xv[q] * r * w4; }
        } else {
            const GAS float* md1 = mod + (size_t)(9 + mod_row(row)) * 6144; const GAS float* nw = (const GAS float*)F.in[4] + DM;
            unsigned pk[8];
#pragma unroll
            for (int q = 0; q < 4; ++q) { const int co = c0 + (q >> 1) * 512 + (q & 1) * 4; *(GAS f32x4*)(xr + co) = xv[q];
                const f32x4 w4 = *(const GAS f32x4*)(nw + co), s4 = *(const GAS f32x4*)(md1 + 1024 + co), h4 = *(const GAS f32x4*)(md1 + co);
                const f32x4 o = (xv[q] * r) * w4 * (s4 + 1.0f) + h4; pk[2 * q] = pk2(o.x, o.y); pk[2 * q + 1] = pk2(o.z, o.w); }
            *(GAS v4u*)(HX + (size_t)row * DM + c0) = (v4u){pk[0], pk[1], pk[2], pk[3]}; *(GAS v4u*)(HX + (size_t)row * DM + 512 + c0) = (v4u){pk[4], pk[5], pk[6], pk[7]};
        }
    }
}

constexpr int PH_PER_LAYER = 14, N_PHASES = 1 + 2 * PH_PER_LAYER;
#ifndef MK_PER_PHASE
#define MK_PER_PHASE 0
#endif
struct Args { const float* in[23]; float* out; unsigned char* ws; int ph_lo, ph_hi; };
__global__ void __launch_bounds__(NWAVES * 64, 2) mk_fwd(Args args) {
    {
        LAS unsigned char* lds = (LAS unsigned char*)g_lds;
        for (int u = threadIdx.x; u < (LDS_BYTES - LDSCTL_OFF) / 4; u += NWAVES * 64) ((LAS unsigned*)(lds + LDSCTL_OFF))[u] = 0u;
        __syncthreads();
        LAS unsigned long long* tab = (LAS unsigned long long*)(lds + TAB_OFF);
        if (threadIdx.x < 23) tab[threadIdx.x] = (unsigned long long)args.in[threadIdx.x];
        if (threadIdx.x == 23) tab[23] = (unsigned long long)args.out;
        if (threadIdx.x == 24) tab[24] = (unsigned long long)args.ws;
        __syncthreads();
#if !MK_PER_PHASE
        if (threadIdx.x == 0) (void)xb_add((unsigned*)(args.ws + WS_CTL) + CW_BAR + XB_XCNT(xb_xcc_id()), 1u);
#endif
    }
#if MK_PER_PHASE
    const int lo = args.ph_lo, hi = args.ph_hi;
#define IN(k) (lo <= (k) && (k) < hi)
#define SEAM(k) do { } while (0)
#else
#define IN(k) true
#define SEAM(k) do { grid_barrier(); if (REP_MASK & 0x10000u) { grid_barrier(); grid_barrier(); } if (TIMING_MASK) { if (blockIdx.x == 0 && threadIdx.x == 0) ((unsigned long long*)(args.ws + WS_CTL + 65536))[1 + seam_id] = __builtin_amdgcn_s_memrealtime(); ++seam_id; } } while (0)
#endif
#ifndef GEMM2_STAGGER
#define GEMM2_STAGGER 0
#endif
#ifndef REP_MASK
#define REP_MASK 0u
#endif
#ifndef TIMING_MASK
#define TIMING_MASK 0u
#endif
#define REP(c) (1 + ((REP_MASK >> (c)) & 1u))
#ifndef PH_MASK
#define PH_MASK 0xffffffffu
#endif
#define INM(k, c) (IN(k) && ((PH_MASK >> (c)) & 1u))
    int seam_id = 0; (void)seam_id;
    if (TIMING_MASK) { if (blockIdx.x == 0 && threadIdx.x == 0) ((unsigned long long*)(args.ws + WS_CTL + 65536))[0] = __builtin_amdgcn_s_memrealtime(); }
    if (INM(0, 0)) { Frame F = make_frame(); phase_mod(F); __syncthreads(); for (int rep = 0; rep < REP(12); ++rep) phase_wconv(F, 0); }
    SEAM(0);
#if DIAG_NAIVE_MOD
    { Frame F = make_frame(); diag_mod(F); } SEAM(0);
#endif
#pragma unroll 1
    for (int l = 0; l < 2; ++l) {
        const int P = 1 + l * PH_PER_LAYER; (void)P;
        if (l == 0) {
            if (INM(P + 0, 1)) for (int rep = 0; rep < REP(1); ++rep) { Frame F = make_frame(); phase_hx(F, l); }
            SEAM(P + 0);
        }
#if DIAG_NAIVE_INPROJ
        { Frame F = make_frame(); diag_gemm(F, l, 0); }
#else
        if (INM(P + 1, 2)) for (int rep = 0; rep < REP(2); ++rep) {
            Frame F = make_frame(); unsigned char* ws = F.ws;
            pg8::Gemm g{(const bf16*)(ws + WS_HX), (const bf16*)(ws + WS_WIN), DM, nullptr}; pg8::StaticOrder S; S.init(NTOK, INC, F.G, (int)blockIdx.x);
            pg8::EpiB16 E{(bf16*)(ws + WS_PX), INC, 0xffff};
            pg8::gemm_phase<pg8::EpiB16, pg8::StaticOrder, true, false>(F.lds, g, S, E);
        }
#endif
        SEAM(P + 1);
        if (INM(P + 2, 3)) for (int rep = 0; rep < REP(13); ++rep) { Frame F = make_frame(); phase_prep(F, l); }
        SEAM(P + 2);
#if DIAG_CHECK_PREP
        { Frame F = make_frame(); diag_check_prep(F, l); } SEAM(P + 2);
#endif
        if (INM(P + 2, 3)) { Frame F = make_frame(); phase_scan_pool(F, l); }
        SEAM(P + 2);
        if (INM(P + 3, 4)) for (int rep = 0; rep < REP(4); ++rep) { Frame F = make_frame(); phase_hnorm(F, l); }
        SEAM(P + 3);
#if DIAG_NAIVE_HGRN
        { Frame F = make_frame(); diag_hgrn_scan(F, l); } SEAM(P + 4);
        { Frame F = make_frame(); diag_hgrn_norm(F, l); } SEAM(P + 4);
#endif
#if DIAG_NAIVE_POOL
        { Frame F = make_frame(); diag_pool(F, l); } SEAM(P + 4);
#endif
#if DIAG_NAIVE_OUTPROJ
        { Frame F = make_frame(); diag_gemm(F, l, 1); }
#else
        if (INM(P + 5, 6)) for (int rep = 0; rep < (l == 0 ? REP(6) : 1); ++rep) {
            Frame F = make_frame(); unsigned char* ws = F.ws;
            const int rbase = l == 0 ? 0 : NC;
            pg8::Gemm g{(const bf16*)(ws + WS_HX) + (size_t)rbase * DM, (const bf16*)(ws + WS_WOUT), DM, nullptr}; pg8::StaticOrder S; S.init(NTOK - rbase, DM, F.G, (int)blockIdx.x);
            pg8::EpiRes E{l == 0 ? F.in[2] : (const float*)(ws + WS_CTXRES), l == 0 ? F.in[0] : (const float*)F.out, (float*)(ws + WS_CTXRES), F.out, (const float*)(ws + WS_MOD) + (size_t)l * 9 * 6144, 2048, rbase};
            pg8::gemm_phase<pg8::EpiRes, pg8::StaticOrder, true, false>(F.lds, g, S, E);
        }
#endif
        SEAM(P + 5);
        if (INM(P + 6, 7)) for (int rep = 0; rep < REP(7); ++rep) { Frame F = make_frame(); phase_route(F, l, rep + 1 < REP(7)); }
        SEAM(P + 6);
        if (INM(P + 7, 8)) { Frame F = make_frame(); phase_slots(F, l); }
        SEAM(P + 7);
#if DIAG_CHECK_SLOTS
        { Frame F = make_frame(); diag_check_slots(F, l); } SEAM(P + 7);
#endif
#pragma unroll 1
        for (int half = 0; half < NHALF; ++half) {
            const int Q = P + 8 + 3 * half; (void)Q;
            if (INM(Q + 0, 9)) for (int rep = 0; rep < REP(9); ++rep) {
                Frame F = make_frame(); unsigned char* ws = F.ws;
                const int* blke = (const int*)(ws + RT_BLKE) + half * MAXBLK; const int* stok = (const int*)(ws + RT_STOK) + half * MAXSLOT;
                const int nblk = __builtin_amdgcn_readfirstlane(((const int*)(ws + RT_MISC))[half]);
                int k1 = DM / 2; asm volatile("" : "+s"(k1));
                pg8::Gemm g{(const bf16*)(ws + WS_HX), (const bf16*)(ws + WS_W13), k1, stok, 0x7a7a7a7a}; pg8::MoeOrder S{blke, nblk, 2, F.G, F.vcu};
                pg8::EpiSwiglu E{(unsigned char*)(ws + WS_HS)};
                pg8::gemm_phase<pg8::EpiSwiglu, pg8::MoeOrder, true, true, true>(F.lds, g, S, E);
            }
            SEAM(Q + 0);
            if (INM(Q + 1, 10)) for (int rep = 0; rep < REP(10); ++rep) {
                Frame F = make_frame(); unsigned char* ws = F.ws;
                const int* blke = (const int*)(ws + RT_BLKE) + half * MAXBLK;
                const int nblk = __builtin_amdgcn_readfirstlane(((const int*)(ws + RT_MISC))[half]);
                if (GEMM2_STAGGER && (F.vcu & 1)) { const unsigned long long t0 = __builtin_amdgcn_s_memrealtime(); while (__builtin_amdgcn_s_memrealtime() - t0 < (unsigned long long)GEMM2_STAGGER) __builtin_amdgcn_s_sleep(8); }
                int k2 = 128; asm volatile("" : "+s"(k2));
                pg8::Gemm g{(const bf16*)(ws + WS_HS), (const bf16*)(ws + WS_W2), k2, nullptr, 0x7e7e7e7e};     pg8::MoeOrder S{blke, nblk, 4, F.G, F.vcu};
                pg8::EpiF8 E{(unsigned char*)(ws + WS_YS), 3, (rep + 1 < (int)REP(10)) ? 1 : 0};
                pg8::gemm_phase<pg8::EpiF8, pg8::MoeOrder, true, false, true>(F.lds, g, S, E);
            }
            SEAM(Q + 1);
#if DIAG_NAIVE_MOE
            { Frame F = make_frame(); diag_moe(F, l, half); } SEAM(Q + 1);
#endif
            if (INM(Q + 2, 11)) { Frame F = make_frame(); phase_combine(F, l, half); if (l == 0 && half == NHALF - 1) for (int rep = 0; rep < REP(12); ++rep) phase_wconv(F, 1); }
            if (!(l == 1 && half == NHALF - 1)) SEAM(Q + 2);
        }
    }
    if (TIMING_MASK) {
        SEAM(99);
        const unsigned long long* ts = (const unsigned long long*)(args.ws + WS_CTL + 65536);
        unsigned long long tk = 0ull;
        for (int k = 0; k < seam_id && k < 32; ++k) if ((TIMING_MASK >> k) & 1u) tk += ts[1 + k] - ts[k];
        const float a = sqrtf((float)((tk / 2500ull) * 2500ull) * 0.0001f);
        for (size_t i = (size_t)blockIdx.x * 512 + threadIdx.x; i < (size_t)NX * DM; i += (size_t)gridDim.x * 512) args.out[i] = a;
    }
#undef IN
#undef INM
#undef SEAM
}

extern "C" void kernel_launch(void* const* d_in, const int* in_sizes, int n_in, void* d_out, int out_size, void* d_ws, size_t ws_size, hipStream_t stream) {
    static int grid = 0;
    if (grid == 0) {
        if (n_in != 23 || out_size != NX * DM || ws_size < WS_END) { fprintf(stderr, "kernel_launch: unexpected shapes (n_in %d, out %d, ws %zu); nothing launched\n", n_in, out_size, ws_size); grid = -1; return; }
        int dev = 0, cus = 0;
        if (hipGetDevice(&dev) != hipSuccess || hipDeviceGetAttribute(&cus, hipDeviceAttributeMultiprocessorCount, dev) != hipSuccess) { grid = -1; return; }
        if (hipFuncSetAttribute((const void*)mk_fwd, hipFuncAttributeMaxDynamicSharedMemorySize, LDS_BYTES) != hipSuccess) { fprintf(stderr, "kernel_launch: hipFuncSetAttribute failed\n"); grid = -1; return; }
        (void)hipGetLastError();
        grid = cus;
    }
    if (grid < 0) return;
    if (hipMemsetAsync((char*)d_ws + WS_CTL, 0, CTL_ZERO_BYTES, stream) != hipSuccess) { fprintf(stderr, "kernel_launch: memset failed\n"); return; }
    Args a{};
    for (int i = 0; i < 23; ++i) a.in[i] = (const float*)d_in[i];
    a.out = (float*)d_out; a.ws = (unsigned char*)d_ws;
#if MK_PER_PHASE
    for (int p = 0; p < N_PHASES; ++p) { a.ph_lo = p; a.ph_hi = p + 1; hipLaunchKernelGGL(mk_fwd, dim3(grid), dim3(NWAVES * 64), LDS_BYTES, stream, a); }
#else
    a.ph_lo = 0; a.ph_hi = N_PHASES;
    hipLaunchKernelGGL(mk_fwd, dim3(grid), dim3(NWAVES * 64), LDS_BYTES, stream, a);
#endif
    const hipError_t le = hipPeekAtLastError();
    if (le != hipSuccess) fprintf(stderr, "kernel_launch: launch failed: %s\n", hipGetErrorName(le));
}
```
